# Optimizing an MI355X kernel written in HIP

```python
import math
import jax, jax.numpy as jnp
from jax import lax
import numpy as np

D_MODEL = 1024
BATCH = 2
SEQ = 8192
DEPTH = 2

N_META = 16
DN_HEAD_DIM = 128
DN_HEADS = D_MODEL // DN_HEAD_DIM
DN_KEY_DIM = DN_HEADS * DN_HEAD_DIM
DN_VAL_DIM = DN_HEADS * DN_HEAD_DIM
QKV_DIM = 2 * DN_KEY_DIM + DN_VAL_DIM
DN_CONV = 4
CHUNK = 64
LEAD_PAD = (-N_META) % CHUNK
POOL_GROUPS = 4
POOL_WINDOWS = (2, 4, 8, 16)
POOL_GROUP_DIM = D_MODEL // 8
POOL_WIDTH = POOL_GROUPS * POOL_GROUP_DIM
POOL_OUT_GROUP = D_MODEL // POOL_GROUPS
N_BRANCHES = 2
SPLIT_SIZES = (QKV_DIM, DN_VAL_DIM, DN_HEADS, DN_HEADS, POOL_WIDTH, N_BRANCHES * D_MODEL)
IN_DIM = QKV_DIM + DN_VAL_DIM + 2 * DN_HEADS + POOL_WIDTH + N_BRANCHES * D_MODEL
D_FF = 256 * ((8 * D_MODEL // 3 + 255) // 256)
FFN_CONV = 3
NORM_EPS = 1e-6

kernel_name = 'hybrid_gdn_pool_meta_block'


def rms_norm(x, gain):
    xf = x.astype(jnp.float32)
    y = xf * lax.rsqrt(jnp.mean(xf * xf, axis=-1, keepdims=True) + NORM_EPS) * gain.astype(jnp.float32)
    return y.astype(x.dtype)


def l2_normalize(x):
    xf = x.astype(jnp.float32)
    return xf * lax.rsqrt(jnp.sum(xf * xf, axis=-1, keepdims=True) + NORM_EPS)


def causal_depthwise_conv(x, w):
    k_width = w.shape[0]
    length = x.shape[1]
    xp = jnp.pad(x, ((0, 0), (k_width - 1, 0), (0, 0)))
    out = xp[:, 0:length] * w[0]
    for j in range(1, k_width):
        out = out + xp[:, j:j + length] * w[j]
    return out


def chunk_gated_delta_rule(q, k, v, g, beta):
    b, t, h, dk = k.shape
    dv = v.shape[-1]
    n = t // CHUNK

    def chunks(a):
        a = a.reshape((b, n, CHUNK, h) + a.shape[3:])
        return jnp.moveaxis(a, 3, 1)

    q = chunks(q) * (dk ** -0.5)
    k = chunks(k)
    v = chunks(v)
    beta = chunks(beta)
    g = lax.cumsum(chunks(g), axis=3)
    idx = jnp.arange(CHUNK)
    causal = idx[:, None] >= idx[None, :]
    strict = idx[:, None] > idx[None, :]
    decay = jnp.exp(jnp.where(causal, g[..., :, None] - g[..., None, :], -jnp.inf))
    kb = k * beta[..., None]
    lower = jnp.where(strict, jnp.einsum('bhncd,bhnsd->bhncs', kb, k) * decay, 0.0)
    eye = jnp.eye(CHUNK, dtype=lower.dtype)
    tinv = lax.linalg.triangular_solve(lower + eye, jnp.broadcast_to(eye, lower.shape),
                                       left_side=True, lower=True, unit_diagonal=True)
    u = jnp.einsum('bhncs,bhnsv->bhncv', tinv, v * beta[..., None])
    w = jnp.einsum('bhncs,bhnsd->bhncd', tinv, kb * jnp.exp(g)[..., None])
    qk = jnp.where(causal, jnp.einsum('bhncd,bhnsd->bhncs', q, k) * decay, 0.0)
    q_dec = q * jnp.exp(g)[..., None]
    k_dec = k * jnp.exp(g[..., -1:] - g)[..., None]
    g_tot = jnp.exp(g[..., -1])

    def step(state, inp):
        q_i, k_i, u_i, w_i, qk_i, gt_i = inp
        v_new = u_i - jnp.einsum('bhck,bhkv->bhcv', w_i, state)
        o_i = jnp.einsum('bhck,bhkv->bhcv', q_i, state) + jnp.einsum('bhcs,bhsv->bhcv', qk_i, v_new)
        state = state * gt_i[..., None, None] + jnp.einsum('bhck,bhcv->bhkv', k_i, v_new)
        return state, o_i

    xs = (jnp.moveaxis(q_dec, 2, 0), jnp.moveaxis(k_dec, 2, 0), jnp.moveaxis(u, 2, 0),
          jnp.moveaxis(w, 2, 0), jnp.moveaxis(qk, 2, 0), jnp.moveaxis(g_tot, 2, 0))
    state0 = jnp.zeros((b, h, dk, dv), jnp.float32)
    _, o = lax.scan(step, state0, xs)
    o = jnp.moveaxis(o, 0, 2)
    return jnp.moveaxis(o, 1, 3).reshape(b, t, h, dv)


def multiscale_causal_pool(p, w_pool, pool_scale):
    b, l, _ = p.shape
    pg = p.astype(jnp.float32).reshape(b, l, POOL_GROUPS, POOL_GROUP_DIM)
    csum = lax.cumsum(pg, axis=1)
    pos = jnp.arange(l)
    outs = []
    for gi, win in enumerate(POOL_WINDOWS):
        c = csum[:, :, gi]
        lagged = jnp.pad(c, ((0, 0), (win, 0), (0, 0)))[:, :l]
        count = jnp.minimum(pos + 1, win).astype(jnp.float32)[None, :, None]
        outs.append((c - lagged) / count - pg[:, :, gi])
    pooled = jnp.stack(outs, axis=2)
    y = jnp.einsum('blgc,gcd->blgd', pooled, w_pool.astype(jnp.float32)).reshape(b, l, D_MODEL)
    return (y * pool_scale.astype(jnp.float32)).astype(p.dtype)


def hybrid_mixer(u, w_in, conv_qkv, a_log, dt_bias, head_norm, w_pool, pool_scale, w_out):
    b, l, _ = u.shape
    proj = jnp.einsum('bld,dp->blp', u, w_in)
    offsets = [int(o) for o in np.cumsum(SPLIT_SIZES)[:-1]]
    qkv, z, b_raw, a_raw, pool_in, gate_pre = jnp.split(proj, offsets, axis=-1)
    qkv = jax.nn.silu(causal_depthwise_conv(qkv, conv_qkv))
    q, k, v = jnp.split(qkv, [DN_KEY_DIM, 2 * DN_KEY_DIM], axis=-1)
    q = l2_normalize(q.reshape(b, l, DN_HEADS, DN_HEAD_DIM))
    k = l2_normalize(k.reshape(b, l, DN_HEADS, DN_HEAD_DIM))
    v = v.reshape(b, l, DN_HEADS, DN_HEAD_DIM).astype(jnp.float32)
    beta = jax.nn.sigmoid(b_raw.astype(jnp.float32))
    g = -jnp.exp(a_log.astype(jnp.float32)) * jax.nn.softplus(
        a_raw.astype(jnp.float32) + dt_bias.astype(jnp.float32))
    pad_r = (-(LEAD_PAD + l)) % CHUNK

    def pad_t(a):
        return jnp.pad(a, [(0, 0), (LEAD_PAD, pad_r)] + [(0, 0)] * (a.ndim - 2))

    o = chunk_gated_delta_rule(pad_t(q), pad_t(k), pad_t(v), pad_t(g), pad_t(beta))
    o = o[:, LEAD_PAD:LEAD_PAD + l]
    zf = z.astype(jnp.float32).reshape(b, l, DN_HEADS, DN_HEAD_DIM)
    o = (o * lax.rsqrt(jnp.mean(o * o, axis=-1, keepdims=True) + NORM_EPS)
         * head_norm.astype(jnp.float32) * jax.nn.silu(zf))
    y_a = o.reshape(b, l, DN_VAL_DIM).astype(u.dtype)
    y_b = multiscale_causal_pool(pool_in, w_pool, pool_scale)
    g_a, g_b = jnp.split(jax.nn.sigmoid(gate_pre), 2, axis=-1)
    y = g_a * y_a + g_b * y_b
    return jnp.einsum('bld,de->ble', y, w_out)


def conv_gated_mlp(u, w_up, conv_ffn, w_down):
    hid = jnp.einsum('bld,df->blf', u, w_up)
    hid = causal_depthwise_conv(hid, conv_ffn)
    gate, val = jnp.split(hid, 2, axis=-1)
    return jnp.einsum('blf,fd->bld', jax.nn.silu(gate) * val, w_down)


def setup_inputs(seed: int = 0) -> dict:
    key = jax.random.key(seed)
    ks = jax.random.split(key, 16)
    f32 = jnp.float32

    def normal(k, shape, scale):
        return jax.random.normal(k, shape, f32) * scale

    x = normal(ks[0], (BATCH, SEQ, D_MODEL), 1.0)
    meta_tokens = normal(ks[1], (N_META, D_MODEL), 1.0)
    norm_mix = 1.0 + normal(ks[2], (DEPTH, D_MODEL), 0.02)
    w_in = normal(ks[3], (DEPTH, D_MODEL, IN_DIM), D_MODEL ** -0.5)
    conv_qkv = normal(ks[4], (DEPTH, DN_CONV, QKV_DIM), DN_CONV ** -0.5)
    a_log = jnp.log(jax.random.uniform(ks[5], (DEPTH, DN_HEADS), f32, 1.0, 16.0))
    dt = jnp.exp(jax.random.uniform(ks[6], (DEPTH, DN_HEADS), f32, math.log(1e-3), math.log(1e-1)))
    dt_bias = dt + jnp.log(-jnp.expm1(-dt))
    head_norm = 1.0 + normal(ks[7], (DEPTH, DN_HEAD_DIM), 0.02)
    w_pool = normal(ks[8], (DEPTH, POOL_GROUPS, POOL_GROUP_DIM, POOL_OUT_GROUP), POOL_GROUP_DIM ** -0.5)
    pool_scale = 1.0 + normal(ks[9], (DEPTH, D_MODEL), 0.02)
    w_out = normal(ks[10], (DEPTH, D_MODEL, D_MODEL), D_MODEL ** -0.5)
    norm_ffn = 1.0 + normal(ks[11], (DEPTH, D_MODEL), 0.02)
    w_up = normal(ks[12], (DEPTH, D_MODEL, 2 * D_FF), D_MODEL ** -0.5)
    conv_ffn = normal(ks[13], (DEPTH, FFN_CONV, 2 * D_FF), FFN_CONV ** -0.5)
    w_down = normal(ks[14], (DEPTH, D_FF, D_MODEL), D_FF ** -0.5)
    norm_final = 1.0 + normal(ks[15], (D_MODEL,), 0.02)
    return {'x': x, 'meta_tokens': meta_tokens, 'norm_mix': norm_mix, 'w_in': w_in,
            'conv_qkv': conv_qkv, 'a_log': a_log, 'dt_bias': dt_bias, 'head_norm': head_norm,
            'w_pool': w_pool, 'pool_scale': pool_scale, 'w_out': w_out, 'norm_ffn': norm_ffn,
            'w_up': w_up, 'conv_ffn': conv_ffn, 'w_down': w_down, 'norm_final': norm_final}


def reference(x, meta_tokens, norm_mix, w_in, conv_qkv, a_log, dt_bias, head_norm, w_pool,
              pool_scale, w_out, norm_ffn, w_up, conv_ffn, w_down, norm_final):
    b = x.shape[0]
    meta = jnp.broadcast_to(meta_tokens.astype(x.dtype)[None], (b, N_META, D_MODEL))
    h = jnp.concatenate([meta, x], axis=1)
    for layer in range(DEPTH):
        h = h + hybrid_mixer(rms_norm(h, norm_mix[layer]), w_in[layer], conv_qkv[layer], a_log[layer],
                             dt_bias[layer], head_norm[layer], w_pool[layer], pool_scale[layer], w_out[layer])
        h = h + conv_gated_mlp(rms_norm(h, norm_ffn[layer]), w_up[layer], conv_ffn[layer], w_down[layer])
    h = rms_norm(h, norm_final)
    return h[:, N_META:]
```

```cpp
#include <hip/hip_runtime.h>
#include <hip/hip_cooperative_groups.h>
#include <cstdio>
namespace cg = cooperative_groups;
#include <hip/hip_runtime.h>
namespace pg8 {
#define PG8_LAS __attribute__((address_space(3)))
typedef unsigned short bf16_t;
typedef short bf16x8 __attribute__((ext_vector_type(8)));
typedef float f32x4 __attribute__((ext_vector_type(4)));
typedef unsigned u32x4 __attribute__((ext_vector_type(4)));
constexpr int BM = 256, BK = 64, HALF = 128, HTB = HALF * BK * 2  , STAGE_BYTES = 8 * HTB, NXCD = 8, WGM = 8;

__host__ __device__ __forceinline__ int lds_byte(int r, int c) { const int st = (r >> 4) * 2 + (c >> 5), rr = r & 15, cc = c & 31, ob = rr * 64 + cc * 2; return st * 1024 + (ob ^ (((ob >> 9) & 1) << 5)); }
__host__ __device__ __forceinline__ void stage_rc(int b, int& R, int& C) { const int st = b / 1024, sb = b % 1024, swz = sb ^ (((sb >> 9) & 1) << 5); R = (st >> 1) * 16 + swz / 64; C = (st & 1) * 32 + (swz % 64) / 2; }
__host__ __device__ __forceinline__ int perm32(int rho) { const int n = rho >> 4, i = rho & 15; return 8 * (i >> 2) + 4 * n + (i & 3); }

struct Unit { int pm, pn; };
struct Gemm { const bf16_t* A; const bf16_t* Bt; int M, N, K, lda, ldb; };

struct StaticOrder {
    int nM, nN, nwg, G, c;
    __host__ __device__ void init(int M, int N, int G_, int c_) { nM = M / BM; nN = N / BM; nwg = nM * nN; G = G_; c = c_; }
    __host__ __device__ bool next(int i, Unit& u) const {
        const long L = (long)i * G + c; if (L >= nwg) return false;
        int wgid = (int)L; { const int q = nwg / NXCD, r = nwg % NXCD, xcd = wgid % NXCD, off = wgid / NXCD; wgid = (xcd < r ? xcd * (q + 1) : r * (q + 1) + (xcd - r) * q) + off; }
        const int nig = WGM * nN, gid = wgid / nig, fm = gid * WGM, gsz = (nM - fm) < WGM ? (nM - fm) : WGM;
        u.pm = fm + ((wgid % nig) % gsz); u.pn = (wgid % nig) / gsz; return true;
    }
    __device__ __forceinline__ void a_ready(const Unit&) const {}
    __device__ __forceinline__ void done(const Unit&) const {}
};

template <class Epi, class Sched>
__device__ __forceinline__ void gemm_phase(PG8_LAS unsigned char* lds, const Gemm g, const Sched& S, const Epi& E) {
    int tid = threadIdx.x; asm volatile("" : "+v"(tid)); const int wid = __builtin_amdgcn_readfirstlane(tid >> 6), lane = tid & 63, wr = wid >> 2, wc = wid & 3, fr = lane & 15, fq = lane >> 4;
    const int K = g.K, nt = K / BK;
    unsigned voffA[2], voffB[2];
#pragma unroll
    for (int i = 0; i < 2; ++i) { int R, C; stage_rc(tid * 16 + i * 8192, R, C); const int Rb = Epi::PERM ? ((R & ~31) + perm32(R & 31)) : R;
        voffA[i] = (unsigned)(R * g.lda + C) * 2u; voffB[i] = (unsigned)(Rb * g.ldb + C) * 2u; }
    const size_t kstep = (size_t)(BK * 2);
    const size_t hstepA = (size_t)HALF * g.lda * 2, hstepB = (size_t)HALF * g.ldb * 2;
    const size_t tstepA = 2 * hstepA, tstepB = 2 * hstepB;
    const unsigned ldsw = (unsigned)wid * 1024u;
    const int aoff = lds_byte(wr * 64 + fr, fq * 8), boff = lds_byte(wc * 32 + fr, fq * 8);
#define PG8_SA(b, h) (((b) * 2 + (h)) * HTB)
#define PG8_SB(b, h) ((4 + (b) * 2 + (h)) * HTB)
#define PG8_STAGE(bufoff, gbase, voff) do { _Pragma("unroll") for (int _i = 0; _i < 2; ++_i) \
        __builtin_amdgcn_global_load_lds((const unsigned*)((const char*)(gbase) + (voff)[_i]), (PG8_LAS unsigned*)(lds + (bufoff) + ldsw + _i * 8192), 16, 0, 0); } while (0)
#define PG8_LDA(dst, b, h) do { _Pragma("unroll") for (int m = 0; m < 4; ++m) _Pragma("unroll") for (int k = 0; k < 2; ++k) dst[m][k] = *(const PG8_LAS bf16x8*)(lds + PG8_SA(b, h) + aoff + m * 2048 + k * 1024); } while (0)
#define PG8_LDB(dst, b, h) do { _Pragma("unroll") for (int n = 0; n < 2; ++n) _Pragma("unroll") for (int k = 0; k < 2; ++k) dst[n][k] = *(const PG8_LAS bf16x8*)(lds + PG8_SB(b, h) + boff + n * 2048 + k * 1024); } while (0)
#define PG8_MMA(ai, bj, At, Bt) do { __builtin_amdgcn_s_setprio(1); _Pragma("unroll") for (int m = 0; m < 4; ++m) _Pragma("unroll") for (int n = 0; n < 2; ++n) _Pragma("unroll") for (int k = 0; k < 2; ++k) \
        acc[ai][bj][m][n] = __builtin_amdgcn_mfma_f32_16x16x32_bf16(Bt[n][k], At[m][k], acc[ai][bj][m][n], 0, 0, 0); __builtin_amdgcn_s_setprio(0); } while (0)
#define PG8_WAIT_V(n) asm volatile("s_waitcnt vmcnt(" #n ")" ::: "memory")
#define PG8_WAIT_L(n) asm volatile("s_waitcnt lgkmcnt(" #n ")" ::: "memory")
#define PG8_BAR __builtin_amdgcn_s_barrier()
#define PG8_SCHED __builtin_amdgcn_sched_barrier(0)
    Unit cur, nxt; int ui = 0;
    if (!S.next(0, cur)) return;
    f32x4 acc[2][2][4][2];
#pragma unroll
    for (int a = 0; a < 2; ++a)
#pragma unroll
        for (int b = 0; b < 2; ++b)
#pragma unroll
            for (int m = 0; m < 4; ++m)
#pragma unroll
                for (int n = 0; n < 2; ++n) acc[a][b][m][n] = (f32x4){0.f, 0.f, 0.f, 0.f};
    bf16x8 At[4][2], B0[2][2], B1[2][2];
    const char* cA = (const char*)g.A + (size_t)cur.pm * tstepA; const char* cB = (const char*)g.Bt + (size_t)cur.pn * tstepB;
    S.a_ready(cur);
    PG8_STAGE(PG8_SB(0, 0), cB, voffB); PG8_STAGE(PG8_SA(0, 0), cA, voffA); PG8_STAGE(PG8_SB(0, 1), cB + hstepB, voffB); PG8_STAGE(PG8_SA(0, 1), cA + hstepA, voffA);
    if (wr == 1) PG8_BAR;
    PG8_WAIT_V(4); PG8_BAR;
    PG8_STAGE(PG8_SB(1, 0), cB + kstep, voffB); PG8_STAGE(PG8_SA(1, 0), cA + kstep, voffA); PG8_STAGE(PG8_SB(1, 1), cB + hstepB + kstep, voffB);
    PG8_WAIT_V(6); PG8_BAR;
    for (;;) {
        const bool has_next = S.next(ui + 1, nxt);
        const char* nA = has_next ? (const char*)g.A + (size_t)nxt.pm * tstepA : cA; const char* nB = has_next ? (const char*)g.Bt + (size_t)nxt.pn * tstepB : cB;
        for (int t = 0; t < nt; t += 2) {
            const bool last = (t == nt - 2);
            const char* a1 = cA + (size_t)(t + 1) * kstep;
            const char* a2 = last ? nA : cA + (size_t)(t + 2) * kstep; const char* b2 = last ? nB : cB + (size_t)(t + 2) * kstep;
            const char* a3 = a2 + kstep; const char* b3 = b2 + kstep;
            if (last && has_next) S.a_ready(nxt);
            PG8_LDB(B0, 0, 0); PG8_SCHED; PG8_LDA(At, 0, 0); PG8_STAGE(PG8_SA(1, 1), a1 + hstepA, voffA);
            PG8_WAIT_L(8); PG8_BAR; PG8_WAIT_L(0); PG8_MMA(0, 0, At, B0); PG8_BAR; PG8_SCHED;
            PG8_LDB(B1, 0, 1); PG8_STAGE(PG8_SB(0, 0), b2, voffB);
            PG8_BAR; PG8_WAIT_L(0); PG8_MMA(0, 1, At, B1); PG8_BAR;
            PG8_LDA(At, 0, 1); PG8_STAGE(PG8_SA(0, 0), a2, voffA);
            PG8_BAR; PG8_WAIT_L(0); PG8_MMA(1, 0, At, B0); PG8_BAR; PG8_SCHED;
            PG8_STAGE(PG8_SB(0, 1), b2 + hstepB, voffB);
            PG8_WAIT_V(6); PG8_BAR; PG8_MMA(1, 1, At, B1); PG8_BAR;
            PG8_LDB(B0, 1, 0); PG8_SCHED; PG8_LDA(At, 1, 0); PG8_STAGE(PG8_SA(0, 1), a2 + hstepA, voffA);
            PG8_WAIT_L(8); PG8_BAR; PG8_WAIT_L(0); PG8_MMA(0, 0, At, B0); PG8_BAR; PG8_SCHED;
            PG8_LDB(B1, 1, 1); PG8_STAGE(PG8_SB(1, 0), b3, voffB);
            PG8_BAR; PG8_WAIT_L(0); PG8_MMA(0, 1, At, B1); PG8_BAR;
            PG8_LDA(At, 1, 1); PG8_STAGE(PG8_SA(1, 0), a3, voffA);
            PG8_BAR; PG8_WAIT_L(0); PG8_MMA(1, 0, At, B0); PG8_BAR; PG8_SCHED;
            PG8_STAGE(PG8_SB(1, 1), b3 + hstepB, voffB);
            PG8_WAIT_V(6); PG8_BAR; PG8_MMA(1, 1, At, B1); PG8_BAR;
        }
        if constexpr (!Epi::AFTER_DRAIN) { E(acc, cur, wr, wc, fr, fq); S.done(cur); }
        if (!has_next) break;
#pragma unroll
        for (int a = 0; a < 2; ++a)
#pragma unroll
            for (int b = 0; b < 2; ++b)
#pragma unroll
                for (int m = 0; m < 4; ++m)
#pragma unroll
                    for (int n = 0; n < 2; ++n) acc[a][b][m][n] = (f32x4){0.f, 0.f, 0.f, 0.f};
        cur = nxt; cA = nA; cB = nB; ++ui;
    }
    PG8_WAIT_V(0);
    if (wr == 0) PG8_BAR;
    PG8_BAR;
    if constexpr (Epi::AFTER_DRAIN) { E.fused(acc, cur, wr, wc, fr, fq, lds, wid, lane); S.done(cur); }
#undef PG8_SA
#undef PG8_SB
#undef PG8_STAGE
#undef PG8_LDA
#undef PG8_LDB
#undef PG8_MMA
#undef PG8_WAIT_V
#undef PG8_WAIT_L
#undef PG8_BAR
#undef PG8_SCHED
}
}


using pg8::bf16_t; using pg8::bf16x8; using pg8::f32x4; using pg8::u32x4;
typedef unsigned u32x2 __attribute__((ext_vector_type(2)));
typedef __bf16 bf16x2_t __attribute__((ext_vector_type(2)));
typedef float f32x2 __attribute__((ext_vector_type(2)));
#define DI __device__ __forceinline__

constexpr int MMAIN = 16384, MPAD = 16640, IN_DIM = 6672, DFF = 2816, FF2 = 5632;
constexpr size_t SZ_ACT = (size_t)MPAD * 1024 * 2;
constexpr size_t WS_WIN = 0;
constexpr size_t WS_WOUT = WS_WIN + (size_t)6656 * 1024 * 2;
constexpr size_t WS_WUP = WS_WOUT + (size_t)1024 * 1024 * 2;
constexpr size_t WS_WDN = WS_WUP + (size_t)5632 * 1024 * 2;
constexpr size_t WS_WPT = WS_WDN + (size_t)1024 * 2816 * 2;
constexpr size_t WS_U = WS_WPT + (size_t)4 * 256 * 128 * 2;
constexpr size_t WS_QB = WS_U + SZ_ACT;
constexpr size_t WS_KB = WS_QB + SZ_ACT;
constexpr size_t WS_VB = WS_KB + SZ_ACT;
constexpr size_t WS_WB = WS_VB + SZ_ACT;
constexpr size_t WS_KTB = WS_WB + SZ_ACT;
constexpr size_t WS_QKB = WS_KTB + SZ_ACT;
constexpr size_t WS_HALO = WS_QKB + (size_t)260 * 8 * 4096 * 2;
constexpr size_t WS_BA = WS_HALO + (size_t)260 * 2 * 5632 * 2;
constexpr size_t WS_HM = WS_BA + (size_t)MPAD * 16 * 4;
constexpr size_t WS_GT = WS_HM + (size_t)256 * 1024 * 4;
constexpr size_t WS_END = WS_GT + (size_t)260 * 8 * 4;
static_assert(WS_QKB + (size_t)260 * 8 * 4096 * 2 - WS_QB == (size_t)MPAD * FF2 * 2, "hid overlay");
static_assert(WS_END <= 268435456ull, "workspace");
constexpr int LDS_BYTES = 131072;

struct Params {
    const float *x, *meta, *norm_mix, *w_in, *conv_qkv, *a_log, *dt_bias, *head_norm, *w_pool, *pool_scale, *w_out, *norm_ffn, *w_up, *conv_ffn, *w_down, *norm_final;
    float* out; unsigned char* ws;
};

DI int opaque_tid() { int t = threadIdx.x; asm volatile("" : "+v"(t)); return t; }
DI unsigned pk2(float a, float b) { f32x2 v = {a, b}; bf16x2_t r = __builtin_convertvector(v, bf16x2_t); return __builtin_bit_cast(unsigned, r); }
DI bf16_t f2bf(float a) { return (bf16_t)(pk2(a, 0.f) & 0xffffu); }
DI float bflo(unsigned w) { return __uint_as_float(w << 16); }
DI float bfhi(unsigned w) { return __uint_as_float(w & 0xffff0000u); }
DI float bf2f(bf16_t b) { return __uint_as_float(((unsigned)b) << 16); }
DI bf16x8 pack8(f32x4 a, f32x4 b) { u32x4 w; w.x = pk2(a[0], a[1]); w.y = pk2(a[2], a[3]); w.z = pk2(b[0], b[1]); w.w = pk2(b[2], b[3]); return __builtin_bit_cast(bf16x8, w); }
DI f32x4 mfma16(bf16x8 a, bf16x8 b, f32x4 c) { return __builtin_amdgcn_mfma_f32_16x16x32_bf16(a, b, c, 0, 0, 0); }
DI float sigm(float x) { return 1.0f / (1.0f + __expf(-x)); }
DI float silu(float x) { return x / (1.0f + __expf(-x)); }
DI float wsum(float v) { v += __shfl_xor(v, 32); v += __shfl_xor(v, 16); v += __shfl_xor(v, 8); v += __shfl_xor(v, 4); v += __shfl_xor(v, 2); v += __shfl_xor(v, 1); return v; }
DI float* hrow(const Params& p, int r) { return r < MMAIN ? p.out + (size_t)r * 1024 : (float*)(p.ws + WS_HM) + (size_t)(r - MMAIN) * 1024; }

struct EpiQKV {
    static constexpr bool PERM = true, AFTER_DRAIN = false;
    bf16_t *Q, *halo;
    DI void operator()(const f32x4 (&acc)[2][2][4][2], const pg8::Unit& u, int wr, int wc, int fr, int fq) const {
        const int which = u.pn >> 2; bf16_t* base = Q + (size_t)which * (SZ_ACT / 2);
#pragma unroll
        for (int ai = 0; ai < 2; ++ai)
#pragma unroll
            for (int m = 0; m < 4; ++m) {
                const int cb = u.pm * 4 + ai * 2 + wr, rr = m * 16 + fr;
#pragma unroll
                for (int bj = 0; bj < 2; ++bj) {
                    const int head = (u.pn & 3) * 2 + bj, cc = wc * 32 + 8 * fq;
                    const f32x4 v0 = acc[ai][bj][m][0], v1 = acc[ai][bj][m][1];
                    u32x4 w; w.x = pk2(v0[0], v0[1]); w.y = pk2(v0[2], v0[3]); w.z = pk2(v1[0], v1[1]); w.w = pk2(v1[2], v1[3]);
                    *(u32x4*)(base + ((size_t)(cb * 8 + head) * 64 + rr) * 128 + cc) = w;
                    if (m == 3 && fr >= 13) *(u32x4*)(halo + ((size_t)cb * 3 + (rr - 61)) * 3072 + u.pn * 256 + bj * 128 + cc) = w;
                }
            }
    }
};
struct EpiZPG {
    static constexpr bool PERM = true, AFTER_DRAIN = false;
    bf16_t *QB0;
    DI void operator()(const f32x4 (&acc)[2][2][4][2], const pg8::Unit& u, int wr, int wc, int fr, int fq) const {
        const int ge4 = u.pn >= 4, ge6 = u.pn >= 6, ge10 = u.pn >= 10, idx = ge4 + ge6 + ge10, is1 = (idx == 1);
        const int slot = idx + 4 * is1, ld = 1024 >> is1, c0 = (u.pn - (4 * ge4 + 2 * ge6 + 4 * ge10)) * 256;
        bf16_t* base = QB0 + (size_t)slot * (SZ_ACT / 2);
#pragma unroll
        for (int ai = 0; ai < 2; ++ai)
#pragma unroll
            for (int m = 0; m < 4; ++m) {
                const int row = u.pm * 256 + ai * 128 + wr * 64 + m * 16 + fr;
#pragma unroll
                for (int bj = 0; bj < 2; ++bj) {
                    const f32x4 v0 = acc[ai][bj][m][0], v1 = acc[ai][bj][m][1];
                    u32x4 w; w.x = pk2(v0[0], v0[1]); w.y = pk2(v0[2], v0[3]); w.z = pk2(v1[0], v1[1]); w.w = pk2(v1[2], v1[3]);
                    *(u32x4*)(base + (size_t)row * ld + c0 + bj * 128 + wc * 32 + 8 * fq) = w;
                }
            }
    }
};
struct EpiHid {
    static constexpr bool PERM = true, AFTER_DRAIN = false;
    bf16_t *H, *halo;
    DI void operator()(const f32x4 (&acc)[2][2][4][2], const pg8::Unit& u, int wr, int wc, int fr, int fq) const {
#pragma unroll
        for (int ai = 0; ai < 2; ++ai)
#pragma unroll
            for (int m = 0; m < 4; ++m) {
                const int cb = u.pm * 4 + ai * 2 + wr, rr = m * 16 + fr, row = cb * 64 + rr;
#pragma unroll
                for (int bj = 0; bj < 2; ++bj) {
                    const int col = u.pn * 256 + bj * 128 + wc * 32 + 8 * fq;
                    const f32x4 v0 = acc[ai][bj][m][0], v1 = acc[ai][bj][m][1];
                    u32x4 w; w.x = pk2(v0[0], v0[1]); w.y = pk2(v0[2], v0[3]); w.z = pk2(v1[0], v1[1]); w.w = pk2(v1[2], v1[3]);
                    *(u32x4*)(H + (size_t)row * FF2 + col) = w;
                    if (m == 3 && fr >= 14) *(u32x4*)(halo + ((size_t)cb * 2 + (rr - 62)) * FF2 + col) = w;
                }
            }
    }
};
struct EpiRes {
    static constexpr bool PERM = false, AFTER_DRAIN = false;
    float *hmain, *hmeta;
    DI void operator()(const f32x4 (&acc)[2][2][4][2], const pg8::Unit& u, int wr, int wc, int fr, int fq) const {
        const int col0 = u.pn * 256 + wc * 32 + 4 * fq;
#pragma unroll
        for (int ai = 0; ai < 2; ++ai)
#pragma unroll
            for (int m = 0; m < 4; ++m) {
                const int row = u.pm * 256 + ai * 128 + wr * 64 + m * 16 + fr;
                float* rp = (row < MMAIN ? hmain + (size_t)row * 1024 : hmeta + (size_t)(row - MMAIN) * 1024) + col0;
#pragma unroll
                for (int bj = 0; bj < 2; ++bj)
#pragma unroll
                    for (int n = 0; n < 2; ++n) { f32x4* q = (f32x4*)(rp + bj * 128 + n * 16); *q = *q + acc[ai][bj][m][n]; }
            }
    }
};

DI void cvt_tile(const float* W, int ldw, int k0, int n0src, bf16_t* Bt, int ldb, int n0dst, float* tl, int tid) {
#pragma unroll
    for (int i = 0; i < 2; ++i) { const int kk = (tid >> 4) + 32 * i, c4 = (tid & 15) * 4;
        const float4 v = *(const float4*)(W + (size_t)(k0 + kk) * ldw + n0src + c4);
        tl[kk * 65 + c4 + 0] = v.x; tl[kk * 65 + c4 + 1] = v.y; tl[kk * 65 + c4 + 2] = v.z; tl[kk * 65 + c4 + 3] = v.w; }
    __syncthreads();
    { const int nn = tid >> 3, k8 = (tid & 7) * 8; float f[8];
#pragma unroll
      for (int j = 0; j < 8; ++j) f[j] = tl[(k8 + j) * 65 + nn];
      u32x4 w; w.x = pk2(f[0], f[1]); w.y = pk2(f[2], f[3]); w.z = pk2(f[4], f[5]); w.w = pk2(f[6], f[7]);
      *(u32x4*)(Bt + (size_t)(n0dst + nn) * ldb + k0 + k8) = w; }
    __syncthreads();
}
DI void convert_weights(const Params& p, int layer, unsigned char* smem, int tid) {
    float* tl = (float*)smem;
    const float* win = p.w_in + (size_t)layer * 1024 * IN_DIM; const float* wout = p.w_out + (size_t)layer * 1024 * 1024;
    const float* wup = p.w_up + (size_t)layer * 1024 * FF2; const float* wdn = p.w_down + (size_t)layer * DFF * 1024; const float* wpl = p.w_pool + (size_t)layer * 4 * 128 * 256;
    bf16_t* Win = (bf16_t*)(p.ws + WS_WIN); bf16_t* Wout = (bf16_t*)(p.ws + WS_WOUT); bf16_t* Wup = (bf16_t*)(p.ws + WS_WUP); bf16_t* Wdn = (bf16_t*)(p.ws + WS_WDN); bf16_t* Wpt = (bf16_t*)(p.ws + WS_WPT);
    for (int t = blockIdx.x; t < 4064; t += gridDim.x) {
        if (t < 1664) { const int kt = t / 104, nt = t % 104, n0 = nt * 64; cvt_tile(win, IN_DIM, kt * 64, n0 + (n0 >= 4096 ? 16 : 0), Win, 1024, n0, tl, tid); }
        else if (t < 1920) { const int q = t - 1664; cvt_tile(wout, 1024, (q >> 4) * 64, (q & 15) * 64, Wout, 1024, (q & 15) * 64, tl, tid); }
        else if (t < 3328) { const int q = t - 1920, kt = q / 88, nt = q % 88; cvt_tile(wup, FF2, kt * 64, nt * 64, Wup, 1024, nt * 64, tl, tid); }
        else if (t < 4032) { const int q = t - 3328, kt = q >> 4, nt = q & 15; cvt_tile(wdn, 1024, kt * 64, nt * 64, Wdn, DFF, nt * 64, tl, tid); }
        else { const int q = t - 4032, g = q >> 3, kt = (q >> 2) & 1, nt = q & 3; cvt_tile(wpl + (size_t)g * 128 * 256, 256, kt * 64, nt * 64, Wpt + (size_t)g * 256 * 128, 128, nt * 64, tl, tid); }
    }
}

DI void phase_norm(const Params& p, int layer, int which, unsigned char* smem) {
    const int tid = opaque_tid(), lane = tid & 63, wid = tid >> 6;
    float* wba = (float*)smem;
    float* BA = (float*)(p.ws + WS_BA); bf16_t* U = (bf16_t*)(p.ws + WS_U);
    if (which == 0) {
        convert_weights(p, layer, smem, tid);
        __syncthreads();
        const float* win = p.w_in + (size_t)layer * 1024 * IN_DIM;
        for (int e = tid; e < 4096; e += 512) { const int k = e >> 2, j4 = (e & 3) * 4; *(float4*)(wba + k * 20 + j4) = *(const float4*)(win + (size_t)k * IN_DIM + 4096 + j4); }
        __syncthreads();
    }
    const float* gain = (which == 0 ? p.norm_mix : p.norm_ffn) + layer * 1024;
    const bool init = (layer == 0 && which == 0);
    for (int r = blockIdx.x * 8 + wid; r < MPAD; r += gridDim.x * 8) {
        const float* src;
        if (init) { if (r < MMAIN) src = p.x + (size_t)r * 1024; else { const int rm = r - MMAIN, s = rm & 63; src = (rm < 128 && s >= 48) ? p.meta + (size_t)(s - 48) * 1024 : nullptr; } }
        else src = hrow(p, r);
        float v[16]; float ss = 0.f;
#pragma unroll
        for (int i = 0; i < 16; ++i) { v[i] = src ? src[lane + 64 * i] : 0.f; ss += v[i] * v[i]; }
        if (init) { float* hr = hrow(p, r);
#pragma unroll
            for (int i = 0; i < 16; ++i) hr[lane + 64 * i] = v[i]; }
        ss = wsum(ss);
        const float rstd = rsqrtf(ss * (1.0f / 1024.0f) + 1e-6f);
#pragma unroll
        for (int i = 0; i < 16; ++i) { v[i] = v[i] * rstd * gain[lane + 64 * i]; U[(size_t)r * 1024 + lane + 64 * i] = f2bf(v[i]); }
        if (which == 0) {
            float acc[16]; int vz = 0; asm volatile("" : "+v"(vz)); const float* wbz = wba + vz;
#pragma unroll
            for (int j = 0; j < 16; ++j) acc[j] = 0.f;
#pragma unroll
            for (int i = 0; i < 16; ++i) { const float* wr_ = wbz + (lane + 64 * i) * 20;
#pragma unroll
                for (int j4 = 0; j4 < 4; ++j4) { const float4 w = *(const float4*)(wr_ + 4 * j4);
                    acc[4 * j4 + 0] += v[i] * w.x; acc[4 * j4 + 1] += v[i] * w.y; acc[4 * j4 + 2] += v[i] * w.z; acc[4 * j4 + 3] += v[i] * w.w; } }
            float o = 0.f;
#pragma unroll
            for (int j = 0; j < 16; ++j) { const float s = wsum(acc[j]); o = (lane == j) ? s : o; }
            if (lane < 16) BA[(size_t)r * 16 + lane] = o;
        }
    }
}
DI void phase_final(const Params& p) {
    const int tid = opaque_tid(), lane = tid & 63, wid = tid >> 6;
    for (int r = blockIdx.x * 8 + wid; r < MMAIN; r += gridDim.x * 8) {
        float* hr = p.out + (size_t)r * 1024; float v[16]; float ss = 0.f;
#pragma unroll
        for (int i = 0; i < 16; ++i) { v[i] = hr[lane + 64 * i]; ss += v[i] * v[i]; }
        ss = wsum(ss); const float rstd = rsqrtf(ss * (1.0f / 1024.0f) + 1e-6f);
#pragma unroll
        for (int i = 0; i < 16; ++i) hr[lane + 64 * i] = v[i] * rstd * p.norm_final[lane + 64 * i];
    }
}

DI void phase_p3(const Params& p, int layer, unsigned char* smem) {
    const int tid = opaque_tid(), lane = tid & 63, wid = tid >> 6; int q4 = lane >> 4, l16 = lane & 15;
    bf16_t* qs = (bf16_t*)(smem); bf16_t* ks = (bf16_t*)(smem + 17408); bf16_t* vbT = (bf16_t*)(smem + 34816); bf16_t* kgT = (bf16_t*)(smem + 53248);
    float* Lm = (float*)(smem + 71680); bf16_t* Tb = (bf16_t*)(smem + 89088); float* sc = (float*)(smem + 98304);
    bf16_t* QB = (bf16_t*)(p.ws + WS_QB); bf16_t* KB = (bf16_t*)(p.ws + WS_KB); bf16_t* VB = (bf16_t*)(p.ws + WS_VB); bf16_t* WB = (bf16_t*)(p.ws + WS_WB);
    bf16_t* KTB = (bf16_t*)(p.ws + WS_KTB); bf16_t* QKB = (bf16_t*)(p.ws + WS_QKB); const bf16_t* HALO = (const bf16_t*)(p.ws + WS_HALO);
    const float* BA = (const float*)(p.ws + WS_BA); float* GT = (float*)(p.ws + WS_GT);
    const float* cw = p.conv_qkv + (size_t)layer * 4 * 3072;
    const float SCALE = 0.08838834764831845f;
    for (int item = blockIdx.x; item < 258 * 8; item += gridDim.x) {
        const int cb = item >> 3, h = item & 7;
        int b, c; if (cb < 256) { b = cb >> 7; c = (cb & 127) + 1; } else { b = cb - 256; c = 0; }
        const int prev_cb = (c == 0) ? -1 : (c == 1 ? 256 + b : cb - 1);
        const size_t blk = (size_t)item * 8192;
        if (wid == 0) {
            const int row = cb * 64 + lane;
            const float braw = BA[(size_t)row * 16 + h], araw = BA[(size_t)row * 16 + 8 + h];
            float beta = 1.0f / (1.0f + expf(-braw));
            const float xx = araw + p.dt_bias[layer * 8 + h]; const float sp = xx > 20.f ? xx : log1pf(expf(xx));
            float g = -expf(p.a_log[layer * 8 + h]) * sp;
            if (c == 0 && lane < 48) { g = 0.f; beta = 0.f; }
            float G = g;
#pragma unroll
            for (int off = 1; off < 64; off <<= 1) { const float t = __shfl_up(G, off); if (lane >= off) G += t; }
            const float Gl = __shfl(G, 63);
            sc[lane] = beta; sc[64 + lane] = G; sc[128 + lane] = expf(G); sc[192 + lane] = expf(Gl - G);
            if (lane == 63) GT[item] = expf(G);
        }
        __syncthreads();
        {
            const int c0 = 2 * lane, r0 = 8 * wid;
            float wq[4][2], wk[4][2], wv[4][2];
#pragma unroll
            for (int j = 0; j < 4; ++j)
#pragma unroll
                for (int e = 0; e < 2; ++e) { wq[j][e] = cw[j * 3072 + h * 128 + c0 + e]; wk[j][e] = cw[j * 3072 + 1024 + h * 128 + c0 + e]; wv[j][e] = cw[j * 3072 + 2048 + h * 128 + c0 + e]; }
            unsigned xq[11], xk[11], xv[11];
#pragma unroll
            for (int i = 0; i < 11; ++i) { const int rr = r0 - 3 + i;
                if (rr >= 0) { xq[i] = *(const unsigned*)(QB + blk + rr * 128 + c0); xk[i] = *(const unsigned*)(KB + blk + rr * 128 + c0); xv[i] = *(const unsigned*)(VB + blk + rr * 128 + c0); }
                else if (prev_cb >= 0) { const bf16_t* hp = HALO + ((size_t)prev_cb * 3 + (rr + 3)) * 3072 + h * 128 + c0; xq[i] = *(const unsigned*)hp; xk[i] = *(const unsigned*)(hp + 1024); xv[i] = *(const unsigned*)(hp + 2048); }
                else { xq[i] = 0u; xk[i] = 0u; xv[i] = 0u; } }
#pragma unroll
            for (int i = 0; i < 8; ++i) {
                const int r = r0 + i;
                float cq0 = 0.f, cq1 = 0.f, ck0 = 0.f, ck1 = 0.f, cv0 = 0.f, cv1 = 0.f;
#pragma unroll
                for (int j = 0; j < 4; ++j) { cq0 += wq[j][0] * bflo(xq[i + j]); cq1 += wq[j][1] * bfhi(xq[i + j]); ck0 += wk[j][0] * bflo(xk[i + j]); ck1 += wk[j][1] * bfhi(xk[i + j]);
                    cv0 += wv[j][0] * bflo(xv[i + j]); cv1 += wv[j][1] * bfhi(xv[i + j]); }
                cq0 = silu(cq0); cq1 = silu(cq1); ck0 = silu(ck0); ck1 = silu(ck1); cv0 = silu(cv0); cv1 = silu(cv1);
                const float sq = wsum(cq0 * cq0 + cq1 * cq1), sk = wsum(ck0 * ck0 + ck1 * ck1);
                const float rq = rsqrtf(sq + 1e-6f), rk = rsqrtf(sk + 1e-6f);
                cq0 *= rq; cq1 *= rq; ck0 *= rk; ck1 *= rk;
                const float beta = sc[r], eg = sc[128 + r];
                *(unsigned*)(qs + r * 136 + c0) = pk2(cq0, cq1); *(unsigned*)(ks + r * 136 + c0) = pk2(ck0, ck1);
                vbT[(c0 + 0) * 72 + r] = f2bf(cv0 * beta); vbT[(c0 + 1) * 72 + r] = f2bf(cv1 * beta);
                kgT[(c0 + 0) * 72 + r] = f2bf(ck0 * beta * eg); kgT[(c0 + 1) * 72 + r] = f2bf(ck1 * beta * eg);
            }
        }
        __syncthreads();
        { int lz = lane; asm volatile("" : "+v"(lz)); q4 = lz >> 4; l16 = lz & 15; }
        if (wid < 4) {
            const int mt = wid; bf16x8 a[4];
#pragma unroll
            for (int kb = 0; kb < 4; ++kb) a[kb] = *(const bf16x8*)(ks + (16 * mt + l16) * 136 + 32 * kb + 8 * q4);
            for (int nt = 0; nt <= mt; ++nt) {
                f32x4 d = {0.f, 0.f, 0.f, 0.f};
#pragma unroll
                for (int kb = 0; kb < 4; ++kb) d = mfma16(a[kb], *(const bf16x8*)(ks + (16 * nt + l16) * 136 + 32 * kb + 8 * q4), d);
                const int j_ = 16 * nt + l16; const float Gj = sc[64 + j_];
#pragma unroll
                for (int i = 0; i < 4; ++i) { const int i_ = 16 * mt + 4 * q4 + i; Lm[i_ * 68 + j_] = (i_ > j_) ? sc[i_] * d[i] * expf(sc[64 + i_] - Gj) : 0.f; }
            }
        } else {
            const int nti = wid - 4; bf16x8 bq[4]; f32x4 d[4];
#pragma unroll
            for (int kb = 0; kb < 4; ++kb) bq[kb] = *(const bf16x8*)(qs + (16 * nti + l16) * 136 + 32 * kb + 8 * q4);
            const int i_ = 16 * nti + l16; const float Gi = sc[64 + i_];
#pragma unroll
            for (int mtj = 0; mtj < 4; ++mtj) {
                f32x4 t = {0.f, 0.f, 0.f, 0.f};
                if (mtj <= nti) {
#pragma unroll
                    for (int kb = 0; kb < 4; ++kb) t = mfma16(*(const bf16x8*)(ks + (16 * mtj + l16) * 136 + 32 * kb + 8 * q4), bq[kb], t);
#pragma unroll
                    for (int i = 0; i < 4; ++i) { const int j_ = 16 * mtj + 4 * q4 + i; t[i] = (i_ >= j_) ? t[i] * SCALE * expf(Gi - sc[64 + j_]) : 0.f; }
                }
                d[mtj] = t;
            }
            *(bf16x8*)(QKB + (size_t)item * 4096 + ((nti * 2 + 0) * 64 + lane) * 8) = pack8(d[0], d[1]);
            *(bf16x8*)(QKB + (size_t)item * 4096 + ((nti * 2 + 1) * 64 + lane) * 8) = pack8(d[2], d[3]);
        }
        __syncthreads();
        if (wid == 0) {
            float t[64]; int vz; asm volatile("v_mov_b32 %0, 0" : "=v"(vz));
            const float* Lv = Lm + vz;
#pragma unroll
            for (int i = 0; i < 64; ++i) {
                float a0 = 0.f, a1 = 0.f, a2 = 0.f, a3 = 0.f;
#pragma unroll
                for (int s4 = 0; s4 < i; s4 += 4) { const float4 l = *(const float4*)(Lv + i * 68 + s4);
                    a0 += l.x * t[s4]; if (s4 + 1 < i) a1 += l.y * t[s4 + 1]; if (s4 + 2 < i) a2 += l.z * t[s4 + 2]; if (s4 + 3 < i) a3 += l.w * t[s4 + 3]; }
                t[i] = ((i == lane) ? 1.f : 0.f) - ((a0 + a1) + (a2 + a3));
                if ((i & 3) == 3) asm volatile("" ::: "memory");
            }
#pragma unroll
            for (int i = 0; i < 64; ++i) Tb[i * 72 + lane] = f2bf(t[i]);
        } else {
            { int lz = lane; asm volatile("" : "+v"(lz)); q4 = lz >> 4; l16 = lz & 15; }
            for (int f = wid - 1; f < 32; f += 7) {
                if (f < 16) {
                    const int mt = f >> 2, kb = f & 3, row = 16 * mt + l16; const float s = SCALE * sc[128 + row];
                    const u32x2 lo = *(const u32x2*)(qs + row * 136 + 32 * kb + 4 * q4), hi = *(const u32x2*)(qs + row * 136 + 32 * kb + 16 + 4 * q4);
                    u32x4 w; w.x = pk2(bflo(lo.x) * s, bfhi(lo.x) * s); w.y = pk2(bflo(lo.y) * s, bfhi(lo.y) * s); w.z = pk2(bflo(hi.x) * s, bfhi(hi.x) * s); w.w = pk2(bflo(hi.y) * s, bfhi(hi.y) * s);
                    *(u32x4*)(QB + blk + (f * 64 + lane) * 8) = w;
                } else {
                    const int ff = f - 16, mtd = ff >> 1, kb2 = ff & 1, dk = 16 * mtd + l16; float v[8];
#pragma unroll
                    for (int j = 0; j < 8; ++j) { const int tok = 32 * kb2 + 16 * (j >> 2) + 4 * q4 + (j & 3); v[j] = bf2f(ks[tok * 136 + dk]) * sc[192 + tok]; }
                    u32x4 w; w.x = pk2(v[0], v[1]); w.y = pk2(v[2], v[3]); w.z = pk2(v[4], v[5]); w.w = pk2(v[6], v[7]);
                    *(u32x4*)(KTB + blk + (ff * 64 + lane) * 8) = w;
                }
            }
        }
        __syncthreads();
        { int lz = lane; asm volatile("" : "+v"(lz)); q4 = lz >> 4; l16 = lz & 15; }
        {
            const int nt = wid; bf16x8 bv[2]; f32x4 d[4];
#pragma unroll
            for (int kb2 = 0; kb2 < 2; ++kb2) bv[kb2] = *(const bf16x8*)(vbT + (16 * nt + l16) * 72 + 32 * kb2 + 8 * q4);
#pragma unroll
            for (int mt = 0; mt < 4; ++mt) { f32x4 t = {0.f, 0.f, 0.f, 0.f};
#pragma unroll
                for (int kb2 = 0; kb2 < 2; ++kb2) t = mfma16(*(const bf16x8*)(Tb + (16 * mt + l16) * 72 + 32 * kb2 + 8 * q4), bv[kb2], t);
                d[mt] = t; }
            *(bf16x8*)(VB + blk + nt * 1024 + lane * 16) = pack8(d[0], d[1]);
            *(bf16x8*)(VB + blk + nt * 1024 + lane * 16 + 8) = pack8(d[2], d[3]);
        }
        {
            const int mtt = wid & 3, half = wid >> 2; bf16x8 bt[2]; f32x4 d[4];
#pragma unroll
            for (int kb2 = 0; kb2 < 2; ++kb2) bt[kb2] = *(const bf16x8*)(Tb + (16 * mtt + l16) * 72 + 32 * kb2 + 8 * q4);
#pragma unroll
            for (int m4 = 0; m4 < 4; ++m4) { const int mtd = 4 * half + m4; f32x4 t = {0.f, 0.f, 0.f, 0.f};
#pragma unroll
                for (int kb2 = 0; kb2 < 2; ++kb2) t = mfma16(*(const bf16x8*)(kgT + (16 * mtd + l16) * 72 + 32 * kb2 + 8 * q4), bt[kb2], t);
                d[m4] = t; }
            *(bf16x8*)(WB + blk + ((mtt * 4 + 2 * half + 0) * 64 + lane) * 8) = pack8(d[0], d[1]);
            *(bf16x8*)(WB + blk + ((mtt * 4 + 2 * half + 1) * 64 + lane) * 8) = pack8(d[2], d[3]);
        }
        __syncthreads();
    }
}

DI void phase_scan(const Params& p) {
    if (blockIdx.x >= 16) return;
    const int tid = opaque_tid(), lane = tid & 63, nt = tid >> 6, q4 = lane >> 4, l16 = lane & 15;
    const int b = blockIdx.x >> 3, h = blockIdx.x & 7;
    const bf16_t* QB = (const bf16_t*)(p.ws + WS_QB); bf16_t* OB = (bf16_t*)(p.ws + WS_KB); const bf16_t* VB = (const bf16_t*)(p.ws + WS_VB); const bf16_t* WB = (const bf16_t*)(p.ws + WS_WB);
    const bf16_t* KTB = (const bf16_t*)(p.ws + WS_KTB); const bf16_t* QKB = (const bf16_t*)(p.ws + WS_QKB); const float* GT = (const float*)(p.ws + WS_GT);
    f32x4 S[8];
#pragma unroll
    for (int i = 0; i < 8; ++i) S[i] = (f32x4){0.f, 0.f, 0.f, 0.f};
    for (int c = 0; c < 129; ++c) {
        const int cb = (c == 0) ? 256 + b : 128 * b + c - 1, item = cb * 8 + h;
        const bf16x8* Wf = (const bf16x8*)(WB + (size_t)item * 8192) + lane; const bf16x8* Qf = (const bf16x8*)(QB + (size_t)item * 8192) + lane;
        const bf16x8* Kf = (const bf16x8*)(KTB + (size_t)item * 8192) + lane; const bf16x8* Pf = (const bf16x8*)(QKB + (size_t)item * 4096) + lane;
        const u32x4 u0 = *(const u32x4*)(VB + (size_t)item * 8192 + nt * 1024 + lane * 16), u1 = *(const u32x4*)(VB + (size_t)item * 8192 + nt * 1024 + lane * 16 + 8);
        const float gt = GT[item];
        bf16x8 Sb[4];
#pragma unroll
        for (int kb = 0; kb < 4; ++kb) Sb[kb] = pack8(S[2 * kb], S[2 * kb + 1]);
        f32x4 vn[4];
        const unsigned uw[8] = {u0.x, u0.y, u0.z, u0.w, u1.x, u1.y, u1.z, u1.w};
#pragma unroll
        for (int mt = 0; mt < 4; ++mt) { f32x4 a = {0.f, 0.f, 0.f, 0.f};
#pragma unroll
            for (int kb = 0; kb < 4; ++kb) a = mfma16(Wf[(mt * 4 + kb) * 64], Sb[kb], a);
            vn[mt][0] = bflo(uw[2 * mt]) - a[0]; vn[mt][1] = bfhi(uw[2 * mt]) - a[1]; vn[mt][2] = bflo(uw[2 * mt + 1]) - a[2]; vn[mt][3] = bfhi(uw[2 * mt + 1]) - a[3]; }
        bf16x8 Vb[2]; Vb[0] = pack8(vn[0], vn[1]); Vb[1] = pack8(vn[2], vn[3]);
#pragma unroll
        for (int mt = 0; mt < 4; ++mt) { f32x4 a = {0.f, 0.f, 0.f, 0.f};
#pragma unroll
            for (int kb = 0; kb < 4; ++kb) a = mfma16(Qf[(mt * 4 + kb) * 64], Sb[kb], a);
#pragma unroll
            for (int kb2 = 0; kb2 < 2; ++kb2) a = mfma16(Pf[(mt * 2 + kb2) * 64], Vb[kb2], a);
            bf16_t* op = OB + (size_t)(cb * 64 + 16 * mt + 4 * q4) * 1024 + h * 128 + 16 * nt + l16;
#pragma unroll
            for (int i = 0; i < 4; ++i) op[(size_t)i * 1024] = f2bf(a[i]); }
#pragma unroll
        for (int mtd = 0; mtd < 8; ++mtd) { f32x4 a = S[mtd] * gt;
#pragma unroll
            for (int kb2 = 0; kb2 < 2; ++kb2) a = mfma16(Kf[(mtd * 2 + kb2) * 64], Vb[kb2], a);
            S[mtd] = a; }
    }
}

DI void phase_combine(const Params& p, int layer, unsigned char* smem) {
    const int tid = opaque_tid(), lane = tid & 63, wid = tid >> 6, q4 = lane >> 4, l16 = lane & 15;
    bf16_t* pl = (bf16_t*)smem;
    float* rs = (float*)(smem + 66560);
    const bf16_t* OB = (const bf16_t*)(p.ws + WS_KB); const bf16_t* ZB = (const bf16_t*)(p.ws + WS_QB); const bf16_t* GA = (const bf16_t*)(p.ws + WS_VB); const bf16_t* GB = (const bf16_t*)(p.ws + WS_WB);
    const bf16_t* PB = (const bf16_t*)(p.ws + WS_QKB); bf16_t* YB = (bf16_t*)(p.ws + WS_KTB); const bf16_t* WPT = (const bf16_t*)(p.ws + WS_WPT);
    const float* hn = p.head_norm + layer * 128; const float* psc = p.pool_scale + layer * 1024;
    for (int cb = blockIdx.x; cb < 260; cb += gridDim.x) {
        if (cb >= 258) { const u32x4 z = {0u, 0u, 0u, 0u};
            for (int e = tid; e < 64 * 128; e += 512) *(u32x4*)(YB + (size_t)cb * 65536 + e * 8) = z;
            continue; }
        const bool meta = cb >= 256; const int b = meta ? cb - 256 : (cb >> 7);
#pragma unroll
        for (int rr = 0; rr < 8; ++rr) { const int t = 8 * wid + rr; const bf16_t* op = OB + (size_t)(cb * 64 + t) * 1024 + lane * 16;
            const u32x4 a = *(const u32x4*)op, c = *(const u32x4*)(op + 8);
            float ss = bflo(a.x) * bflo(a.x) + bfhi(a.x) * bfhi(a.x) + bflo(a.y) * bflo(a.y) + bfhi(a.y) * bfhi(a.y) + bflo(a.z) * bflo(a.z) + bfhi(a.z) * bfhi(a.z) + bflo(a.w) * bflo(a.w) + bfhi(a.w) * bfhi(a.w)
                     + bflo(c.x) * bflo(c.x) + bfhi(c.x) * bfhi(c.x) + bflo(c.y) * bflo(c.y) + bfhi(c.y) * bfhi(c.y) + bflo(c.z) * bflo(c.z) + bfhi(c.z) * bfhi(c.z) + bflo(c.w) * bflo(c.w) + bfhi(c.w) * bfhi(c.w);
            ss += __shfl_xor(ss, 1); ss += __shfl_xor(ss, 2); ss += __shfl_xor(ss, 4);
            if ((lane & 7) == 0) rs[t * 8 + (lane >> 3)] = rsqrtf(ss * (1.0f / 128.0f) + 1e-6f); }
        for (int it = 0; it < 8; ++it) { const int idx = tid + 512 * it, t = idx >> 6, g = (idx >> 4) & 3, c8 = idx & 15, win = 2 << g, row = cb * 64 + t;
            float acc[8], self[8];
#pragma unroll
            for (int j = 0; j < 8; ++j) { acc[j] = 0.f; self[j] = 0.f; }
            int nd, cnt;
            if (!meta) { nd = win; cnt = win; } else { const int pt = t - 48; nd = pt < 0 ? 0 : (pt + 1 < win ? pt + 1 : win); cnt = nd > 0 ? nd : 1; }
            const int im = row - 8192 * b;
            for (int d = 0; d < nd; ++d) { int pr; if (meta || im - d >= 0) pr = row - d; else pr = MMAIN + 64 * b + 64 + (im - d);
                const u32x4 v = *(const u32x4*)(PB + (size_t)pr * 512 + g * 128 + c8 * 8);
                const float f[8] = {bflo(v.x), bfhi(v.x), bflo(v.y), bfhi(v.y), bflo(v.z), bfhi(v.z), bflo(v.w), bfhi(v.w)};
#pragma unroll
                for (int j = 0; j < 8; ++j) { acc[j] += f[j]; if (d == 0) self[j] = f[j]; } }
            const float inv = 1.0f / (float)cnt; u32x4 w;
            w.x = pk2(acc[0] * inv - self[0], acc[1] * inv - self[1]); w.y = pk2(acc[2] * inv - self[2], acc[3] * inv - self[3]);
            w.z = pk2(acc[4] * inv - self[4], acc[5] * inv - self[5]); w.w = pk2(acc[6] * inv - self[6], acc[7] * inv - self[7]);
            *(u32x4*)(pl + t * 520 + g * 128 + c8 * 8) = w; }
        __syncthreads();
        { const int g = wid >> 1, colbase = 128 * wid; const bf16_t* wp = WPT + (size_t)g * 256 * 128 + (size_t)(colbase & 255) * 128;
          for (int mtc = 0; mtc < 8; ++mtc) { bf16x8 a[4];
#pragma unroll
              for (int kb = 0; kb < 4; ++kb) a[kb] = *(const bf16x8*)(wp + (16 * mtc + l16) * 128 + 32 * kb + 8 * q4);
              const int c0 = colbase + 16 * mtc + 4 * q4;
              const f32x4 hn4 = *(const f32x4*)(hn + (c0 & 127)), ps4 = *(const f32x4*)(psc + c0);
#pragma unroll
              for (int ntt = 0; ntt < 4; ++ntt) { f32x4 d = {0.f, 0.f, 0.f, 0.f};
#pragma unroll
                  for (int kb = 0; kb < 4; ++kb) d = mfma16(a[kb], *(const bf16x8*)(pl + (16 * ntt + l16) * 520 + g * 128 + 32 * kb + 8 * q4), d);
                  const int t = 16 * ntt + l16; const size_t off = (size_t)(cb * 64 + t) * 1024 + c0; u32x2 yo = {0u, 0u};
                  if (!(meta && t < 48)) {
                      const u32x2 o2 = *(const u32x2*)(OB + off), z2 = *(const u32x2*)(ZB + off), a2 = *(const u32x2*)(GA + off), b2 = *(const u32x2*)(GB + off);
                      const float rq = rs[t * 8 + wid];
                      const float ov[4] = {bflo(o2.x), bfhi(o2.x), bflo(o2.y), bfhi(o2.y)}, zv[4] = {bflo(z2.x), bfhi(z2.x), bflo(z2.y), bfhi(z2.y)};
                      const float av[4] = {bflo(a2.x), bfhi(a2.x), bflo(a2.y), bfhi(a2.y)}, bv[4] = {bflo(b2.x), bfhi(b2.x), bflo(b2.y), bfhi(b2.y)};
                      float y[4];
#pragma unroll
                      for (int i = 0; i < 4; ++i) y[i] = sigm(av[i]) * (ov[i] * rq * hn4[i] * silu(zv[i])) + sigm(bv[i]) * (d[i] * ps4[i]);
                      yo.x = pk2(y[0], y[1]); yo.y = pk2(y[2], y[3]); }
                  *(u32x2*)(YB + off) = yo; } } }
        __syncthreads();
    }
}

DI void phase_convact(const Params& p, int layer) {
    const int tid = opaque_tid();
    bf16_t* HID = (bf16_t*)(p.ws + WS_QB); const bf16_t* HALO = (const bf16_t*)(p.ws + WS_HALO);
    const float* cw = p.conv_ffn + (size_t)layer * 3 * FF2;
    if (tid >= 352) return;
    const int j0 = tid * 8;
    float wg[3][8], wv[3][8];
#pragma unroll
    for (int j = 0; j < 3; ++j)
#pragma unroll
        for (int e = 0; e < 8; ++e) { wg[j][e] = cw[j * FF2 + j0 + e]; wv[j][e] = cw[j * FF2 + DFF + j0 + e]; }
    for (int cb = blockIdx.x; cb < 258; cb += gridDim.x) {
        const bool meta = cb >= 256; const int prev = meta ? -1 : ((cb & 127) == 0 ? 256 + (cb >> 7) : cb - 1);
        float g1[8], g2[8], v1[8], v2[8];
        if (prev >= 0) { const bf16_t* hp = HALO + (size_t)prev * 2 * FF2;
            const u32x4 a = *(const u32x4*)(hp + j0), c = *(const u32x4*)(hp + DFF + j0), a1 = *(const u32x4*)(hp + FF2 + j0), c1 = *(const u32x4*)(hp + FF2 + DFF + j0);
            g2[0] = bflo(a.x); g2[1] = bfhi(a.x); g2[2] = bflo(a.y); g2[3] = bfhi(a.y); g2[4] = bflo(a.z); g2[5] = bfhi(a.z); g2[6] = bflo(a.w); g2[7] = bfhi(a.w);
            v2[0] = bflo(c.x); v2[1] = bfhi(c.x); v2[2] = bflo(c.y); v2[3] = bfhi(c.y); v2[4] = bflo(c.z); v2[5] = bfhi(c.z); v2[6] = bflo(c.w); v2[7] = bfhi(c.w);
            g1[0] = bflo(a1.x); g1[1] = bfhi(a1.x); g1[2] = bflo(a1.y); g1[3] = bfhi(a1.y); g1[4] = bflo(a1.z); g1[5] = bfhi(a1.z); g1[6] = bflo(a1.w); g1[7] = bfhi(a1.w);
            v1[0] = bflo(c1.x); v1[1] = bfhi(c1.x); v1[2] = bflo(c1.y); v1[3] = bfhi(c1.y); v1[4] = bflo(c1.z); v1[5] = bfhi(c1.z); v1[6] = bflo(c1.w); v1[7] = bfhi(c1.w);
        } else {
#pragma unroll
            for (int e = 0; e < 8; ++e) { g1[e] = 0.f; g2[e] = 0.f; v1[e] = 0.f; v2[e] = 0.f; } }
        for (int tb = meta ? 48 : 0; tb < 64; tb += 8) {
            u32x4 rg[8], rv[8];
#pragma unroll
            for (int i = 0; i < 8; ++i) { const bf16_t* hp = HID + (size_t)(cb * 64 + tb + i) * FF2 + j0; rg[i] = *(const u32x4*)hp; rv[i] = *(const u32x4*)(hp + DFF); }
#pragma unroll
            for (int i = 0; i < 8; ++i) {
                const float g0[8] = {bflo(rg[i].x), bfhi(rg[i].x), bflo(rg[i].y), bfhi(rg[i].y), bflo(rg[i].z), bfhi(rg[i].z), bflo(rg[i].w), bfhi(rg[i].w)};
                const float v0[8] = {bflo(rv[i].x), bfhi(rv[i].x), bflo(rv[i].y), bfhi(rv[i].y), bflo(rv[i].z), bfhi(rv[i].z), bflo(rv[i].w), bfhi(rv[i].w)};
                float a[8];
#pragma unroll
                for (int e = 0; e < 8; ++e) { const float cg = wg[0][e] * g2[e] + wg[1][e] * g1[e] + wg[2][e] * g0[e], cv = wv[0][e] * v2[e] + wv[1][e] * v1[e] + wv[2][e] * v0[e];
                    a[e] = silu(cg) * cv; g2[e] = g1[e]; g1[e] = g0[e]; v2[e] = v1[e]; v1[e] = v0[e]; }
                u32x4 w; w.x = pk2(a[0], a[1]); w.y = pk2(a[2], a[3]); w.z = pk2(a[4], a[5]); w.w = pk2(a[6], a[7]);
                *(u32x4*)(HID + (size_t)(cb * 64 + tb + i) * FF2 + j0) = w;
            }
        }
    }
}

__global__ void __launch_bounds__(512, 2) mega_fwd(Params p) {
    extern __shared__ __attribute__((aligned(16))) unsigned char smem[];
    cg::grid_group grid = cg::this_grid();
    PG8_LAS unsigned char* lds = (PG8_LAS unsigned char*)smem;
    bf16_t* U = (bf16_t*)(p.ws + WS_U); bf16_t* QB = (bf16_t*)(p.ws + WS_QB); bf16_t* KB = (bf16_t*)(p.ws + WS_KB); bf16_t* VB = (bf16_t*)(p.ws + WS_VB); bf16_t* WB = (bf16_t*)(p.ws + WS_WB);
    bf16_t* KTB = (bf16_t*)(p.ws + WS_KTB); bf16_t* QKB = (bf16_t*)(p.ws + WS_QKB); bf16_t* HALO = (bf16_t*)(p.ws + WS_HALO);
    bf16_t* Win = (bf16_t*)(p.ws + WS_WIN); bf16_t* Wout = (bf16_t*)(p.ws + WS_WOUT); bf16_t* Wup = (bf16_t*)(p.ws + WS_WUP); bf16_t* Wdn = (bf16_t*)(p.ws + WS_WDN);
    float* HM = (float*)(p.ws + WS_HM);
    const int G = (int)gridDim.x, c = (int)blockIdx.x;
#pragma unroll 1
    for (int layer = 0; layer < 2; ++layer) {
        phase_norm(p, layer, 0, smem); grid.sync();
        { pg8::Gemm g{U, Win, MPAD, 3072, 1024, 1024, 1024}; pg8::StaticOrder S; S.init(MPAD, 3072, G, c); EpiQKV E{QB, HALO}; pg8::gemm_phase<EpiQKV, pg8::StaticOrder>(lds, g, S, E); }
        grid.sync();
        phase_p3(p, layer, smem); grid.sync();
        phase_scan(p); grid.sync();
        { pg8::Gemm g{U, Win + (size_t)3072 * 1024, MPAD, 3584, 1024, 1024, 1024}; pg8::StaticOrder S; S.init(MPAD, 3584, G, c); EpiZPG E{QB}; pg8::gemm_phase<EpiZPG, pg8::StaticOrder>(lds, g, S, E); }
        grid.sync();
        phase_combine(p, layer, smem); grid.sync();
        { pg8::Gemm g{KTB, Wout, MPAD, 1024, 1024, 1024, 1024}; pg8::StaticOrder S; S.init(MPAD, 1024, G, c); EpiRes E{p.out, HM}; pg8::gemm_phase<EpiRes, pg8::StaticOrder>(lds, g, S, E); }
        grid.sync();
        phase_norm(p, layer, 1, smem); grid.sync();
        { pg8::Gemm g{U, Wup, MPAD, FF2, 1024, 1024, 1024}; pg8::StaticOrder S; S.init(MPAD, FF2, G, c); EpiHid E{QB, HALO}; pg8::gemm_phase<EpiHid, pg8::StaticOrder>(lds, g, S, E); }
        grid.sync();
        phase_convact(p, layer); grid.sync();
        { pg8::Gemm g{QB, Wdn, MPAD, 1024, DFF, FF2, DFF}; pg8::StaticOrder S; S.init(MPAD, 1024, G, c); EpiRes E{p.out, HM}; pg8::gemm_phase<EpiRes, pg8::StaticOrder>(lds, g, S, E); }
        grid.sync();
    }
    phase_final(p);
}

extern "C" void kernel_launch(void* const* d_in, const int* in_sizes, int n_in, void* d_out, int out_size, void* d_ws, size_t ws_size, hipStream_t stream) {
    static int grid_blocks = 0;
    if (!grid_blocks) {
        int dev = 0, cus = 0, per_cu = 0;
        hipGetDevice(&dev);
        hipDeviceGetAttribute(&cus, hipDeviceAttributeMultiprocessorCount, dev);
        if (hipFuncSetAttribute((const void*)mega_fwd, hipFuncAttributeMaxDynamicSharedMemorySize, LDS_BYTES) != hipSuccess) fprintf(stderr, "hipFuncSetAttribute failed\n");
        hipOccupancyMaxActiveBlocksPerMultiprocessor(&per_cu, (const void*)mega_fwd, 512, LDS_BYTES);
        if (per_cu < 1) { fprintf(stderr, "occupancy query reports %d blocks/CU\n", per_cu); per_cu = 1; }
        if (per_cu > 1) per_cu = 1;
        grid_blocks = cus * per_cu;
        if (ws_size < WS_END) fprintf(stderr, "workspace too small: %zu < %zu\n", ws_size, (size_t)WS_END);
    }
    Params p{};
    p.x = (const float*)d_in[0]; p.meta = (const float*)d_in[1]; p.norm_mix = (const float*)d_in[2]; p.w_in = (const float*)d_in[3]; p.conv_qkv = (const float*)d_in[4];
    p.a_log = (const float*)d_in[5]; p.dt_bias = (const float*)d_in[6]; p.head_norm = (const float*)d_in[7]; p.w_pool = (const float*)d_in[8]; p.pool_scale = (const float*)d_in[9];
    p.w_out = (const float*)d_in[10]; p.norm_ffn = (const float*)d_in[11]; p.w_up = (const float*)d_in[12]; p.conv_ffn = (const float*)d_in[13]; p.w_down = (const float*)d_in[14]; p.norm_final = (const float*)d_in[15];
    p.out = (float*)d_out; p.ws = (unsigned char*)d_ws;
    void* args[] = {&p};
    hipError_t e = hipLaunchCooperativeKernel((const void*)mega_fwd, dim3(grid_blocks), dim3(512), args, LDS_BYTES, stream);
    if (e != hipSuccess) fprintf(stderr, "cooperative launch failed: %s (grid %d)\n", hipGetErrorString(e), grid_blocks);
}
```

```cpp
#include <hip/hip_runtime.h>
#include <hip/hip_cooperative_groups.h>
#include <cstdio>
namespace cg = cooperative_groups;
#include <hip/hip_runtime.h>
namespace pg8 {
#define PG8_LAS __attribute__((address_space(3)))
typedef unsigned short bf16_t;
typedef short bf16x8 __attribute__((ext_vector_type(8)));
typedef float f32x4 __attribute__((ext_vector_type(4)));
typedef unsigned u32x4 __attribute__((ext_vector_type(4)));
constexpr int BM = 256, BK = 64, HALF = 128, HTB = HALF * BK * 2  , STAGE_BYTES = 8 * HTB, NXCD = 8, WGM = 8;

__host__ __device__ __forceinline__ int lds_byte(int r, int c) { const int st = (r >> 4) * 2 + (c >> 5), rr = r & 15, cc = c & 31, ob = rr * 64 + cc * 2; return st * 1024 + (ob ^ (((ob >> 9) & 1) << 5)); }
__host__ __device__ __forceinline__ void stage_rc(int b, int& R, int& C) { const int st = b / 1024, sb = b % 1024, swz = sb ^ (((sb >> 9) & 1) << 5); R = (st >> 1) * 16 + swz / 64; C = (st & 1) * 32 + (swz % 64) / 2; }
__host__ __device__ __forceinline__ int perm32(int rho) { const int n = rho >> 4, i = rho & 15; return 8 * (i >> 2) + 4 * n + (i & 3); }

struct Unit { int pm, pn; };
struct Gemm { const bf16_t* A; const bf16_t* Bt; int M, N, K, lda, ldb; };

struct StaticOrder {
    int nM, nN, nwg, G, c;
    __host__ __device__ void init(int M, int N, int G_, int c_) { nM = M / BM; nN = N / BM; nwg = nM * nN; G = G_; c = c_; }
    __host__ __device__ bool next(int i, Unit& u) const {
        const long L = (long)i * G + c; if (L >= nwg) return false;
        int wgid = (int)L; { const int q = nwg / NXCD, r = nwg % NXCD, xcd = wgid % NXCD, off = wgid / NXCD; wgid = (xcd < r ? xcd * (q + 1) : r * (q + 1) + (xcd - r) * q) + off; }
        const int nig = WGM * nN, gid = wgid / nig, fm = gid * WGM, gsz = (nM - fm) < WGM ? (nM - fm) : WGM;
        u.pm = fm + ((wgid % nig) % gsz); u.pn = (wgid % nig) / gsz; return true;
    }
    __device__ __forceinline__ void a_ready(const Unit&) const {}
    __device__ __forceinline__ void done(const Unit&) const {}
};

template <class Epi, class Sched>
__device__ __forceinline__ void gemm_phase(PG8_LAS unsigned char* lds, const Gemm g, const Sched& S, const Epi& E) {
    int tid = threadIdx.x; asm volatile("" : "+v"(tid)); const int wid = __builtin_amdgcn_readfirstlane(tid >> 6), lane = tid & 63, wr = wid >> 2, wc = wid & 3, fr = lane & 15, fq = lane >> 4;
    const int K = g.K, nt = K / BK;
    unsigned voffA[2], voffB[2];
#pragma unroll
    for (int i = 0; i < 2; ++i) { int R, C; stage_rc(tid * 16 + i * 8192, R, C); const int Rb = Epi::PERM ? ((R & ~31) + perm32(R & 31)) : R;
        voffA[i] = (unsigned)(R * g.lda + C) * 2u; voffB[i] = (unsigned)(Rb * g.ldb + C) * 2u; }
    const size_t kstep = (size_t)(BK * 2);
    const size_t hstepA = (size_t)HALF * g.lda * 2, hstepB = (size_t)HALF * g.ldb * 2;
    const size_t tstepA = 2 * hstepA, tstepB = 2 * hstepB;
    const unsigned ldsw = (unsigned)wid * 1024u;
    const int aoff = lds_byte(wr * 64 + fr, fq * 8), boff = lds_byte(wc * 32 + fr, fq * 8);
#define PG8_SA(b, h) (((b) * 2 + (h)) * HTB)
#define PG8_SB(b, h) ((4 + (b) * 2 + (h)) * HTB)
#define PG8_STAGE(bufoff, gbase, voff) do { _Pragma("unroll") for (int _i = 0; _i < 2; ++_i) \
        __builtin_amdgcn_global_load_lds((const unsigned*)((const char*)(gbase) + (voff)[_i]), (PG8_LAS unsigned*)(lds + (bufoff) + ldsw + _i * 8192), 16, 0, 0); } while (0)
#define PG8_LDA(dst, b, h) do { _Pragma("unroll") for (int m = 0; m < 4; ++m) _Pragma("unroll") for (int k = 0; k < 2; ++k) dst[m][k] = *(const PG8_LAS bf16x8*)(lds + PG8_SA(b, h) + aoff + m * 2048 + k * 1024); } while (0)
#define PG8_LDB(dst, b, h) do { _Pragma("unroll") for (int n = 0; n < 2; ++n) _Pragma("unroll") for (int k = 0; k < 2; ++k) dst[n][k] = *(const PG8_LAS bf16x8*)(lds + PG8_SB(b, h) + boff + n * 2048 + k * 1024); } while (0)
#define PG8_MMA(ai, bj, At, Bt) do { __builtin_amdgcn_s_setprio(1); _Pragma("unroll") for (int m = 0; m < 4; ++m) _Pragma("unroll") for (int n = 0; n < 2; ++n) _Pragma("unroll") for (int k = 0; k < 2; ++k) \
        acc[ai][bj][m][n] = __builtin_amdgcn_mfma_f32_16x16x32_bf16(Bt[n][k], At[m][k], acc[ai][bj][m][n], 0, 0, 0); __builtin_amdgcn_s_setprio(0); } while (0)
#define PG8_WAIT_V(n) asm volatile("s_waitcnt vmcnt(" #n ")" ::: "memory")
#define PG8_WAIT_L(n) asm volatile("s_waitcnt lgkmcnt(" #n ")" ::: "memory")
#define PG8_BAR __builtin_amdgcn_s_barrier()
#define PG8_SCHED __builtin_amdgcn_sched_barrier(0)
    Unit cur, nxt; int ui = 0;
    if (!S.next(0, cur)) return;
    f32x4 acc[2][2][4][2];
#pragma unroll
    for (int a = 0; a < 2; ++a)
#pragma unroll
        for (int b = 0; b < 2; ++b)
#pragma unroll
            for (int m = 0; m < 4; ++m)
#pragma unroll
                for (int n = 0; n < 2; ++n) acc[a][b][m][n] = (f32x4){0.f, 0.f, 0.f, 0.f};
    bf16x8 At[4][2], B0[2][2], B1[2][2];
    const char* cA = (const char*)g.A + (size_t)cur.pm * tstepA; const char* cB = (const char*)g.Bt + (size_t)cur.pn * tstepB;
    S.a_ready(cur);
    PG8_STAGE(PG8_SB(0, 0), cB, voffB); PG8_STAGE(PG8_SA(0, 0), cA, voffA); PG8_STAGE(PG8_SB(0, 1), cB + hstepB, voffB); PG8_STAGE(PG8_SA(0, 1), cA + hstepA, voffA);
    if (wr == 1) PG8_BAR;
    PG8_WAIT_V(4); PG8_BAR;
    PG8_STAGE(PG8_SB(1, 0), cB + kstep, voffB); PG8_STAGE(PG8_SA(1, 0), cA + kstep, voffA); PG8_STAGE(PG8_SB(1, 1), cB + hstepB + kstep, voffB);
    PG8_WAIT_V(6); PG8_BAR;
    for (;;) {
        const bool has_next = S.next(ui + 1, nxt);
        const char* nA = has_next ? (const char*)g.A + (size_t)nxt.pm * tstepA : cA; const char* nB = has_next ? (const char*)g.Bt + (size_t)nxt.pn * tstepB : cB;
        for (int t = 0; t < nt; t += 2) {
            const bool last = (t == nt - 2);
            const char* a1 = cA + (size_t)(t + 1) * kstep;
            const char* a2 = last ? nA : cA + (size_t)(t + 2) * kstep; const char* b2 = last ? nB : cB + (size_t)(t + 2) * kstep;
            const char* a3 = a2 + kstep; const char* b3 = b2 + kstep;
            if (last && has_next) S.a_ready(nxt);
            PG8_LDB(B0, 0, 0); PG8_SCHED; PG8_LDA(At, 0, 0); PG8_STAGE(PG8_SA(1, 1), a1 + hstepA, voffA);
            PG8_WAIT_L(8); PG8_BAR; PG8_WAIT_L(0); PG8_MMA(0, 0, At, B0); PG8_BAR; PG8_SCHED;
            PG8_LDB(B1, 0, 1); PG8_STAGE(PG8_SB(0, 0), b2, voffB);
            PG8_BAR; PG8_WAIT_L(0); PG8_MMA(0, 1, At, B1); PG8_BAR;
            PG8_LDA(At, 0, 1); PG8_STAGE(PG8_SA(0, 0), a2, voffA);
            PG8_BAR; PG8_WAIT_L(0); PG8_MMA(1, 0, At, B0); PG8_BAR; PG8_SCHED;
            PG8_STAGE(PG8_SB(0, 1), b2 + hstepB, voffB);
            PG8_WAIT_V(6); PG8_BAR; PG8_MMA(1, 1, At, B1); PG8_BAR;
            PG8_LDB(B0, 1, 0); PG8_SCHED; PG8_LDA(At, 1, 0); PG8_STAGE(PG8_SA(0, 1), a2 + hstepA, voffA);
            PG8_WAIT_L(8); PG8_BAR; PG8_WAIT_L(0); PG8_MMA(0, 0, At, B0); PG8_BAR; PG8_SCHED;
            PG8_LDB(B1, 1, 1); PG8_STAGE(PG8_SB(1, 0), b3, voffB);
            PG8_BAR; PG8_WAIT_L(0); PG8_MMA(0, 1, At, B1); PG8_BAR;
            PG8_LDA(At, 1, 1); PG8_STAGE(PG8_SA(1, 0), a3, voffA);
            PG8_BAR; PG8_WAIT_L(0); PG8_MMA(1, 0, At, B0); PG8_BAR; PG8_SCHED;
            PG8_STAGE(PG8_SB(1, 1), b3 + hstepB, voffB);
            PG8_WAIT_V(6); PG8_BAR; PG8_MMA(1, 1, At, B1); PG8_BAR;
        }
        if constexpr (!Epi::AFTER_DRAIN) { E(acc, cur, wr, wc, fr, fq); S.done(cur); }
        if (!has_next) break;
#pragma unroll
        for (int a = 0; a < 2; ++a)
#pragma unroll
            for (int b = 0; b < 2; ++b)
#pragma unroll
                for (int m = 0; m < 4; ++m)
#pragma unroll
                    for (int n = 0; n < 2; ++n) acc[a][b][m][n] = (f32x4){0.f, 0.f, 0.f, 0.f};
        cur = nxt; cA = nA; cB = nB; ++ui;
    }
    PG8_WAIT_V(0);
    if (wr == 0) PG8_BAR;
    PG8_BAR;
    if constexpr (Epi::AFTER_DRAIN) { E.fused(acc, cur, wr, wc, fr, fq, lds, wid, lane); S.done(cur); }
#undef PG8_SA
#undef PG8_SB
#undef PG8_STAGE
#undef PG8_LDA
#undef PG8_LDB
#undef PG8_MMA
#undef PG8_WAIT_V
#undef PG8_WAIT_L
#undef PG8_BAR
#undef PG8_SCHED
}
}


using pg8::bf16_t; using pg8::bf16x8; using pg8::f32x4; using pg8::u32x4;
typedef unsigned u32x2 __attribute__((ext_vector_type(2)));
typedef __bf16 bf16x2_t __attribute__((ext_vector_type(2)));
typedef float f32x2 __attribute__((ext_vector_type(2)));
#define DI __device__ __forceinline__

constexpr int MMAIN = 16384, MPAD = 16640, IN_DIM = 6672, DFF = 2816, FF2 = 5632;
constexpr size_t SZ_ACT = (size_t)MPAD * 1024 * 2;
constexpr size_t WS_WIN = 0;
constexpr size_t WS_WOUT = WS_WIN + (size_t)6656 * 1024 * 2;
constexpr size_t WS_WUP = WS_WOUT + (size_t)1024 * 1024 * 2;
constexpr size_t WS_WDN = WS_WUP + (size_t)5632 * 1024 * 2;
constexpr size_t WS_WPT = WS_WDN + (size_t)1024 * 2816 * 2;
constexpr size_t WS_U = WS_WPT + (size_t)4 * 256 * 128 * 2;
constexpr size_t WS_QB = WS_U + SZ_ACT;
constexpr size_t WS_KB = WS_QB + SZ_ACT;
constexpr size_t WS_VB = WS_KB + SZ_ACT;
constexpr size_t WS_WB = WS_VB + SZ_ACT;
constexpr size_t WS_KTB = WS_WB + SZ_ACT;
constexpr size_t WS_QKB = WS_KTB + SZ_ACT;
constexpr size_t WS_HALO = WS_QKB + (size_t)260 * 8 * 4096 * 2;
constexpr size_t WS_BA = WS_HALO + (size_t)260 * 2 * 5632 * 2;
constexpr size_t WS_HM = WS_BA + (size_t)MPAD * 16 * 4;
constexpr size_t WS_GT = WS_HM + (size_t)256 * 1024 * 4;
constexpr size_t WS_END = WS_GT + (size_t)260 * 8 * 4;
static_assert(WS_QKB + (size_t)260 * 8 * 4096 * 2 - WS_QB == (size_t)MPAD * FF2 * 2, "hid overlay");
static_assert(WS_END <= 268435456ull, "workspace");
constexpr int LDS_BYTES = 131072;

struct Params {
    const float *x, *meta, *norm_mix, *w_in, *conv_qkv, *a_log, *dt_bias, *head_norm, *w_pool, *pool_scale, *w_out, *norm_ffn, *w_up, *conv_ffn, *w_down, *norm_final;
    float* out; unsigned char* ws;
};

DI int opaque_tid() { int t = threadIdx.x; asm volatile("" : "+v"(t)); return t; }
DI unsigned pk2(float a, float b) { f32x2 v = {a, b}; bf16x2_t r = __builtin_convertvector(v, bf16x2_t); return __builtin_bit_cast(unsigned, r); }
DI bf16_t f2bf(float a) { return (bf16_t)(pk2(a, 0.f) & 0xffffu); }
DI float bflo(unsigned w) { return __uint_as_float(w << 16); }
DI float bfhi(unsigned w) { return __uint_as_float(w & 0xffff0000u); }
DI float bf2f(bf16_t b) { return __uint_as_float(((unsigned)b) << 16); }
DI bf16x8 pack8(f32x4 a, f32x4 b) { u32x4 w; w.x = pk2(a[0], a[1]); w.y = pk2(a[2], a[3]); w.z = pk2(b[0], b[1]); w.w = pk2(b[2], b[3]); return __builtin_bit_cast(bf16x8, w); }
DI f32x4 mfma16(bf16x8 a, bf16x8 b, f32x4 c) { return __builtin_amdgcn_mfma_f32_16x16x32_bf16(a, b, c, 0, 0, 0); }
DI float sigm(float x) { return 1.0f / (1.0f + __expf(-x)); }
DI float silu(float x) { return x / (1.0f + __expf(-x)); }
DI float wsum(float v) { v += __shfl_xor(v, 32); v += __shfl_xor(v, 16); v += __shfl_xor(v, 8); v += __shfl_xor(v, 4); v += __shfl_xor(v, 2); v += __shfl_xor(v, 1); return v; }
DI float* hrow(const Params& p, int r) { return r < MMAIN ? p.out + (size_t)r * 1024 : (float*)(p.ws + WS_HM) + (size_t)(r - MMAIN) * 1024; }

struct EpiQKV {
    static constexpr bool PERM = true, AFTER_DRAIN = false;
    bf16_t *Q, *halo;
    DI void operator()(const f32x4 (&acc)[2][2][4][2], const pg8::Unit& u, int wr, int wc, int fr, int fq) const {
        const int which = u.pn >> 2; bf16_t* base = Q + (size_t)which * (SZ_ACT / 2);
#pragma unroll
        for (int ai = 0; ai < 2; ++ai)
#pragma unroll
            for (int m = 0; m < 4; ++m) {
                const int cb = u.pm * 4 + ai * 2 + wr, rr = m * 16 + fr;
#pragma unroll
                for (int bj = 0; bj < 2; ++bj) {
                    const int head = (u.pn & 3) * 2 + bj, cc = wc * 32 + 8 * fq;
                    const f32x4 v0 = acc[ai][bj][m][0], v1 = acc[ai][bj][m][1];
                    u32x4 w; w.x = pk2(v0[0], v0[1]); w.y = pk2(v0[2], v0[3]); w.z = pk2(v1[0], v1[1]); w.w = pk2(v1[2], v1[3]);
                    *(u32x4*)(base + ((size_t)(cb * 8 + head) * 64 + rr) * 128 + cc) = w;
                    if (m == 3 && fr >= 13) *(u32x4*)(halo + ((size_t)cb * 3 + (rr - 61)) * 3072 + u.pn * 256 + bj * 128 + cc) = w;
                }
            }
    }
};
struct EpiZPG {
    static constexpr bool PERM = true, AFTER_DRAIN = false;
    bf16_t *QB0;
    DI void operator()(const f32x4 (&acc)[2][2][4][2], const pg8::Unit& u, int wr, int wc, int fr, int fq) const {
        const int ge4 = u.pn >= 4, ge6 = u.pn >= 6, ge10 = u.pn >= 10, idx = ge4 + ge6 + ge10, is1 = (idx == 1);
        const int slot = idx + 4 * is1, ld = 1024 >> is1, c0 = (u.pn - (4 * ge4 + 2 * ge6 + 4 * ge10)) * 256;
        bf16_t* base = QB0 + (size_t)slot * (SZ_ACT / 2);
#pragma unroll
        for (int ai = 0; ai < 2; ++ai)
#pragma unroll
            for (int m = 0; m < 4; ++m) {
                const int row = u.pm * 256 + ai * 128 + wr * 64 + m * 16 + fr;
#pragma unroll
                for (int bj = 0; bj < 2; ++bj) {
                    const f32x4 v0 = acc[ai][bj][m][0], v1 = acc[ai][bj][m][1];
                    u32x4 w; w.x = pk2(v0[0], v0[1]); w.y = pk2(v0[2], v0[3]); w.z = pk2(v1[0], v1[1]); w.w = pk2(v1[2], v1[3]);
                    *(u32x4*)(base + (size_t)row * ld + c0 + bj * 128 + wc * 32 + 8 * fq) = w;
                }
            }
    }
};
struct EpiHid {
    static constexpr bool PERM = true, AFTER_DRAIN = false;
    bf16_t *H, *halo;
    DI void operator()(const f32x4 (&acc)[2][2][4][2], const pg8::Unit& u, int wr, int wc, int fr, int fq) const {
#pragma unroll
        for (int ai = 0; ai < 2; ++ai)
#pragma unroll
            for (int m = 0; m < 4; ++m) {
                const int cb = u.pm * 4 + ai * 2 + wr, rr = m * 16 + fr, row = cb * 64 + rr;
#pragma unroll
                for (int bj = 0; bj < 2; ++bj) {
                    const int col = u.pn * 256 + bj * 128 + wc * 32 + 8 * fq;
                    const f32x4 v0 = acc[ai][bj][m][0], v1 = acc[ai][bj][m][1];
                    u32x4 w; w.x = pk2(v0[0], v0[1]); w.y = pk2(v0[2], v0[3]); w.z = pk2(v1[0], v1[1]); w.w = pk2(v1[2], v1[3]);
                    *(u32x4*)(H + (size_t)row * FF2 + col) = w;
                    if (m == 3 && fr >= 14) *(u32x4*)(halo + ((size_t)cb * 2 + (rr - 62)) * FF2 + col) = w;
                }
            }
    }
};
struct EpiRes {
    static constexpr bool PERM = false, AFTER_DRAIN = false;
    float *hmain, *hmeta;
    DI void operator()(const f32x4 (&acc)[2][2][4][2], const pg8::Unit& u, int wr, int wc, int fr, int fq) const {
        const int col0 = u.pn * 256 + wc * 32 + 4 * fq;
#pragma unroll
        for (int ai = 0; ai < 2; ++ai)
#pragma unroll
            for (int m = 0; m < 4; ++m) {
                const int row = u.pm * 256 + ai * 128 + wr * 64 + m * 16 + fr;
                float* rp = (row < MMAIN ? hmain + (size_t)row * 1024 : hmeta + (size_t)(row - MMAIN) * 1024) + col0;
#pragma unroll
                for (int bj = 0; bj < 2; ++bj)
#pragma unroll
                    for (int n = 0; n < 2; ++n) { f32x4* q = (f32x4*)(rp + bj * 128 + n * 16); *q = *q + acc[ai][bj][m][n]; }
            }
    }
};

DI void cvt_tile(const float* W, int ldw, int k0, int n0src, bf16_t* Bt, int ldb, int n0dst, float* tl, int tid) {
#pragma unroll
    for (int i = 0; i < 2; ++i) { const int kk = (tid >> 4) + 32 * i, c4 = (tid & 15) * 4;
        const float4 v = *(const float4*)(W + (size_t)(k0 + kk) * ldw + n0src + c4);
        tl[kk * 65 + c4 + 0] = v.x; tl[kk * 65 + c4 + 1] = v.y; tl[kk * 65 + c4 + 2] = v.z; tl[kk * 65 + c4 + 3] = v.w; }
    __syncthreads();
    { const int nn = tid >> 3, k8 = (tid & 7) * 8; float f[8];
#pragma unroll
      for (int j = 0; j < 8; ++j) f[j] = tl[(k8 + j) * 65 + nn];
      u32x4 w; w.x = pk2(f[0], f[1]); w.y = pk2(f[2], f[3]); w.z = pk2(f[4], f[5]); w.w = pk2(f[6], f[7]);
      *(u32x4*)(Bt + (size_t)(n0dst + nn) * ldb + k0 + k8) = w; }
    __syncthreads();
}
DI void convert_weights(const Params& p, int layer, unsigned char* smem, int tid) {
    float* tl = (float*)smem;
    const float* win = p.w_in + (size_t)layer * 1024 * IN_DIM; const float* wout = p.w_out + (size_t)layer * 1024 * 1024;
    const float* wup = p.w_up + (size_t)layer * 1024 * FF2; const float* wdn = p.w_down + (size_t)layer * DFF * 1024; const float* wpl = p.w_pool + (size_t)layer * 4 * 128 * 256;
    bf16_t* Win = (bf16_t*)(p.ws + WS_WIN); bf16_t* Wout = (bf16_t*)(p.ws + WS_WOUT); bf16_t* Wup = (bf16_t*)(p.ws + WS_WUP); bf16_t* Wdn = (bf16_t*)(p.ws + WS_WDN); bf16_t* Wpt = (bf16_t*)(p.ws + WS_WPT);
    for (int t = blockIdx.x; t < 4064; t += gridDim.x) {
        if (t < 1664) { const int kt = t / 104, nt = t % 104, n0 = nt * 64; cvt_tile(win, IN_DIM, kt * 64, n0 + (n0 >= 4096 ? 16 : 0), Win, 1024, n0, tl, tid); }
        else if (t < 1920) { const int q = t - 1664; cvt_tile(wout, 1024, (q >> 4) * 64, (q & 15) * 64, Wout, 1024, (q & 15) * 64, tl, tid); }
        else if (t < 3328) { const int q = t - 1920, kt = q / 88, nt = q % 88; cvt_tile(wup, FF2, kt * 64, nt * 64, Wup, 1024, nt * 64, tl, tid); }
        else if (t < 4032) { const int q = t - 3328, kt = q >> 4, nt = q & 15; cvt_tile(wdn, 1024, kt * 64, nt * 64, Wdn, DFF, nt * 64, tl, tid); }
        else { const int q = t - 4032, g = q >> 3, kt = (q >> 2) & 1, nt = q & 3; cvt_tile(wpl + (size_t)g * 128 * 256, 256, kt * 64, nt * 64, Wpt + (size_t)g * 256 * 128, 128, nt * 64, tl, tid); }
    }
}

DI void phase_norm(const Params& p, int layer, int which, unsigned char* smem) {
    const int tid = opaque_tid(), lane = tid & 63, wid = tid >> 6;
    float* wba = (float*)smem;
    float* BA = (float*)(p.ws + WS_BA); bf16_t* U = (bf16_t*)(p.ws + WS_U);
    if (which == 0) {
        convert_weights(p, layer, smem, tid);
        __syncthreads();
        const float* win = p.w_in + (size_t)layer * 1024 * IN_DIM;
        for (int e = tid; e < 4096; e += 512) { const int k = e >> 2, j4 = (e & 3) * 4; *(float4*)(wba + k * 20 + j4) = *(const float4*)(win + (size_t)k * IN_DIM + 4096 + j4); }
        __syncthreads();
    }
    const float* gain = (which == 0 ? p.norm_mix : p.norm_ffn) + layer * 1024;
    const bool init = (layer == 0 && which == 0);
    for (int r = blockIdx.x * 8 + wid; r < MPAD; r += gridDim.x * 8) {
        const float* src;
        if (init) { if (r < MMAIN) src = p.x + (size_t)r * 1024; else { const int rm = r - MMAIN, s = rm & 63; src = (rm < 128 && s >= 48) ? p.meta + (size_t)(s - 48) * 1024 : nullptr; } }
        else src = hrow(p, r);
        float v[16]; float ss = 0.f;
#pragma unroll
        for (int i = 0; i < 16; ++i) { v[i] = src ? src[lane + 64 * i] : 0.f; ss += v[i] * v[i]; }
        if (init) { float* hr = hrow(p, r);
#pragma unroll
            for (int i = 0; i < 16; ++i) hr[lane + 64 * i] = v[i]; }
        ss = wsum(ss);
        const float rstd = rsqrtf(ss * (1.0f / 1024.0f) + 1e-6f);
#pragma unroll
        for (int i = 0; i < 16; ++i) { v[i] = v[i] * rstd * gain[lane + 64 * i]; U[(size_t)r * 1024 + lane + 64 * i] = f2bf(v[i]); }
        if (which == 0) {
            float acc[16]; int vz = 0; asm volatile("" : "+v"(vz)); const float* wbz = wba + vz;
#pragma unroll
            for (int j = 0; j < 16; ++j) acc[j] = 0.f;
#pragma unroll
            for (int i = 0; i < 16; ++i) { const float* wr_ = wbz + (lane + 64 * i) * 20;
#pragma unroll
                for (int j4 = 0; j4 < 4; ++j4) { const float4 w = *(const float4*)(wr_ + 4 * j4);
                    acc[4 * j4 + 0] += v[i] * w.x; acc[4 * j4 + 1] += v[i] * w.y; acc[4 * j4 + 2] += v[i] * w.z; acc[4 * j4 + 3] += v[i] * w.w; } }
            float o = 0.f;
#pragma unroll
            for (int j = 0; j < 16; ++j) { const float s = wsum(acc[j]); o = (lane == j) ? s : o; }
            if (lane < 16) BA[(size_t)r * 16 + lane] = o;
        }
    }
}
DI void phase_final(const Params& p) {
    const int tid = opaque_tid(), lane = tid & 63, wid = tid >> 6;
    for (int r = blockIdx.x * 8 + wid; r < MMAIN; r += gridDim.x * 8) {
        float* hr = p.out + (size_t)r * 1024; float v[16]; float ss = 0.f;
#pragma unroll
        for (int i = 0; i < 16; ++i) { v[i] = hr[lane + 64 * i]; ss += v[i] * v[i]; }
        ss = wsum(ss); const float rstd = rsqrtf(ss * (1.0f / 1024.0f) + 1e-6f);
#pragma unroll
        for (int i = 0; i < 16; ++i) hr[lane + 64 * i] = v[i] * rstd * p.norm_final[lane + 64 * i];
    }
}

DI void phase_p3(const Params& p, int layer, unsigned char* smem) {
    const int tid = opaque_tid(), lane = tid & 63, wid = tid >> 6; int q4 = lane >> 4, l16 = lane & 15;
    bf16_t* qs = (bf16_t*)(smem); bf16_t* ks = (bf16_t*)(smem + 17408); bf16_t* vbT = (bf16_t*)(smem + 34816); bf16_t* kgT = (bf16_t*)(smem + 53248);
    float* Lm = (float*)(smem + 71680); bf16_t* Tb = (bf16_t*)(smem + 89088); float* sc = (float*)(smem + 98304);
    bf16_t* QB = (bf16_t*)(p.ws + WS_QB); bf16_t* KB = (bf16_t*)(p.ws + WS_KB); bf16_t* VB = (bf16_t*)(p.ws + WS_VB); bf16_t* WB = (bf16_t*)(p.ws + WS_WB);
    bf16_t* KTB = (bf16_t*)(p.ws + WS_KTB); bf16_t* QKB = (bf16_t*)(p.ws + WS_QKB); const bf16_t* HALO = (const bf16_t*)(p.ws + WS_HALO);
    const float* BA = (const float*)(p.ws + WS_BA); float* GT = (float*)(p.ws + WS_GT);
    const float* cw = p.conv_qkv + (size_t)layer * 4 * 3072;
    const float SCALE = 0.08838834764831845f;
    for (int item = blockIdx.x; item < 258 * 8; item += gridDim.x) {
        const int cb = item >> 3, h = item & 7;
        int b, c; if (cb < 256) { b = cb >> 7; c = (cb & 127) + 1; } else { b = cb - 256; c = 0; }
        const int prev_cb = (c == 0) ? -1 : (c == 1 ? 256 + b : cb - 1);
        const size_t blk = (size_t)item * 8192;
        if (wid == 0) {
            const int row = cb * 64 + lane;
            const float braw = BA[(size_t)row * 16 + h], araw = BA[(size_t)row * 16 + 8 + h];
            float beta = 1.0f / (1.0f + expf(-braw));
            const float xx = araw + p.dt_bias[layer * 8 + h]; const float sp = xx > 20.f ? xx : log1pf(expf(xx));
            float g = -expf(p.a_log[layer * 8 + h]) * sp;
            if (c == 0 && lane < 48) { g = 0.f; beta = 0.f; }
            float G = g;
#pragma unroll
            for (int off = 1; off < 64; off <<= 1) { const float t = __shfl_up(G, off); if (lane >= off) G += t; }
            const float Gl = __shfl(G, 63);
            sc[lane] = beta; sc[64 + lane] = G; sc[128 + lane] = expf(G); sc[192 + lane] = expf(Gl - G);
            if (lane == 63) GT[item] = expf(G);
        }
        __syncthreads();
        {
            const int c0 = 2 * lane, r0 = 8 * wid;
            float wq[4][2], wk[4][2], wv[4][2];
#pragma unroll
            for (int j = 0; j < 4; ++j)
#pragma unroll
                for (int e = 0; e < 2; ++e) { wq[j][e] = cw[j * 3072 + h * 128 + c0 + e]; wk[j][e] = cw[j * 3072 + 1024 + h * 128 + c0 + e]; wv[j][e] = cw[j * 3072 + 2048 + h * 128 + c0 + e]; }
            unsigned xq[11], xk[11], xv[11];
#pragma unroll
            for (int i = 0; i < 11; ++i) { const int rr = r0 - 3 + i;
                if (rr >= 0) { xq[i] = *(const unsigned*)(QB + blk + rr * 128 + c0); xk[i] = *(const unsigned*)(KB + blk + rr * 128 + c0); xv[i] = *(const unsigned*)(VB + blk + rr * 128 + c0); }
                else if (prev_cb >= 0) { const bf16_t* hp = HALO + ((size_t)prev_cb * 3 + (rr + 3)) * 3072 + h * 128 + c0; xq[i] = *(const unsigned*)hp; xk[i] = *(const unsigned*)(hp + 1024); xv[i] = *(const unsigned*)(hp + 2048); }
                else { xq[i] = 0u; xk[i] = 0u; xv[i] = 0u; } }
#pragma unroll
            for (int i = 0; i < 8; ++i) {
                const int r = r0 + i;
                float cq0 = 0.f, cq1 = 0.f, ck0 = 0.f, ck1 = 0.f, cv0 = 0.f, cv1 = 0.f;
#pragma unroll
                for (int j = 0; j < 4; ++j) { cq0 += wq[j][0] * bflo(xq[i + j]); cq1 += wq[j][1] * bfhi(xq[i + j]); ck0 += wk[j][0] * bflo(xk[i + j]); ck1 += wk[j][1] * bfhi(xk[i + j]);
                    cv0 += wv[j][0] * bflo(xv[i + j]); cv1 += wv[j][1] * bfhi(xv[i + j]); }
                cq0 = silu(cq0); cq1 = silu(cq1); ck0 = silu(ck0); ck1 = silu(ck1); cv0 = silu(cv0); cv1 = silu(cv1);
                const float sq = wsum(cq0 * cq0 + cq1 * cq1), sk = wsum(ck0 * ck0 + ck1 * ck1);
                const float rq = rsqrtf(sq + 1e-6f), rk = rsqrtf(sk + 1e-6f);
                cq0 *= rq; cq1 *= rq; ck0 *= rk; ck1 *= rk;
                const float beta = sc[r], eg = sc[128 + r];
                *(unsigned*)(qs + r * 136 + c0) = pk2(cq0, cq1); *(unsigned*)(ks + r * 136 + c0) = pk2(ck0, ck1);
                vbT[(c0 + 0) * 72 + r] = f2bf(cv0 * beta); vbT[(c0 + 1) * 72 + r] = f2bf(cv1 * beta);
                kgT[(c0 + 0) * 72 + r] = f2bf(ck0 * beta * eg); kgT[(c0 + 1) * 72 + r] = f2bf(ck1 * beta * eg);
            }
        }
        __syncthreads();
        { int lz = lane; asm volatile("" : "+v"(lz)); q4 = lz >> 4; l16 = lz & 15; }
        if (wid < 4) {
            const int mt = wid; bf16x8 a[4];
#pragma unroll
            for (int kb = 0; kb < 4; ++kb) a[kb] = *(const bf16x8*)(ks + (16 * mt + l16) * 136 + 32 * kb + 8 * q4);
            for (int nt = 0; nt <= mt; ++nt) {
                f32x4 d = {0.f, 0.f, 0.f, 0.f};
#pragma unroll
                for (int kb = 0; kb < 4; ++kb) d = mfma16(a[kb], *(const bf16x8*)(ks + (16 * nt + l16) * 136 + 32 * kb + 8 * q4), d);
                const int j_ = 16 * nt + l16; const float Gj = sc[64 + j_];
#pragma unroll
                for (int i = 0; i < 4; ++i) { const int i_ = 16 * mt + 4 * q4 + i; Lm[i_ * 68 + j_] = (i_ > j_) ? sc[i_] * d[i] * expf(sc[64 + i_] - Gj) : 0.f; }
            }
        } else {
            const int nti = wid - 4; bf16x8 bq[4]; f32x4 d[4];
#pragma unroll
            for (int kb = 0; kb < 4; ++kb) bq[kb] = *(const bf16x8*)(qs + (16 * nti + l16) * 136 + 32 * kb + 8 * q4);
            const int i_ = 16 * nti + l16; const float Gi = sc[64 + i_];
#pragma unroll
            for (int mtj = 0; mtj < 4; ++mtj) {
                f32x4 t = {0.f, 0.f, 0.f, 0.f};
                if (mtj <= nti) {
#pragma unroll
                    for (int kb = 0; kb < 4; ++kb) t = mfma16(*(const bf16x8*)(ks + (16 * mtj + l16) * 136 + 32 * kb + 8 * q4), bq[kb], t);
#pragma unroll
                    for (int i = 0; i < 4; ++i) { const int j_ = 16 * mtj + 4 * q4 + i; t[i] = (i_ >= j_) ? t[i] * SCALE * expf(Gi - sc[64 + j_]) : 0.f; }
                }
                d[mtj] = t;
            }
            *(bf16x8*)(QKB + (size_t)item * 4096 + ((nti * 2 + 0) * 64 + lane) * 8) = pack8(d[0], d[1]);
            *(bf16x8*)(QKB + (size_t)item * 4096 + ((nti * 2 + 1) * 64 + lane) * 8) = pack8(d[2], d[3]);
        }
        __syncthreads();
        if (wid == 0) {
            float t[64]; int vz; asm volatile("v_mov_b32 %0, 0" : "=v"(vz));
            const float* Lv = Lm + vz;
#pragma unroll
            for (int i = 0; i < 64; ++i) {
                float a0 = 0.f, a1 = 0.f, a2 = 0.f, a3 = 0.f;
#pragma unroll
                for (int s4 = 0; s4 < i; s4 += 4) { const float4 l = *(const float4*)(Lv + i * 68 + s4);
                    a0 += l.x * t[s4]; if (s4 + 1 < i) a1 += l.y * t[s4 + 1]; if (s4 + 2 < i) a2 += l.z * t[s4 + 2]; if (s4 + 3 < i) a3 += l.w * t[s4 + 3]; }
                t[i] = ((i == lane) ? 1.f : 0.f) - ((a0 + a1) + (a2 + a3));
                if ((i & 3) == 3) asm volatile("" ::: "memory");
            }
#pragma unroll
            for (int i = 0; i < 64; ++i) Tb[i * 72 + lane] = f2bf(t[i]);
        } else {
            { int lz = lane; asm volatile("" : "+v"(lz)); q4 = lz >> 4; l16 = lz & 15; }
            for (int f = wid - 1; f < 32; f += 7) {
                if (f < 16) {
                    const int mt = f >> 2, kb = f & 3, row = 16 * mt + l16; const float s = SCALE * sc[128 + row];
                    const u32x2 lo = *(const u32x2*)(qs + row * 136 + 32 * kb + 4 * q4), hi = *(const u32x2*)(qs + row * 136 + 32 * kb + 16 + 4 * q4);
                    u32x4 w; w.x = pk2(bflo(lo.x) * s, bfhi(lo.x) * s); w.y = pk2(bflo(lo.y) * s, bfhi(lo.y) * s); w.z = pk2(bflo(hi.x) * s, bfhi(hi.x) * s); w.w = pk2(bflo(hi.y) * s, bfhi(hi.y) * s);
                    *(u32x4*)(QB + blk + (f * 64 + lane) * 8) = w;
                } else {
                    const int ff = f - 16, mtd = ff >> 1, kb2 = ff & 1, dk = 16 * mtd + l16; float v[8];
#pragma unroll
                    for (int j = 0; j < 8; ++j) { const int tok = 32 * kb2 + 16 * (j >> 2) + 4 * q4 + (j & 3); v[j] = bf2f(ks[tok * 136 + dk]) * sc[192 + tok]; }
                    u32x4 w; w.x = pk2(v[0], v[1]); w.y = pk2(v[2], v[3]); w.z = pk2(v[4], v[5]); w.w = pk2(v[6], v[7]);
                    *(u32x4*)(KTB + blk + (ff * 64 + lane) * 8) = w;
                }
            }
        }
        __syncthreads();
        { int lz = lane; asm volatile("" : "+v"(lz)); q4 = lz >> 4; l16 = lz & 15; }
        {
            const int nt = wid; bf16x8 bv[2]; f32x4 d[4];
#pragma unroll
            for (int kb2 = 0; kb2 < 2; ++kb2) bv[kb2] = *(const bf16x8*)(vbT + (16 * nt + l16) * 72 + 32 * kb2 + 8 * q4);
#pragma unroll
            for (int mt = 0; mt < 4; ++mt) { f32x4 t = {0.f, 0.f, 0.f, 0.f};
#pragma unroll
                for (int kb2 = 0; kb2 < 2; ++kb2) t = mfma16(*(const bf16x8*)(Tb + (16 * mt + l16) * 72 + 32 * kb2 + 8 * q4), bv[kb2], t);
                d[mt] = t; }
            *(bf16x8*)(VB + blk + nt * 1024 + lane * 16) = pack8(d[0], d[1]);
            *(bf16x8*)(VB + blk + nt * 1024 + lane * 16 + 8) = pack8(d[2], d[3]);
        }
        {
            const int mtt = wid & 3, half = wid >> 2; bf16x8 bt[2]; f32x4 d[4];
#pragma unroll
            for (int kb2 = 0; kb2 < 2; ++kb2) bt[kb2] = *(const bf16x8*)(Tb + (16 * mtt + l16) * 72 + 32 * kb2 + 8 * q4);
#pragma unroll
            for (int m4 = 0; m4 < 4; ++m4) { const int mtd = 4 * half + m4; f32x4 t = {0.f, 0.f, 0.f, 0.f};
#pragma unroll
                for (int kb2 = 0; kb2 < 2; ++kb2) t = mfma16(*(const bf16x8*)(kgT + (16 * mtd + l16) * 72 + 32 * kb2 + 8 * q4), bt[kb2], t);
                d[m4] = t; }
            *(bf16x8*)(WB + blk + ((mtt * 4 + 2 * half + 0) * 64 + lane) * 8) = pack8(d[0], d[1]);
            *(bf16x8*)(WB + blk + ((mtt * 4 + 2 * half + 1) * 64 + lane) * 8) = pack8(d[2], d[3]);
        }
        __syncthreads();
    }
}

DI void scan_step(const unsigned char* buf, f32x4 (&S)[8], const u32x4 u0, const u32x4 u1, const float gt, bf16_t* op, int lane) {
    const bf16x8* Wf = (const bf16x8*)(buf) + lane; const bf16x8* Qf = (const bf16x8*)(buf + 16384) + lane;
    const bf16x8* Kf = (const bf16x8*)(buf + 32768) + lane; const bf16x8* Pf = (const bf16x8*)(buf + 49152) + lane;
    bf16x8 Sb[4];
#pragma unroll
    for (int kb = 0; kb < 4; ++kb) Sb[kb] = pack8(S[2 * kb], S[2 * kb + 1]);
    f32x4 vn[4];
    const unsigned uw[8] = {u0.x, u0.y, u0.z, u0.w, u1.x, u1.y, u1.z, u1.w};
#pragma unroll
    for (int mt = 0; mt < 4; ++mt) { f32x4 a = {0.f, 0.f, 0.f, 0.f};
#pragma unroll
        for (int kb = 0; kb < 4; ++kb) a = mfma16(Wf[(mt * 4 + kb) * 64], Sb[kb], a);
        vn[mt][0] = bflo(uw[2 * mt]) - a[0]; vn[mt][1] = bfhi(uw[2 * mt]) - a[1]; vn[mt][2] = bflo(uw[2 * mt + 1]) - a[2]; vn[mt][3] = bfhi(uw[2 * mt + 1]) - a[3]; }
    bf16x8 Vb[2]; Vb[0] = pack8(vn[0], vn[1]); Vb[1] = pack8(vn[2], vn[3]);
#pragma unroll
    for (int mt = 0; mt < 4; ++mt) { f32x4 a = {0.f, 0.f, 0.f, 0.f};
#pragma unroll
        for (int kb = 0; kb < 4; ++kb) a = mfma16(Qf[(mt * 4 + kb) * 64], Sb[kb], a);
#pragma unroll
        for (int kb2 = 0; kb2 < 2; ++kb2) a = mfma16(Pf[(mt * 2 + kb2) * 64], Vb[kb2], a);
#pragma unroll
        for (int i = 0; i < 4; ++i) op[(size_t)(16 * mt + i) * 1024] = f2bf(a[i]); }
#pragma unroll
    for (int mtd = 0; mtd < 8; ++mtd) { f32x4 a = S[mtd] * gt;
#pragma unroll
        for (int kb2 = 0; kb2 < 2; ++kb2) a = mfma16(Kf[(mtd * 2 + kb2) * 64], Vb[kb2], a);
        S[mtd] = a; }
}
#define SC_BAR() do { asm volatile("s_waitcnt lgkmcnt(0)" ::: "memory"); __builtin_amdgcn_s_barrier(); asm volatile("" ::: "memory"); } while (0)
DI void phase_scan(const Params& p, unsigned char* smem) {
    if (blockIdx.x >= 128) return;
    const int tid = opaque_tid(), lane = tid & 63, wid = __builtin_amdgcn_readfirstlane(tid >> 6), q4 = lane >> 4, l16 = lane & 15;
    const int bx = blockIdx.x & 7, by = blockIdx.x >> 3, nt = by & 7, g = bx + 8 * (by >> 3), b = g >> 3, h = g & 7;
#define SC_CB(c) (((c) == 0) ? 256 + b : 128 * b + (c) - 1)
    if (wid != 0) {
        const int r = wid - 1, rr = r >> 1, slot = 3 * (rr == 0) + 4 * (rr == 2) + 5 * (rr == 3), isq = (rr == 3);
        const unsigned char* sb = p.ws + WS_QB + (size_t)slot * SZ_ACT + (size_t)(r & 1) * 8192 + lane * 16;
        const size_t istride = (size_t)16384 >> isq;
        unsigned char* d0 = smem + r * 8192 + lane * 16; unsigned char* d1 = d0 + 57344;
        u32x4 ra[8], rb[8];
#define SC_LOAD(dst, c) do { const int cc_ = (c) < 129 ? (c) : 128; const unsigned char* s_ = sb + (size_t)(SC_CB(cc_) * 8 + h) * istride; _Pragma("unroll") for (int i_ = 0; i_ < 8; ++i_) dst[i_] = *(const u32x4*)(s_ + i_ * 1024); } while (0)
#define SC_WRITE(dptr, src) do { _Pragma("unroll") for (int i_ = 0; i_ < 8; ++i_) *(u32x4*)((dptr) + i_ * 1024) = src[i_]; } while (0)
        SC_LOAD(ra, 0); SC_WRITE(d0, ra); SC_LOAD(ra, 1); SC_LOAD(rb, 2);
        SC_BAR();
        for (int c = 0; c < 128; c += 2) {
            SC_WRITE(d1, ra); SC_LOAD(ra, c + 3); SC_BAR();
            SC_WRITE(d0, rb); SC_LOAD(rb, c + 4); SC_BAR();
        }
        SC_BAR();
    } else {
        const bf16_t* VB = (const bf16_t*)(p.ws + WS_VB); const float* GT = (const float*)(p.ws + WS_GT);
        bf16_t* OB = (bf16_t*)(p.ws + WS_KB) + (size_t)(4 * q4) * 1024 + h * 128 + 16 * nt + l16;
        f32x4 S[8];
#pragma unroll
        for (int i = 0; i < 8; ++i) S[i] = (f32x4){0.f, 0.f, 0.f, 0.f};
        u32x4 ua0, ua1, ub0, ub1; float gta, gtb;
#define SC_LOADU(x0, x1, gtx, c) do { const int cc_ = (c) < 129 ? (c) : 128; const int it_ = SC_CB(cc_) * 8 + h; const bf16_t* s_ = VB + (size_t)it_ * 8192 + nt * 1024 + lane * 16; x0 = *(const u32x4*)s_; x1 = *(const u32x4*)(s_ + 8); gtx = GT[it_]; } while (0)
        SC_LOADU(ua0, ua1, gta, 0); SC_LOADU(ub0, ub1, gtb, 1);
        SC_BAR();
        for (int c = 0; c < 128; c += 2) {
            scan_step(smem, S, ua0, ua1, gta, OB + (size_t)(SC_CB(c) * 64) * 1024, lane);
            SC_LOADU(ua0, ua1, gta, c + 2); SC_BAR();
            scan_step(smem + 57344, S, ub0, ub1, gtb, OB + (size_t)(SC_CB(c + 1) * 64) * 1024, lane);
            SC_LOADU(ub0, ub1, gtb, c + 3); SC_BAR();
        }
        scan_step(smem, S, ua0, ua1, gta, OB + (size_t)(SC_CB(128) * 64) * 1024, lane);
        SC_BAR();
    }
#undef SC_LOAD
#undef SC_WRITE
#undef SC_LOADU
#undef SC_CB
}

DI void phase_combine(const Params& p, int layer, unsigned char* smem) {
    const int tid = opaque_tid(), lane = tid & 63, wid = tid >> 6, q4 = lane >> 4, l16 = lane & 15;
    bf16_t* pl = (bf16_t*)smem;
    float* rs = (float*)(smem + 66560);
    const bf16_t* OB = (const bf16_t*)(p.ws + WS_KB); const bf16_t* ZB = (const bf16_t*)(p.ws + WS_QB); const bf16_t* GA = (const bf16_t*)(p.ws + WS_VB); const bf16_t* GB = (const bf16_t*)(p.ws + WS_WB);
    const bf16_t* PB = (const bf16_t*)(p.ws + WS_QKB); bf16_t* YB = (bf16_t*)(p.ws + WS_KTB); const bf16_t* WPT = (const bf16_t*)(p.ws + WS_WPT);
    const float* hn = p.head_norm + layer * 128; const float* psc = p.pool_scale + layer * 1024;
    for (int cb = blockIdx.x; cb < 260; cb += gridDim.x) {
        if (cb >= 258) { const u32x4 z = {0u, 0u, 0u, 0u};
            for (int e = tid; e < 64 * 128; e += 512) *(u32x4*)(YB + (size_t)cb * 65536 + e * 8) = z;
            continue; }
        const bool meta = cb >= 256; const int b = meta ? cb - 256 : (cb >> 7);
#pragma unroll
        for (int rr = 0; rr < 8; ++rr) { const int t = 8 * wid + rr; const bf16_t* op = OB + (size_t)(cb * 64 + t) * 1024 + lane * 16;
            const u32x4 a = *(const u32x4*)op, c = *(const u32x4*)(op + 8);
            float ss = bflo(a.x) * bflo(a.x) + bfhi(a.x) * bfhi(a.x) + bflo(a.y) * bflo(a.y) + bfhi(a.y) * bfhi(a.y) + bflo(a.z) * bflo(a.z) + bfhi(a.z) * bfhi(a.z) + bflo(a.w) * bflo(a.w) + bfhi(a.w) * bfhi(a.w)
                     + bflo(c.x) * bflo(c.x) + bfhi(c.x) * bfhi(c.x) + bflo(c.y) * bflo(c.y) + bfhi(c.y) * bfhi(c.y) + bflo(c.z) * bflo(c.z) + bfhi(c.z) * bfhi(c.z) + bflo(c.w) * bflo(c.w) + bfhi(c.w) * bfhi(c.w);
            ss += __shfl_xor(ss, 1); ss += __shfl_xor(ss, 2); ss += __shfl_xor(ss, 4);
            if ((lane & 7) == 0) rs[t * 8 + (lane >> 3)] = rsqrtf(ss * (1.0f / 128.0f) + 1e-6f); }
        for (int it = 0; it < 8; ++it) { const int idx = tid + 512 * it, t = idx >> 6, g = (idx >> 4) & 3, c8 = idx & 15, win = 2 << g, row = cb * 64 + t;
            float acc[8], self[8];
#pragma unroll
            for (int j = 0; j < 8; ++j) { acc[j] = 0.f; self[j] = 0.f; }
            int nd, cnt;
            if (!meta) { nd = win; cnt = win; } else { const int pt = t - 48; nd = pt < 0 ? 0 : (pt + 1 < win ? pt + 1 : win); cnt = nd > 0 ? nd : 1; }
            const int im = row - 8192 * b;
            for (int d = 0; d < nd; ++d) { int pr; if (meta || im - d >= 0) pr = row - d; else pr = MMAIN + 64 * b + 64 + (im - d);
                const u32x4 v = *(const u32x4*)(PB + (size_t)pr * 512 + g * 128 + c8 * 8);
                const float f[8] = {bflo(v.x), bfhi(v.x), bflo(v.y), bfhi(v.y), bflo(v.z), bfhi(v.z), bflo(v.w), bfhi(v.w)};
#pragma unroll
                for (int j = 0; j < 8; ++j) { acc[j] += f[j]; if (d == 0) self[j] = f[j]; } }
            const float inv = 1.0f / (float)cnt; u32x4 w;
            w.x = pk2(acc[0] * inv - self[0], acc[1] * inv - self[1]); w.y = pk2(acc[2] * inv - self[2], acc[3] * inv - self[3]);
            w.z = pk2(acc[4] * inv - self[4], acc[5] * inv - self[5]); w.w = pk2(acc[6] * inv - self[6], acc[7] * inv - self[7]);
            *(u32x4*)(pl + t * 520 + g * 128 + c8 * 8) = w; }
        __syncthreads();
        { const int g = wid >> 1, colbase = 128 * wid; const bf16_t* wp = WPT + (size_t)g * 256 * 128 + (size_t)(colbase & 255) * 128;
          for (int mtc = 0; mtc < 8; ++mtc) { bf16x8 a[4];
#pragma unroll
              for (int kb = 0; kb < 4; ++kb) a[kb] = *(const bf16x8*)(wp + (16 * mtc + l16) * 128 + 32 * kb + 8 * q4);
              const int c0 = colbase + 16 * mtc + 4 * q4;
              const f32x4 hn4 = *(const f32x4*)(hn + (c0 & 127)), ps4 = *(const f32x4*)(psc + c0);
#pragma unroll
              for (int ntt = 0; ntt < 4; ++ntt) { f32x4 d = {0.f, 0.f, 0.f, 0.f};
#pragma unroll
                  for (int kb = 0; kb < 4; ++kb) d = mfma16(a[kb], *(const bf16x8*)(pl + (16 * ntt + l16) * 520 + g * 128 + 32 * kb + 8 * q4), d);
                  const int t = 16 * ntt + l16; const size_t off = (size_t)(cb * 64 + t) * 1024 + c0; u32x2 yo = {0u, 0u};
                  if (!(meta && t < 48)) {
                      const u32x2 o2 = *(const u32x2*)(OB + off), z2 = *(const u32x2*)(ZB + off), a2 = *(const u32x2*)(GA + off), b2 = *(const u32x2*)(GB + off);
                      const float rq = rs[t * 8 + wid];
                      const float ov[4] = {bflo(o2.x), bfhi(o2.x), bflo(o2.y), bfhi(o2.y)}, zv[4] = {bflo(z2.x), bfhi(z2.x), bflo(z2.y), bfhi(z2.y)};
                      const float av[4] = {bflo(a2.x), bfhi(a2.x), bflo(a2.y), bfhi(a2.y)}, bv[4] = {bflo(b2.x), bfhi(b2.x), bflo(b2.y), bfhi(b2.y)};
                      float y[4];
#pragma unroll
                      for (int i = 0; i < 4; ++i) y[i] = sigm(av[i]) * (ov[i] * rq * hn4[i] * silu(zv[i])) + sigm(bv[i]) * (d[i] * ps4[i]);
                      yo.x = pk2(y[0], y[1]); yo.y = pk2(y[2], y[3]); }
                  *(u32x2*)(YB + off) = yo; } } }
        __syncthreads();
    }
}

DI void phase_convact(const Params& p, int layer) {
    const int tid = opaque_tid();
    bf16_t* HID = (bf16_t*)(p.ws + WS_QB); const bf16_t* HALO = (const bf16_t*)(p.ws + WS_HALO);
    const float* cw = p.conv_ffn + (size_t)layer * 3 * FF2;
    if (tid >= 352) return;
    const int j0 = tid * 8;
    float wg[3][8], wv[3][8];
#pragma unroll
    for (int j = 0; j < 3; ++j)
#pragma unroll
        for (int e = 0; e < 8; ++e) { wg[j][e] = cw[j * FF2 + j0 + e]; wv[j][e] = cw[j * FF2 + DFF + j0 + e]; }
    for (int cb = blockIdx.x; cb < 258; cb += gridDim.x) {
        const bool meta = cb >= 256; const int prev = meta ? -1 : ((cb & 127) == 0 ? 256 + (cb >> 7) : cb - 1);
        float g1[8], g2[8], v1[8], v2[8];
        if (prev >= 0) { const bf16_t* hp = HALO + (size_t)prev * 2 * FF2;
            const u32x4 a = *(const u32x4*)(hp + j0), c = *(const u32x4*)(hp + DFF + j0), a1 = *(const u32x4*)(hp + FF2 + j0), c1 = *(const u32x4*)(hp + FF2 + DFF + j0);
            g2[0] = bflo(a.x); g2[1] = bfhi(a.x); g2[2] = bflo(a.y); g2[3] = bfhi(a.y); g2[4] = bflo(a.z); g2[5] = bfhi(a.z); g2[6] = bflo(a.w); g2[7] = bfhi(a.w);
            v2[0] = bflo(c.x); v2[1] = bfhi(c.x); v2[2] = bflo(c.y); v2[3] = bfhi(c.y); v2[4] = bflo(c.z); v2[5] = bfhi(c.z); v2[6] = bflo(c.w); v2[7] = bfhi(c.w);
            g1[0] = bflo(a1.x); g1[1] = bfhi(a1.x); g1[2] = bflo(a1.y); g1[3] = bfhi(a1.y); g1[4] = bflo(a1.z); g1[5] = bfhi(a1.z); g1[6] = bflo(a1.w); g1[7] = bfhi(a1.w);
            v1[0] = bflo(c1.x); v1[1] = bfhi(c1.x); v1[2] = bflo(c1.y); v1[3] = bfhi(c1.y); v1[4] = bflo(c1.z); v1[5] = bfhi(c1.z); v1[6] = bflo(c1.w); v1[7] = bfhi(c1.w);
        } else {
#pragma unroll
            for (int e = 0; e < 8; ++e) { g1[e] = 0.f; g2[e] = 0.f; v1[e] = 0.f; v2[e] = 0.f; } }
        for (int tb = meta ? 48 : 0; tb < 64; tb += 8) {
            u32x4 rg[8], rv[8];
#pragma unroll
            for (int i = 0; i < 8; ++i) { const bf16_t* hp = HID + (size_t)(cb * 64 + tb + i) * FF2 + j0; rg[i] = *(const u32x4*)hp; rv[i] = *(const u32x4*)(hp + DFF); }
#pragma unroll
            for (int i = 0; i < 8; ++i) {
                const float g0[8] = {bflo(rg[i].x), bfhi(rg[i].x), bflo(rg[i].y), bfhi(rg[i].y), bflo(rg[i].z), bfhi(rg[i].z), bflo(rg[i].w), bfhi(rg[i].w)};
                const float v0[8] = {bflo(rv[i].x), bfhi(rv[i].x), bflo(rv[i].y), bfhi(rv[i].y), bflo(rv[i].z), bfhi(rv[i].z), bflo(rv[i].w), bfhi(rv[i].w)};
                float a[8];
#pragma unroll
                for (int e = 0; e < 8; ++e) { const float cg = wg[0][e] * g2[e] + wg[1][e] * g1[e] + wg[2][e] * g0[e], cv = wv[0][e] * v2[e] + wv[1][e] * v1[e] + wv[2][e] * v0[e];
                    a[e] = silu(cg) * cv; g2[e] = g1[e]; g1[e] = g0[e]; v2[e] = v1[e]; v1[e] = v0[e]; }
                u32x4 w; w.x = pk2(a[0], a[1]); w.y = pk2(a[2], a[3]); w.z = pk2(a[4], a[5]); w.w = pk2(a[6], a[7]);
                *(u32x4*)(HID + (size_t)(cb * 64 + tb + i) * FF2 + j0) = w;
            }
        }
    }
}

__global__ void __launch_bounds__(512, 2) mega_fwd(Params p) {
    extern __shared__ __attribute__((aligned(16))) unsigned char smem[];
    cg::grid_group grid = cg::this_grid();
    PG8_LAS unsigned char* lds = (PG8_LAS unsigned char*)smem;
    bf16_t* U = (bf16_t*)(p.ws + WS_U); bf16_t* QB = (bf16_t*)(p.ws + WS_QB); bf16_t* KB = (bf16_t*)(p.ws + WS_KB); bf16_t* VB = (bf16_t*)(p.ws + WS_VB); bf16_t* WB = (bf16_t*)(p.ws + WS_WB);
    bf16_t* KTB = (bf16_t*)(p.ws + WS_KTB); bf16_t* QKB = (bf16_t*)(p.ws + WS_QKB); bf16_t* HALO = (bf16_t*)(p.ws + WS_HALO);
    bf16_t* Win = (bf16_t*)(p.ws + WS_WIN); bf16_t* Wout = (bf16_t*)(p.ws + WS_WOUT); bf16_t* Wup = (bf16_t*)(p.ws + WS_WUP); bf16_t* Wdn = (bf16_t*)(p.ws + WS_WDN);
    float* HM = (float*)(p.ws + WS_HM);
    const int G = (int)gridDim.x, c = (int)blockIdx.x;
#pragma unroll 1
    for (int layer = 0; layer < 2; ++layer) {
        phase_norm(p, layer, 0, smem); grid.sync();
        { pg8::Gemm g{U, Win, MPAD, 3072, 1024, 1024, 1024}; pg8::StaticOrder S; S.init(MPAD, 3072, G, c); EpiQKV E{QB, HALO}; pg8::gemm_phase<EpiQKV, pg8::StaticOrder>(lds, g, S, E); }
        grid.sync();
        phase_p3(p, layer, smem); grid.sync();
        phase_scan(p, smem); grid.sync();
        { pg8::Gemm g{U, Win + (size_t)3072 * 1024, MPAD, 3584, 1024, 1024, 1024}; pg8::StaticOrder S; S.init(MPAD, 3584, G, c); EpiZPG E{QB}; pg8::gemm_phase<EpiZPG, pg8::StaticOrder>(lds, g, S, E); }
        grid.sync();
        phase_combine(p, layer, smem); grid.sync();
        { pg8::Gemm g{KTB, Wout, MPAD, 1024, 1024, 1024, 1024}; pg8::StaticOrder S; S.init(MPAD, 1024, G, c); EpiRes E{p.out, HM}; pg8::gemm_phase<EpiRes, pg8::StaticOrder>(lds, g, S, E); }
        grid.sync();
        phase_norm(p, layer, 1, smem); grid.sync();
        { pg8::Gemm g{U, Wup, MPAD, FF2, 1024, 1024, 1024}; pg8::StaticOrder S; S.init(MPAD, FF2, G, c); EpiHid E{QB, HALO}; pg8::gemm_phase<EpiHid, pg8::StaticOrder>(lds, g, S, E); }
        grid.sync();
        phase_convact(p, layer); grid.sync();
        { pg8::Gemm g{QB, Wdn, MPAD, 1024, DFF, FF2, DFF}; pg8::StaticOrder S; S.init(MPAD, 1024, G, c); EpiRes E{p.out, HM}; pg8::gemm_phase<EpiRes, pg8::StaticOrder>(lds, g, S, E); }
        grid.sync();
    }
    phase_final(p);
}

extern "C" void kernel_launch(void* const* d_in, const int* in_sizes, int n_in, void* d_out, int out_size, void* d_ws, size_t ws_size, hipStream_t stream) {
    static int grid_blocks = 0;
    if (!grid_blocks) {
        int dev = 0, cus = 0, per_cu = 0;
        hipGetDevice(&dev);
        hipDeviceGetAttribute(&cus, hipDeviceAttributeMultiprocessorCount, dev);
        if (hipFuncSetAttribute((const void*)mega_fwd, hipFuncAttributeMaxDynamicSharedMemorySize, LDS_BYTES) != hipSuccess) fprintf(stderr, "hipFuncSetAttribute failed\n");
        hipOccupancyMaxActiveBlocksPerMultiprocessor(&per_cu, (const void*)mega_fwd, 512, LDS_BYTES);
        if (per_cu < 1) { fprintf(stderr, "occupancy query reports %d blocks/CU\n", per_cu); per_cu = 1; }
        if (per_cu > 1) per_cu = 1;
        grid_blocks = cus * per_cu;
        if (ws_size < WS_END) fprintf(stderr, "workspace too small: %zu < %zu\n", ws_size, (size_t)WS_END);
    }
    Params p{};
    p.x = (const float*)d_in[0]; p.meta = (const float*)d_in[1]; p.norm_mix = (const float*)d_in[2]; p.w_in = (const float*)d_in[3]; p.conv_qkv = (const float*)d_in[4];
    p.a_log = (const float*)d_in[5]; p.dt_bias = (const float*)d_in[6]; p.head_norm = (const float*)d_in[7]; p.w_pool = (const float*)d_in[8]; p.pool_scale = (const float*)d_in[9];
    p.w_out = (const float*)d_in[10]; p.norm_ffn = (const float*)d_in[11]; p.w_up = (const float*)d_in[12]; p.conv_ffn = (const float*)d_in[13]; p.w_down = (const float*)d_in[14]; p.norm_final = (const float*)d_in[15];
    p.out = (float*)d_out; p.ws = (unsigned char*)d_ws;
    void* args[] = {&p};
    hipError_t e = hipLaunchCooperativeKernel((const void*)mega_fwd, dim3(grid_blocks), dim3(512), args, LDS_BYTES, stream);
    if (e != hipSuccess) fprintf(stderr, "cooperative launch failed: %s (grid %d)\n", hipGetErrorString(e), grid_blocks);
}
```

```cpp
#include <hip/hip_runtime.h>
#include <hip/hip_cooperative_groups.h>
#include <cstdio>
namespace cg = cooperative_groups;
#ifndef PROBE
#define PROBE 0
#endif
#include <hip/hip_runtime.h>
namespace pg8 {
#define PG8_LAS __attribute__((address_space(3)))
typedef unsigned short bf16_t;
typedef short bf16x8 __attribute__((ext_vector_type(8)));
typedef float f32x4 __attribute__((ext_vector_type(4)));
typedef unsigned u32x4 __attribute__((ext_vector_type(4)));
constexpr int BM = 256, BK = 64, HALF = 128, HTB = HALF * BK * 2  , STAGE_BYTES = 8 * HTB, NXCD = 8, WGM = 8;

__host__ __device__ __forceinline__ int lds_byte(int r, int c) { const int st = (r >> 4) * 2 + (c >> 5), rr = r & 15, cc = c & 31, ob = rr * 64 + cc * 2; return st * 1024 + (ob ^ (((ob >> 9) & 1) << 5)); }
__host__ __device__ __forceinline__ void stage_rc(int b, int& R, int& C) { const int st = b / 1024, sb = b % 1024, swz = sb ^ (((sb >> 9) & 1) << 5); R = (st >> 1) * 16 + swz / 64; C = (st & 1) * 32 + (swz % 64) / 2; }
__host__ __device__ __forceinline__ int perm32(int rho) { const int n = rho >> 4, i = rho & 15; return 8 * (i >> 2) + 4 * n + (i & 3); }

struct Unit { int pm, pn; };
struct Gemm { const bf16_t* A; const bf16_t* Bt; int M, N, K, lda, ldb; };

struct StaticOrder {
    int nM, nN, nwg, G, c;
    __host__ __device__ void init(int M, int N, int G_, int c_) { nM = M / BM; nN = N / BM; nwg = nM * nN; G = G_; c = c_; }
    __host__ __device__ bool next(int i, Unit& u) const {
        const long L = (long)i * G + c; if (L >= nwg) return false;
        int wgid = (int)L; { const int q = nwg / NXCD, r = nwg % NXCD, xcd = wgid % NXCD, off = wgid / NXCD; wgid = (xcd < r ? xcd * (q + 1) : r * (q + 1) + (xcd - r) * q) + off; }
        const int nig = WGM * nN, gid = wgid / nig, fm = gid * WGM, gsz = (nM - fm) < WGM ? (nM - fm) : WGM;
        u.pm = fm + ((wgid % nig) % gsz); u.pn = (wgid % nig) / gsz; return true;
    }
    __device__ __forceinline__ void a_ready(const Unit&) const {}
    __device__ __forceinline__ void done(const Unit&) const {}
};

template <class Epi, class Sched>
__device__ __forceinline__ void gemm_phase(PG8_LAS unsigned char* lds, const Gemm g, const Sched& S, const Epi& E, int tid_in) {
    int tid = tid_in; asm volatile("" : "+v"(tid)); const int wid = __builtin_amdgcn_readfirstlane(tid >> 6), lane = tid & 63, wr = wid >> 2, wc = wid & 3, fr = lane & 15, fq = lane >> 4;
    const int K = g.K, nt = K / BK;
    unsigned voffA[2], voffB[2];
#pragma unroll
    for (int i = 0; i < 2; ++i) { int R, C; stage_rc(tid * 16 + i * 8192, R, C); const int Rb = Epi::PERM ? ((R & ~31) + perm32(R & 31)) : R;
        voffA[i] = (unsigned)(R * g.lda + C) * 2u; voffB[i] = (unsigned)(Rb * g.ldb + C) * 2u; }
    const size_t kstep = (size_t)(BK * 2);
    const size_t hstepA = (size_t)HALF * g.lda * 2, hstepB = (size_t)HALF * g.ldb * 2;
    const size_t tstepA = 2 * hstepA, tstepB = 2 * hstepB;
    const unsigned ldsw = (unsigned)wid * 1024u;
    const int aoff = lds_byte(wr * 64 + fr, fq * 8), boff = lds_byte(wc * 32 + fr, fq * 8);
#define PG8_SA(b, h) (((b) * 2 + (h)) * HTB)
#define PG8_SB(b, h) ((4 + (b) * 2 + (h)) * HTB)
#define PG8_STAGE(bufoff, gbase, voff) do { _Pragma("unroll") for (int _i = 0; _i < 2; ++_i) \
        __builtin_amdgcn_global_load_lds((const unsigned*)((const char*)(gbase) + (voff)[_i]), (PG8_LAS unsigned*)(lds + (bufoff) + ldsw + _i * 8192), 16, 0, 0); } while (0)
#define PG8_LDA(dst, b, h) do { _Pragma("unroll") for (int m = 0; m < 4; ++m) _Pragma("unroll") for (int k = 0; k < 2; ++k) dst[m][k] = *(const PG8_LAS bf16x8*)(lds + PG8_SA(b, h) + aoff + m * 2048 + k * 1024); } while (0)
#define PG8_LDB(dst, b, h) do { _Pragma("unroll") for (int n = 0; n < 2; ++n) _Pragma("unroll") for (int k = 0; k < 2; ++k) dst[n][k] = *(const PG8_LAS bf16x8*)(lds + PG8_SB(b, h) + boff + n * 2048 + k * 1024); } while (0)
#define PG8_MMA(ai, bj, At, Bt) do { __builtin_amdgcn_s_setprio(1); _Pragma("unroll") for (int m = 0; m < 4; ++m) _Pragma("unroll") for (int n = 0; n < 2; ++n) _Pragma("unroll") for (int k = 0; k < 2; ++k) \
        acc[ai][bj][m][n] = __builtin_amdgcn_mfma_f32_16x16x32_bf16(Bt[n][k], At[m][k], acc[ai][bj][m][n], 0, 0, 0); __builtin_amdgcn_s_setprio(0); } while (0)
#define PG8_WAIT_V(n) asm volatile("s_waitcnt vmcnt(" #n ")" ::: "memory")
#define PG8_WAIT_L(n) asm volatile("s_waitcnt lgkmcnt(" #n ")" ::: "memory")
#define PG8_BAR __builtin_amdgcn_s_barrier()
#define PG8_SCHED __builtin_amdgcn_sched_barrier(0)
    Unit cur, nxt; int ui = 0;
    if (!S.next(0, cur)) return;
    f32x4 acc[2][2][4][2];
#pragma unroll
    for (int a = 0; a < 2; ++a)
#pragma unroll
        for (int b = 0; b < 2; ++b)
#pragma unroll
            for (int m = 0; m < 4; ++m)
#pragma unroll
                for (int n = 0; n < 2; ++n) acc[a][b][m][n] = (f32x4){0.f, 0.f, 0.f, 0.f};
    bf16x8 At[4][2], B0[2][2], B1[2][2];
    const char* cA = (const char*)g.A + (size_t)cur.pm * tstepA; const char* cB = (const char*)g.Bt + (size_t)cur.pn * tstepB;
    S.a_ready(cur);
    PG8_STAGE(PG8_SB(0, 0), cB, voffB); PG8_STAGE(PG8_SA(0, 0), cA, voffA); PG8_STAGE(PG8_SB(0, 1), cB + hstepB, voffB); PG8_STAGE(PG8_SA(0, 1), cA + hstepA, voffA);
    if (wr == 1) PG8_BAR;
    PG8_WAIT_V(4); PG8_BAR;
    PG8_STAGE(PG8_SB(1, 0), cB + kstep, voffB); PG8_STAGE(PG8_SA(1, 0), cA + kstep, voffA); PG8_STAGE(PG8_SB(1, 1), cB + hstepB + kstep, voffB);
    PG8_WAIT_V(6); PG8_BAR;
    for (;;) {
        const bool has_next = S.next(ui + 1, nxt);
        const char* nA = has_next ? (const char*)g.A + (size_t)nxt.pm * tstepA : cA; const char* nB = has_next ? (const char*)g.Bt + (size_t)nxt.pn * tstepB : cB;
        for (int t = 0; t < nt; t += 2) {
            const bool last = (t == nt - 2);
            const char* a1 = cA + (size_t)(t + 1) * kstep;
            const char* a2 = last ? nA : cA + (size_t)(t + 2) * kstep; const char* b2 = last ? nB : cB + (size_t)(t + 2) * kstep;
            const char* a3 = a2 + kstep; const char* b3 = b2 + kstep;
            if (last && has_next) S.a_ready(nxt);
            PG8_LDB(B0, 0, 0); PG8_SCHED; PG8_LDA(At, 0, 0); PG8_STAGE(PG8_SA(1, 1), a1 + hstepA, voffA);
            PG8_WAIT_L(8); PG8_BAR; PG8_WAIT_L(0); PG8_MMA(0, 0, At, B0); PG8_BAR; PG8_SCHED;
            PG8_LDB(B1, 0, 1); PG8_STAGE(PG8_SB(0, 0), b2, voffB);
            PG8_BAR; PG8_WAIT_L(0); PG8_MMA(0, 1, At, B1); PG8_BAR;
            PG8_LDA(At, 0, 1); PG8_STAGE(PG8_SA(0, 0), a2, voffA);
            PG8_BAR; PG8_WAIT_L(0); PG8_MMA(1, 0, At, B0); PG8_BAR; PG8_SCHED;
            PG8_STAGE(PG8_SB(0, 1), b2 + hstepB, voffB);
            PG8_WAIT_V(6); PG8_BAR; PG8_MMA(1, 1, At, B1); PG8_BAR;
            PG8_LDB(B0, 1, 0); PG8_SCHED; PG8_LDA(At, 1, 0); PG8_STAGE(PG8_SA(0, 1), a2 + hstepA, voffA);
            PG8_WAIT_L(8); PG8_BAR; PG8_WAIT_L(0); PG8_MMA(0, 0, At, B0); PG8_BAR; PG8_SCHED;
            PG8_LDB(B1, 1, 1); PG8_STAGE(PG8_SB(1, 0), b3, voffB);
            PG8_BAR; PG8_WAIT_L(0); PG8_MMA(0, 1, At, B1); PG8_BAR;
            PG8_LDA(At, 1, 1); PG8_STAGE(PG8_SA(1, 0), a3, voffA);
            PG8_BAR; PG8_WAIT_L(0); PG8_MMA(1, 0, At, B0); PG8_BAR; PG8_SCHED;
            PG8_STAGE(PG8_SB(1, 1), b3 + hstepB, voffB);
            PG8_WAIT_V(6); PG8_BAR; PG8_MMA(1, 1, At, B1); PG8_BAR;
        }
        if constexpr (!Epi::AFTER_DRAIN) { E(acc, cur, wr, wc, fr, fq); S.done(cur); }
        if (!has_next) break;
#pragma unroll
        for (int a = 0; a < 2; ++a)
#pragma unroll
            for (int b = 0; b < 2; ++b)
#pragma unroll
                for (int m = 0; m < 4; ++m)
#pragma unroll
                    for (int n = 0; n < 2; ++n) acc[a][b][m][n] = (f32x4){0.f, 0.f, 0.f, 0.f};
        cur = nxt; cA = nA; cB = nB; ++ui;
    }
    PG8_WAIT_V(0);
    if (wr == 0) PG8_BAR;
    PG8_BAR;
    if constexpr (Epi::AFTER_DRAIN) { E.fused(acc, cur, wr, wc, fr, fq, lds, wid, lane); S.done(cur); }
#undef PG8_SA
#undef PG8_SB
#undef PG8_STAGE
#undef PG8_LDA
#undef PG8_LDB
#undef PG8_MMA
#undef PG8_WAIT_V
#undef PG8_WAIT_L
#undef PG8_BAR
#undef PG8_SCHED
}
}


#define XB_TMO      128
#define XB_XCNT(j)  (256  + 64 * (j))
#define XB_XSUB(j)  (1280 + 64 * (j))
#define XB_XGEN(j)  (2304 + 64 * (j))
#define XB_TOP      3328
#define XB_TOPGEN   3392
#define XCD_BAR_WORDS 3456
#define XB_SPIN_CAP (1u << 18)
#define LAS __attribute__((address_space(3)))

__device__ __forceinline__ unsigned xb_ld(unsigned* p)              { return __hip_atomic_load(p, __ATOMIC_RELAXED, __HIP_MEMORY_SCOPE_AGENT); }
__device__ __forceinline__ unsigned xb_add(unsigned* p, unsigned v) { return __hip_atomic_fetch_add(p, v, __ATOMIC_RELAXED, __HIP_MEMORY_SCOPE_AGENT); }
__device__ __forceinline__ unsigned xb_xcc_id() { return (unsigned)__builtin_amdgcn_s_getreg((3 << 11) | 20) & 0xFu; }
#define XB_SPIN(cond, bar) do { unsigned _sp = 0; while (cond) { __builtin_amdgcn_s_sleep(1); \
    if ((++_sp & 255u) == 0u) { if (xb_ld(&(bar)[XB_TMO])) break; if (_sp > XB_SPIN_CAP) { atomicAdd(&(bar)[XB_TMO], 1u); break; } } } } while (0)

struct XcdBarrier { unsigned* bar; unsigned x; volatile LAS unsigned* st; };
__device__ __forceinline__ XcdBarrier xcd_barrier_post(unsigned* bar, volatile LAS unsigned* st, bool t0) {
    XcdBarrier b; b.bar = bar; b.x = xb_xcc_id(); b.st = st;
    if (t0) (void)xb_add(&bar[XB_XCNT(b.x)], 1u);
    return b;
}
__device__ __forceinline__ void xcd_barrier_complete(unsigned* bar, unsigned x, unsigned& nloc, unsigned& nx) {
    const unsigned G = gridDim.x * gridDim.y * gridDim.z;
    unsigned sum, cnt, mine, sp = 0u;
    for (;;) {
        sum = 0u; cnt = 0u; mine = 0u;
#pragma unroll
        for (unsigned j = 0; j < 16; ++j) { const unsigned c = xb_ld(&bar[XB_XCNT(j)]); sum += c; cnt += (c > 0u) ? 1u : 0u; mine = (j == x) ? c : mine; }
        if (sum == G) break;
        __builtin_amdgcn_s_sleep(1);
        if ((++sp & 255u) == 0u) { if (xb_ld(&bar[XB_TMO])) break; if (sp > XB_SPIN_CAP) { atomicAdd(&bar[XB_TMO], 1u); break; } }
    }
    nloc = mine > 0u ? mine : 1u; nx = cnt > 0u ? cnt : 1u;
}
__device__ __forceinline__ void xcd_barrier(const XcdBarrier& b, bool t0) {
    asm volatile("s_waitcnt vmcnt(0)" ::: "memory");
    __syncthreads();
    if (t0) {
        unsigned* bar = b.bar;
        __builtin_amdgcn_s_waitcnt(0);
        unsigned nloc = b.st[0], nx = b.st[1];
        if (nloc == 0u) { xcd_barrier_complete(bar, b.x, nloc, nx); b.st[0] = nloc; b.st[1] = nx; }
        const unsigned old = xb_add(&bar[XB_XSUB(b.x)], 1u);
        const unsigned gen = old / nloc;
        if (old + 1u == (gen + 1u) * nloc) {
            __builtin_amdgcn_fence(__ATOMIC_RELEASE, "agent");
            asm volatile("s_waitcnt vmcnt(0)" ::: "memory");
            const unsigned og = xb_add(&bar[XB_TOP], 1u);
            const unsigned tg = og / nx;
            if (og + 1u == (tg + 1u) * nx) xb_add(&bar[XB_TOPGEN], 1u);
            else XB_SPIN(xb_ld(&bar[XB_TOPGEN]) == tg, bar);
            __builtin_amdgcn_fence(__ATOMIC_ACQUIRE, "agent");
            xb_add(&bar[XB_XGEN(b.x)], 1u);
            asm volatile("s_waitcnt vmcnt(0)" ::: "memory");
        } else {
            XB_SPIN(xb_ld(&bar[XB_XGEN(b.x)]) == gen, bar);
            __builtin_amdgcn_fence(__ATOMIC_ACQUIRE, "agent");
            asm volatile("s_waitcnt vmcnt(0)" ::: "memory");
        }
    }
    __syncthreads();
}

using pg8::bf16_t; using pg8::bf16x8; using pg8::f32x4; using pg8::u32x4;
typedef unsigned u32x2 __attribute__((ext_vector_type(2)));
typedef __bf16 bf16x2_t __attribute__((ext_vector_type(2)));
typedef float f32x2 __attribute__((ext_vector_type(2)));
#define DI __device__ __forceinline__

constexpr int MMAIN = 16384, MPAD = 16640, IN_DIM = 6672, DFF = 2816, FF2 = 5632;
constexpr size_t SZ_ACT = (size_t)MPAD * 1024 * 2;
constexpr size_t WS_WIN = 0;
constexpr size_t WS_WOUT = WS_WIN + (size_t)6656 * 1024 * 2;
constexpr size_t WS_WUP = WS_WOUT + (size_t)1024 * 1024 * 2;
constexpr size_t WS_WDN = WS_WUP + (size_t)5632 * 1024 * 2;
constexpr size_t WS_WPT = WS_WDN + (size_t)1024 * 2816 * 2;
constexpr size_t WS_U = WS_WPT + (size_t)4 * 256 * 128 * 2;
constexpr size_t WS_QB = WS_U + SZ_ACT;
constexpr size_t WS_KB = WS_QB + SZ_ACT;
constexpr size_t WS_VB = WS_KB + SZ_ACT;
constexpr size_t WS_WB = WS_VB + SZ_ACT;
constexpr size_t WS_KTB = WS_WB + SZ_ACT;
constexpr size_t WS_QKB = WS_KTB + SZ_ACT;
constexpr size_t WS_HALO = WS_QKB + (size_t)260 * 8 * 4096 * 2;
constexpr size_t WS_BA = WS_HALO + (size_t)260 * 2 * 5632 * 2;
constexpr size_t WS_HM = WS_BA + (size_t)MPAD * 16 * 4;
constexpr size_t WS_GT = WS_HM + (size_t)256 * 1024 * 4;
constexpr size_t WS_BAR = WS_GT + (size_t)260 * 8 * 4 + 64;
constexpr size_t WS_END = WS_BAR + (size_t)XCD_BAR_WORDS * 4;
static_assert(WS_QKB + (size_t)260 * 8 * 4096 * 2 - WS_QB == (size_t)MPAD * FF2 * 2, "hid overlay");
static_assert(WS_END <= 268435456ull, "workspace");
constexpr int LDS_BYTES = 131072 + 16;

struct Params {
    const float *x, *meta, *norm_mix, *w_in, *conv_qkv, *a_log, *dt_bias, *head_norm, *w_pool, *pool_scale, *w_out, *norm_ffn, *w_up, *conv_ffn, *w_down, *norm_final;
    float* out; unsigned char* ws; int wid0, pad0;
};

DI int opaque_tid(const Params& p) { int t = (p.wid0 << 6) | (int)__builtin_amdgcn_mbcnt_hi(~0u, __builtin_amdgcn_mbcnt_lo(~0u, 0u)); asm volatile("" : "+v"(t)); return t; }
DI unsigned pk2(float a, float b) { f32x2 v = {a, b}; bf16x2_t r = __builtin_convertvector(v, bf16x2_t); return __builtin_bit_cast(unsigned, r); }
DI bf16_t f2bf(float a) { return (bf16_t)(pk2(a, 0.f) & 0xffffu); }
DI float bflo(unsigned w) { return __uint_as_float(w << 16); }
DI float bfhi(unsigned w) { return __uint_as_float(w & 0xffff0000u); }
DI float bf2f(bf16_t b) { return __uint_as_float(((unsigned)b) << 16); }
DI bf16x8 pack8(f32x4 a, f32x4 b) { u32x4 w; w.x = pk2(a[0], a[1]); w.y = pk2(a[2], a[3]); w.z = pk2(b[0], b[1]); w.w = pk2(b[2], b[3]); return __builtin_bit_cast(bf16x8, w); }
DI f32x4 mfma16(bf16x8 a, bf16x8 b, f32x4 c) { return __builtin_amdgcn_mfma_f32_16x16x32_bf16(a, b, c, 0, 0, 0); }
DI float sigm(float x) { return 1.0f / (1.0f + __expf(-x)); }
DI float silu(float x) { return x / (1.0f + __expf(-x)); }
DI float wsum(float v) { v += __shfl_xor(v, 32); v += __shfl_xor(v, 16); v += __shfl_xor(v, 8); v += __shfl_xor(v, 4); v += __shfl_xor(v, 2); v += __shfl_xor(v, 1); return v; }
DI float* hrow(const Params& p, int r) { return r < MMAIN ? p.out + (size_t)r * 1024 : (float*)(p.ws + WS_HM) + (size_t)(r - MMAIN) * 1024; }

struct EpiQKV {
    static constexpr bool PERM = true, AFTER_DRAIN = false;
    bf16_t *Q, *halo;
    DI void operator()(const f32x4 (&acc)[2][2][4][2], const pg8::Unit& u, int wr, int wc, int fr, int fq) const {
        const int which = u.pn >> 2; bf16_t* base = Q + (size_t)which * (SZ_ACT / 2);
#pragma unroll
        for (int ai = 0; ai < 2; ++ai)
#pragma unroll
            for (int m = 0; m < 4; ++m) {
                const int cb = u.pm * 4 + ai * 2 + wr, rr = m * 16 + fr;
#pragma unroll
                for (int bj = 0; bj < 2; ++bj) {
                    const int head = (u.pn & 3) * 2 + bj, cc = wc * 32 + 8 * fq;
                    const f32x4 v0 = acc[ai][bj][m][0], v1 = acc[ai][bj][m][1];
                    u32x4 w; w.x = pk2(v0[0], v0[1]); w.y = pk2(v0[2], v0[3]); w.z = pk2(v1[0], v1[1]); w.w = pk2(v1[2], v1[3]);
                    *(u32x4*)(base + ((size_t)(cb * 8 + head) * 64 + rr) * 128 + cc) = w;
                    if (m == 3 && fr >= 13) *(u32x4*)(halo + ((size_t)cb * 3 + (rr - 61)) * 3072 + u.pn * 256 + bj * 128 + cc) = w;
                }
            }
    }
};
struct EpiZPG {
    static constexpr bool PERM = true, AFTER_DRAIN = false;
    bf16_t *QB0;
    DI void operator()(const f32x4 (&acc)[2][2][4][2], const pg8::Unit& u, int wr, int wc, int fr, int fq) const {
        const int ge4 = u.pn >= 4, ge6 = u.pn >= 6, ge10 = u.pn >= 10, idx = ge4 + ge6 + ge10, is1 = (idx == 1);
        const int slot = idx + 4 * is1, ld = 1024 >> is1, c0 = (u.pn - (4 * ge4 + 2 * ge6 + 4 * ge10)) * 256;
        bf16_t* base = QB0 + (size_t)slot * (SZ_ACT / 2);
#pragma unroll
        for (int ai = 0; ai < 2; ++ai)
#pragma unroll
            for (int m = 0; m < 4; ++m) {
                const int row = u.pm * 256 + ai * 128 + wr * 64 + m * 16 + fr;
#pragma unroll
                for (int bj = 0; bj < 2; ++bj) {
                    const f32x4 v0 = acc[ai][bj][m][0], v1 = acc[ai][bj][m][1];
                    u32x4 w; w.x = pk2(v0[0], v0[1]); w.y = pk2(v0[2], v0[3]); w.z = pk2(v1[0], v1[1]); w.w = pk2(v1[2], v1[3]);
                    *(u32x4*)(base + (size_t)row * ld + c0 + bj * 128 + wc * 32 + 8 * fq) = w;
                }
            }
    }
};
struct EpiHid {
    static constexpr bool PERM = true, AFTER_DRAIN = false;
    bf16_t *H, *halo;
    DI void operator()(const f32x4 (&acc)[2][2][4][2], const pg8::Unit& u, int wr, int wc, int fr, int fq) const {
#pragma unroll
        for (int ai = 0; ai < 2; ++ai)
#pragma unroll
            for (int m = 0; m < 4; ++m) {
                const int cb = u.pm * 4 + ai * 2 + wr, rr = m * 16 + fr, row = cb * 64 + rr;
#pragma unroll
                for (int bj = 0; bj < 2; ++bj) {
                    const int col = u.pn * 256 + bj * 128 + wc * 32 + 8 * fq;
                    const f32x4 v0 = acc[ai][bj][m][0], v1 = acc[ai][bj][m][1];
                    u32x4 w; w.x = pk2(v0[0], v0[1]); w.y = pk2(v0[2], v0[3]); w.z = pk2(v1[0], v1[1]); w.w = pk2(v1[2], v1[3]);
                    *(u32x4*)(H + (size_t)row * FF2 + col) = w;
                    if (m == 3 && fr >= 14) *(u32x4*)(halo + ((size_t)cb * 2 + (rr - 62)) * FF2 + col) = w;
                }
            }
    }
};
struct EpiRes {
    static constexpr bool PERM = false, AFTER_DRAIN = false;
    float *hmain, *hmeta;
    DI void operator()(const f32x4 (&acc)[2][2][4][2], const pg8::Unit& u, int wr, int wc, int fr, int fq) const {
        const int col0 = u.pn * 256 + wc * 32 + 4 * fq;
#pragma unroll
        for (int ai = 0; ai < 2; ++ai)
#pragma unroll
            for (int m = 0; m < 4; ++m) {
                const int row = u.pm * 256 + ai * 128 + wr * 64 + m * 16 + fr;
                float* rp = (row < MMAIN ? hmain + (size_t)row * 1024 : hmeta + (size_t)(row - MMAIN) * 1024) + col0;
#pragma unroll
                for (int bj = 0; bj < 2; ++bj)
#pragma unroll
                    for (int n = 0; n < 2; ++n) { f32x4* q = (f32x4*)(rp + bj * 128 + n * 16); *q = *q + acc[ai][bj][m][n]; }
            }
    }
};

DI void cvt_tile(const float* W, int ldw, int k0, int n0src, bf16_t* Bt, int ldb, int n0dst, float* tl, int tid) {
#pragma unroll
    for (int i = 0; i < 2; ++i) { const int kk = (tid >> 4) + 32 * i, c4 = (tid & 15) * 4;
        const float4 v = *(const float4*)(W + (size_t)(k0 + kk) * ldw + n0src + c4);
        tl[kk * 65 + c4 + 0] = v.x; tl[kk * 65 + c4 + 1] = v.y; tl[kk * 65 + c4 + 2] = v.z; tl[kk * 65 + c4 + 3] = v.w; }
    __syncthreads();
    { const int nn = tid >> 3, k8 = (tid & 7) * 8; float f[8];
#pragma unroll
      for (int j = 0; j < 8; ++j) f[j] = tl[(k8 + j) * 65 + nn];
      u32x4 w; w.x = pk2(f[0], f[1]); w.y = pk2(f[2], f[3]); w.z = pk2(f[4], f[5]); w.w = pk2(f[6], f[7]);
      *(u32x4*)(Bt + (size_t)(n0dst + nn) * ldb + k0 + k8) = w; }
    __syncthreads();
}
DI void convert_weights(const Params& p, int layer, unsigned char* smem, int tid) {
    float* tl = (float*)smem;
    const float* win = p.w_in + (size_t)layer * 1024 * IN_DIM; const float* wout = p.w_out + (size_t)layer * 1024 * 1024;
    const float* wup = p.w_up + (size_t)layer * 1024 * FF2; const float* wdn = p.w_down + (size_t)layer * DFF * 1024; const float* wpl = p.w_pool + (size_t)layer * 4 * 128 * 256;
    bf16_t* Win = (bf16_t*)(p.ws + WS_WIN); bf16_t* Wout = (bf16_t*)(p.ws + WS_WOUT); bf16_t* Wup = (bf16_t*)(p.ws + WS_WUP); bf16_t* Wdn = (bf16_t*)(p.ws + WS_WDN); bf16_t* Wpt = (bf16_t*)(p.ws + WS_WPT);
    for (int t = blockIdx.x; t < 4064; t += gridDim.x) {
        if (t < 1664) { const int kt = t / 104, nt = t % 104, n0 = nt * 64; cvt_tile(win, IN_DIM, kt * 64, n0 + (n0 >= 4096 ? 16 : 0), Win, 1024, n0, tl, tid); }
        else if (t < 1920) { const int q = t - 1664; cvt_tile(wout, 1024, (q >> 4) * 64, (q & 15) * 64, Wout, 1024, (q & 15) * 64, tl, tid); }
        else if (t < 3328) { const int q = t - 1920, kt = q / 88, nt = q % 88; cvt_tile(wup, FF2, kt * 64, nt * 64, Wup, 1024, nt * 64, tl, tid); }
        else if (t < 4032) { const int q = t - 3328, kt = q >> 4, nt = q & 15; cvt_tile(wdn, 1024, kt * 64, nt * 64, Wdn, DFF, nt * 64, tl, tid); }
        else { const int q = t - 4032, g = q >> 3, kt = (q >> 2) & 1, nt = q & 3; cvt_tile(wpl + (size_t)g * 128 * 256, 256, kt * 64, nt * 64, Wpt + (size_t)g * 256 * 128, 128, nt * 64, tl, tid); }
    }
}

DI void phase_norm(const Params& p, int layer, int which, unsigned char* smem) {
    const int tid = opaque_tid(p), lane = tid & 63, wid = tid >> 6;
    float* wba = (float*)smem;
    float* BA = (float*)(p.ws + WS_BA); bf16_t* U = (bf16_t*)(p.ws + WS_U);
    if (which == 0) {
        convert_weights(p, layer, smem, tid);
        __syncthreads();
        const float* win = p.w_in + (size_t)layer * 1024 * IN_DIM;
        for (int e = tid; e < 4096; e += 512) { const int k = e >> 2, j4 = (e & 3) * 4; *(float4*)(wba + k * 20 + j4) = *(const float4*)(win + (size_t)k * IN_DIM + 4096 + j4); }
        __syncthreads();
    }
    const float* gain = (which == 0 ? p.norm_mix : p.norm_ffn) + layer * 1024;
    const bool init = (layer == 0 && which == 0);
    for (int r = blockIdx.x * 8 + wid; r < MPAD; r += gridDim.x * 8) {
        const float* src;
        if (init) { if (r < MMAIN) src = p.x + (size_t)r * 1024; else { const int rm = r - MMAIN, s = rm & 63; src = (rm < 128 && s >= 48) ? p.meta + (size_t)(s - 48) * 1024 : nullptr; } }
        else src = hrow(p, r);
        float v[16]; float ss = 0.f;
#pragma unroll
        for (int i = 0; i < 16; ++i) { v[i] = src ? src[lane + 64 * i] : 0.f; ss += v[i] * v[i]; }
        if (init) { float* hr = hrow(p, r);
#pragma unroll
            for (int i = 0; i < 16; ++i) hr[lane + 64 * i] = v[i]; }
        ss = wsum(ss);
        const float rstd = rsqrtf(ss * (1.0f / 1024.0f) + 1e-6f);
#pragma unroll
        for (int i = 0; i < 16; ++i) { v[i] = v[i] * rstd * gain[lane + 64 * i]; U[(size_t)r * 1024 + lane + 64 * i] = f2bf(v[i]); }
        if (which == 0) {
            float acc[16]; int vz = 0; asm volatile("" : "+v"(vz)); const float* wbz = wba + vz;
#pragma unroll
            for (int j = 0; j < 16; ++j) acc[j] = 0.f;
#pragma unroll
            for (int i = 0; i < 16; ++i) { const float* wr_ = wbz + (lane + 64 * i) * 20;
#pragma unroll
                for (int j4 = 0; j4 < 4; ++j4) { const float4 w = *(const float4*)(wr_ + 4 * j4);
                    acc[4 * j4 + 0] += v[i] * w.x; acc[4 * j4 + 1] += v[i] * w.y; acc[4 * j4 + 2] += v[i] * w.z; acc[4 * j4 + 3] += v[i] * w.w; } }
            float o = 0.f;
#pragma unroll
            for (int j = 0; j < 16; ++j) { const float s = wsum(acc[j]); o = (lane == j) ? s : o; }
            if (lane < 16) BA[(size_t)r * 16 + lane] = o;
        }
    }
}
DI void phase_final(const Params& p) {
    const int tid = opaque_tid(p), lane = tid & 63, wid = tid >> 6;
    for (int r = blockIdx.x * 8 + wid; r < MMAIN; r += gridDim.x * 8) {
        float* hr = p.out + (size_t)r * 1024; float v[16]; float ss = 0.f;
#pragma unroll
        for (int i = 0; i < 16; ++i) { v[i] = hr[lane + 64 * i]; ss += v[i] * v[i]; }
        ss = wsum(ss); const float rstd = rsqrtf(ss * (1.0f / 1024.0f) + 1e-6f);
#pragma unroll
        for (int i = 0; i < 16; ++i) hr[lane + 64 * i] = v[i] * rstd * p.norm_final[lane + 64 * i];
    }
}

DI void phase_p3(const Params& p, int layer, unsigned char* smem) {
    const int tid = opaque_tid(p), lane = tid & 63, wid = tid >> 6; int q4 = lane >> 4, l16 = lane & 15;
    bf16_t* qs = (bf16_t*)(smem); bf16_t* ks = (bf16_t*)(smem + 17408); bf16_t* vbT = (bf16_t*)(smem + 34816); bf16_t* kgT = (bf16_t*)(smem + 53248);
    float* Lm = (float*)(smem + 71680); bf16_t* Tb = (bf16_t*)(smem + 89088); float* sc = (float*)(smem + 98304);
    bf16_t* QB = (bf16_t*)(p.ws + WS_QB); bf16_t* KB = (bf16_t*)(p.ws + WS_KB); bf16_t* VB = (bf16_t*)(p.ws + WS_VB); bf16_t* WB = (bf16_t*)(p.ws + WS_WB);
    bf16_t* KTB = (bf16_t*)(p.ws + WS_KTB); bf16_t* QKB = (bf16_t*)(p.ws + WS_QKB); const bf16_t* HALO = (const bf16_t*)(p.ws + WS_HALO);
    const float* BA = (const float*)(p.ws + WS_BA); float* GT = (float*)(p.ws + WS_GT);
    const float* cw = p.conv_qkv + (size_t)layer * 4 * 3072;
    const float SCALE = 0.08838834764831845f;
    for (int item = blockIdx.x; item < 258 * 8; item += gridDim.x) {
        const int cb = item >> 3, h = item & 7;
        int b, c; if (cb < 256) { b = cb >> 7; c = (cb & 127) + 1; } else { b = cb - 256; c = 0; }
        const int prev_cb = (c == 0) ? -1 : (c == 1 ? 256 + b : cb - 1);
        const size_t blk = (size_t)item * 8192;
        if (wid == 0) {
            const int row = cb * 64 + lane;
            const float braw = BA[(size_t)row * 16 + h], araw = BA[(size_t)row * 16 + 8 + h];
            float beta = 1.0f / (1.0f + expf(-braw));
            const float xx = araw + p.dt_bias[layer * 8 + h]; const float sp = xx > 20.f ? xx : log1pf(expf(xx));
            float g = -expf(p.a_log[layer * 8 + h]) * sp;
            if (c == 0 && lane < 48) { g = 0.f; beta = 0.f; }
            float G = g;
#pragma unroll
            for (int off = 1; off < 64; off <<= 1) { const float t = __shfl_up(G, off); if (lane >= off) G += t; }
            const float Gl = __shfl(G, 63);
            sc[lane] = beta; sc[64 + lane] = G; sc[128 + lane] = expf(G); sc[192 + lane] = expf(Gl - G);
            if (lane == 63) GT[item] = expf(G);
        }
        __syncthreads();
        {
            const int c0 = 2 * lane, r0 = 8 * wid;
            float wq[4][2], wk[4][2], wv[4][2];
#pragma unroll
            for (int j = 0; j < 4; ++j)
#pragma unroll
                for (int e = 0; e < 2; ++e) { wq[j][e] = cw[j * 3072 + h * 128 + c0 + e]; wk[j][e] = cw[j * 3072 + 1024 + h * 128 + c0 + e]; wv[j][e] = cw[j * 3072 + 2048 + h * 128 + c0 + e]; }
            unsigned xq[11], xk[11], xv[11];
#pragma unroll
            for (int i = 0; i < 11; ++i) { const int rr = r0 - 3 + i;
                if (rr >= 0) { xq[i] = *(const unsigned*)(QB + blk + rr * 128 + c0); xk[i] = *(const unsigned*)(KB + blk + rr * 128 + c0); xv[i] = *(const unsigned*)(VB + blk + rr * 128 + c0); }
                else if (prev_cb >= 0) { const bf16_t* hp = HALO + ((size_t)prev_cb * 3 + (rr + 3)) * 3072 + h * 128 + c0; xq[i] = *(const unsigned*)hp; xk[i] = *(const unsigned*)(hp + 1024); xv[i] = *(const unsigned*)(hp + 2048); }
                else { xq[i] = 0u; xk[i] = 0u; xv[i] = 0u; } }
#pragma unroll
            for (int i = 0; i < 8; ++i) {
                const int r = r0 + i;
                float cq0 = 0.f, cq1 = 0.f, ck0 = 0.f, ck1 = 0.f, cv0 = 0.f, cv1 = 0.f;
#pragma unroll
                for (int j = 0; j < 4; ++j) { cq0 += wq[j][0] * bflo(xq[i + j]); cq1 += wq[j][1] * bfhi(xq[i + j]); ck0 += wk[j][0] * bflo(xk[i + j]); ck1 += wk[j][1] * bfhi(xk[i + j]);
                    cv0 += wv[j][0] * bflo(xv[i + j]); cv1 += wv[j][1] * bfhi(xv[i + j]); }
                cq0 = silu(cq0); cq1 = silu(cq1); ck0 = silu(ck0); ck1 = silu(ck1); cv0 = silu(cv0); cv1 = silu(cv1);
                const float sq = wsum(cq0 * cq0 + cq1 * cq1), sk = wsum(ck0 * ck0 + ck1 * ck1);
                const float rq = rsqrtf(sq + 1e-6f), rk = rsqrtf(sk + 1e-6f);
                cq0 *= rq; cq1 *= rq; ck0 *= rk; ck1 *= rk;
                const float beta = sc[r], eg = sc[128 + r];
                *(unsigned*)(qs + r * 136 + c0) = pk2(cq0, cq1); *(unsigned*)(ks + r * 136 + c0) = pk2(ck0, ck1);
                vbT[(c0 + 0) * 72 + r] = f2bf(cv0 * beta); vbT[(c0 + 1) * 72 + r] = f2bf(cv1 * beta);
                kgT[(c0 + 0) * 72 + r] = f2bf(ck0 * beta * eg); kgT[(c0 + 1) * 72 + r] = f2bf(ck1 * beta * eg);
            }
        }
        __syncthreads();
        { int lz = lane; asm volatile("" : "+v"(lz)); q4 = lz >> 4; l16 = lz & 15; }
        if (wid < 4) {
            const int mt = wid; bf16x8 a[4];
#pragma unroll
            for (int kb = 0; kb < 4; ++kb) a[kb] = *(const bf16x8*)(ks + (16 * mt + l16) * 136 + 32 * kb + 8 * q4);
            for (int nt = 0; nt <= mt; ++nt) {
                f32x4 d = {0.f, 0.f, 0.f, 0.f};
#pragma unroll
                for (int kb = 0; kb < 4; ++kb) d = mfma16(a[kb], *(const bf16x8*)(ks + (16 * nt + l16) * 136 + 32 * kb + 8 * q4), d);
                const int j_ = 16 * nt + l16; const float Gj = sc[64 + j_];
#pragma unroll
                for (int i = 0; i < 4; ++i) { const int i_ = 16 * mt + 4 * q4 + i; Lm[i_ * 68 + j_] = (i_ > j_) ? sc[i_] * d[i] * expf(sc[64 + i_] - Gj) : 0.f; }
            }
        } else {
            const int nti = wid - 4; bf16x8 bq[4]; f32x4 d[4];
#pragma unroll
            for (int kb = 0; kb < 4; ++kb) bq[kb] = *(const bf16x8*)(qs + (16 * nti + l16) * 136 + 32 * kb + 8 * q4);
            const int i_ = 16 * nti + l16; const float Gi = sc[64 + i_];
#pragma unroll
            for (int mtj = 0; mtj < 4; ++mtj) {
                f32x4 t = {0.f, 0.f, 0.f, 0.f};
                if (mtj <= nti) {
#pragma unroll
                    for (int kb = 0; kb < 4; ++kb) t = mfma16(*(const bf16x8*)(ks + (16 * mtj + l16) * 136 + 32 * kb + 8 * q4), bq[kb], t);
#pragma unroll
                    for (int i = 0; i < 4; ++i) { const int j_ = 16 * mtj + 4 * q4 + i; t[i] = (i_ >= j_) ? t[i] * SCALE * expf(Gi - sc[64 + j_]) : 0.f; }
                }
                d[mtj] = t;
            }
            *(bf16x8*)(QKB + (size_t)item * 4096 + ((nti * 2 + 0) * 64 + lane) * 8) = pack8(d[0], d[1]);
            *(bf16x8*)(QKB + (size_t)item * 4096 + ((nti * 2 + 1) * 64 + lane) * 8) = pack8(d[2], d[3]);
        }
        __syncthreads();
        if (wid == 0) {
            float t[64]; int vz; asm volatile("v_mov_b32 %0, 0" : "=v"(vz));
            const float* Lv = Lm + vz;
#pragma unroll
            for (int i = 0; i < 64; ++i) {
                float a0 = 0.f, a1 = 0.f, a2 = 0.f, a3 = 0.f;
#pragma unroll
                for (int s4 = 0; s4 < i; s4 += 4) { const float4 l = *(const float4*)(Lv + i * 68 + s4);
                    a0 += l.x * t[s4]; if (s4 + 1 < i) a1 += l.y * t[s4 + 1]; if (s4 + 2 < i) a2 += l.z * t[s4 + 2]; if (s4 + 3 < i) a3 += l.w * t[s4 + 3]; }
                t[i] = ((i == lane) ? 1.f : 0.f) - ((a0 + a1) + (a2 + a3));
                if ((i & 1) == 1) asm volatile("" ::: "memory");
            }
#pragma unroll
            for (int i = 0; i < 64; ++i) Tb[i * 72 + lane] = f2bf(t[i]);
        } else {
            { int lz = lane; asm volatile("" : "+v"(lz)); q4 = lz >> 4; l16 = lz & 15; }
            for (int f = wid - 1; f < 32; f += 7) {
                if (f < 16) {
                    const int mt = f >> 2, kb = f & 3, row = 16 * mt + l16; const float s = SCALE * sc[128 + row];
                    const u32x2 lo = *(const u32x2*)(qs + row * 136 + 32 * kb + 4 * q4), hi = *(const u32x2*)(qs + row * 136 + 32 * kb + 16 + 4 * q4);
                    u32x4 w; w.x = pk2(bflo(lo.x) * s, bfhi(lo.x) * s); w.y = pk2(bflo(lo.y) * s, bfhi(lo.y) * s); w.z = pk2(bflo(hi.x) * s, bfhi(hi.x) * s); w.w = pk2(bflo(hi.y) * s, bfhi(hi.y) * s);
                    *(u32x4*)(QB + blk + (f * 64 + lane) * 8) = w;
                } else {
                    const int ff = f - 16, mtd = ff >> 1, kb2 = ff & 1, dk = 16 * mtd + l16; float v[8];
#pragma unroll
                    for (int j = 0; j < 8; ++j) { const int tok = 32 * kb2 + 16 * (j >> 2) + 4 * q4 + (j & 3); v[j] = bf2f(ks[tok * 136 + dk]) * sc[192 + tok]; }
                    u32x4 w; w.x = pk2(v[0], v[1]); w.y = pk2(v[2], v[3]); w.z = pk2(v[4], v[5]); w.w = pk2(v[6], v[7]);
                    *(u32x4*)(KTB + blk + (ff * 64 + lane) * 8) = w;
                }
            }
        }
        __syncthreads();
        { int lz = lane; asm volatile("" : "+v"(lz)); q4 = lz >> 4; l16 = lz & 15; }
        {
            const int nt = wid; bf16x8 bv[2]; f32x4 d[4];
#pragma unroll
            for (int kb2 = 0; kb2 < 2; ++kb2) bv[kb2] = *(const bf16x8*)(vbT + (16 * nt + l16) * 72 + 32 * kb2 + 8 * q4);
#pragma unroll
            for (int mt = 0; mt < 4; ++mt) { f32x4 t = {0.f, 0.f, 0.f, 0.f};
#pragma unroll
                for (int kb2 = 0; kb2 < 2; ++kb2) t = mfma16(*(const bf16x8*)(Tb + (16 * mt + l16) * 72 + 32 * kb2 + 8 * q4), bv[kb2], t);
                d[mt] = t; }
            *(bf16x8*)(VB + blk + nt * 1024 + lane * 16) = pack8(d[0], d[1]);
            *(bf16x8*)(VB + blk + nt * 1024 + lane * 16 + 8) = pack8(d[2], d[3]);
        }
        {
            const int mtt = wid & 3, half = wid >> 2; bf16x8 bt[2]; f32x4 d[4];
#pragma unroll
            for (int kb2 = 0; kb2 < 2; ++kb2) bt[kb2] = *(const bf16x8*)(Tb + (16 * mtt + l16) * 72 + 32 * kb2 + 8 * q4);
#pragma unroll
            for (int m4 = 0; m4 < 4; ++m4) { const int mtd = 4 * half + m4; f32x4 t = {0.f, 0.f, 0.f, 0.f};
#pragma unroll
                for (int kb2 = 0; kb2 < 2; ++kb2) t = mfma16(*(const bf16x8*)(kgT + (16 * mtd + l16) * 72 + 32 * kb2 + 8 * q4), bt[kb2], t);
                d[m4] = t; }
            *(bf16x8*)(WB + blk + ((mtt * 4 + 2 * half + 0) * 64 + lane) * 8) = pack8(d[0], d[1]);
            *(bf16x8*)(WB + blk + ((mtt * 4 + 2 * half + 1) * 64 + lane) * 8) = pack8(d[2], d[3]);
        }
        __syncthreads();
    }
}

DI void scan_step(const unsigned char* buf, f32x4 (&S)[8], bf16_t* op, int lane) {
    const bf16x8* Wf = (const bf16x8*)(buf) + lane; const bf16x8* Qf = (const bf16x8*)(buf + 16384) + lane;
    const bf16x8* Kf = (const bf16x8*)(buf + 32768) + lane; const bf16x8* Pf = (const bf16x8*)(buf + 49152) + lane;
#define SC_SB() __builtin_amdgcn_sched_barrier(0)
    bf16x8 fa[16], fb[16], Sb[4], Vb[2]; f32x4 vn[4], o[4];
#pragma unroll
    for (int f = 0; f < 16; ++f) fa[f] = Wf[f * 64];
#pragma unroll
    for (int kb = 0; kb < 4; ++kb) Sb[kb] = pack8(S[2 * kb], S[2 * kb + 1]);
    SC_SB();
#pragma unroll
    for (int f = 0; f < 16; ++f) fb[f] = Qf[f * 64];
    SC_SB();
    const u32x4 u0 = *(const u32x4*)(buf + 57344 + lane * 32), u1 = *(const u32x4*)(buf + 57344 + lane * 32 + 16); const float gt = *(const float*)(buf + 57344 + 2048);
    const unsigned uw[8] = {u0.x, u0.y, u0.z, u0.w, u1.x, u1.y, u1.z, u1.w};
#pragma unroll
    for (int mt = 0; mt < 4; ++mt) { f32x4 a = {0.f, 0.f, 0.f, 0.f};
#pragma unroll
        for (int kb = 0; kb < 4; ++kb) a = mfma16(fa[mt * 4 + kb], Sb[kb], a);
        vn[mt][0] = bflo(uw[2 * mt]) - a[0]; vn[mt][1] = bfhi(uw[2 * mt]) - a[1]; vn[mt][2] = bflo(uw[2 * mt + 1]) - a[2]; vn[mt][3] = bfhi(uw[2 * mt + 1]) - a[3]; }
    SC_SB();
#pragma unroll
    for (int f = 0; f < 8; ++f) fa[f] = Pf[f * 64];
#pragma unroll
    for (int f = 0; f < 8; ++f) fa[8 + f] = Kf[f * 64];
    Vb[0] = pack8(vn[0], vn[1]); Vb[1] = pack8(vn[2], vn[3]);
    SC_SB();
#pragma unroll
    for (int mt = 0; mt < 4; ++mt) { f32x4 a = {0.f, 0.f, 0.f, 0.f};
#pragma unroll
        for (int kb = 0; kb < 4; ++kb) a = mfma16(fb[mt * 4 + kb], Sb[kb], a);
        o[mt] = a; }
    SC_SB();
#pragma unroll
    for (int f = 0; f < 8; ++f) fb[f] = Kf[(8 + f) * 64];
    SC_SB();
#pragma unroll
    for (int mt = 0; mt < 4; ++mt) { f32x4 a = o[mt];
#pragma unroll
        for (int kb2 = 0; kb2 < 2; ++kb2) a = mfma16(fa[mt * 2 + kb2], Vb[kb2], a);
        o[mt] = a; }
#pragma unroll
    for (int mtd = 0; mtd < 4; ++mtd) { f32x4 a = S[mtd] * gt;
#pragma unroll
        for (int kb2 = 0; kb2 < 2; ++kb2) a = mfma16(fa[8 + mtd * 2 + kb2], Vb[kb2], a);
        S[mtd] = a; }
    SC_SB();
#pragma unroll
    for (int mtd = 4; mtd < 8; ++mtd) { f32x4 a = S[mtd] * gt;
#pragma unroll
        for (int kb2 = 0; kb2 < 2; ++kb2) a = mfma16(fb[(mtd - 4) * 2 + kb2], Vb[kb2], a);
        S[mtd] = a; }
#pragma unroll
    for (int mt = 0; mt < 4; ++mt)
#pragma unroll
        for (int i = 0; i < 4; ++i) op[(size_t)(16 * mt + i) * 1024] = f2bf(o[mt][i]);
#undef SC_SB
}
#define SC_BAR() do { asm volatile("s_waitcnt lgkmcnt(0)" ::: "memory"); __builtin_amdgcn_s_barrier(); asm volatile("" ::: "memory"); } while (0)
DI void phase_scan(const Params& p, unsigned char* smem) {
    if (blockIdx.x >= 128) return;
    const int tid = opaque_tid(p), lane = tid & 63, wid = __builtin_amdgcn_readfirstlane(tid >> 6), q4 = lane >> 4, l16 = lane & 15;
    const int bx = blockIdx.x & 7, by = blockIdx.x >> 3, nt = by & 7, g = bx + 8 * (by >> 3), b = g >> 3, h = g & 7;
    constexpr int BUFB = 59904;
#define SC_CB(c) (((c) == 0) ? 256 + b : 128 * b + (c) - 1)
    if (wid != 0) {
        const int r = wid - 1, rr = r >> 1, slot = 3 * (rr == 0) + 4 * (rr == 2) + 5 * (rr == 3), isq = (rr == 3);
        const unsigned char* sb = p.ws + WS_QB + (size_t)slot * SZ_ACT + (size_t)(r & 1) * 8192 + lane * 16;
        const unsigned char* ub = p.ws + WS_VB + nt * 2048 + lane * 32; const float* GT = (const float*)(p.ws + WS_GT);
        const size_t istride = (size_t)16384 >> isq;
        unsigned char* d0 = smem + r * 8192 + lane * 16; unsigned char* d1 = d0 + BUFB;
        unsigned char* e0 = smem + 57344 + lane * 32; unsigned char* e1 = e0 + BUFB;
        u32x4 ra[8], rb[8], rc[8], rd[8]; u32x4 xa[2], xb[2], xc[2], xd[2]; float ga = 0.f, gb = 0.f, gc = 0.f, gd = 0.f;
#define SC_LOAD(dst, xd_, gd_, c) do { const int cc_ = (c) < 129 ? (c) : 128; const int it_ = SC_CB(cc_) * 8 + h; const unsigned char* s_ = sb + (size_t)it_ * istride; \
        _Pragma("unroll") for (int i_ = 0; i_ < 8; ++i_) dst[i_] = *(const u32x4*)(s_ + i_ * 1024); \
        if (r == 6) { const unsigned char* us_ = ub + (size_t)it_ * 16384; xd_[0] = *(const u32x4*)us_; xd_[1] = *(const u32x4*)(us_ + 16); gd_ = GT[it_]; } } while (0)
#define SC_WRITE(dptr, eptr, src, xs_, gs_) do { _Pragma("unroll") for (int i_ = 0; i_ < 8; ++i_) *(u32x4*)((dptr) + i_ * 1024) = src[i_]; \
        if (r == 6) { *(u32x4*)(eptr) = xs_[0]; *(u32x4*)((eptr) + 16) = xs_[1]; if (lane == 0) *(float*)((eptr) + 2048) = gs_; } } while (0)
        SC_LOAD(ra, xa, ga, 0); SC_WRITE(d0, e0, ra, xa, ga); SC_LOAD(ra, xa, ga, 1); SC_LOAD(rb, xb, gb, 2); SC_LOAD(rc, xc, gc, 3); SC_LOAD(rd, xd, gd, 4);
        SC_BAR();
        for (int c = 0; c < 128; c += 4) {
            SC_WRITE(d1, e1, ra, xa, ga); SC_LOAD(ra, xa, ga, c + 5); SC_BAR();
            SC_WRITE(d0, e0, rb, xb, gb); SC_LOAD(rb, xb, gb, c + 6); SC_BAR();
            SC_WRITE(d1, e1, rc, xc, gc); SC_LOAD(rc, xc, gc, c + 7); SC_BAR();
            SC_WRITE(d0, e0, rd, xd, gd); SC_LOAD(rd, xd, gd, c + 8); SC_BAR();
        }
        SC_BAR();
    } else {
        __builtin_amdgcn_s_setprio(3);
        bf16_t* OB = (bf16_t*)(p.ws + WS_KB) + (size_t)(4 * q4) * 1024 + h * 128 + 16 * nt + l16;
        f32x4 S[8];
#pragma unroll
        for (int i = 0; i < 8; ++i) S[i] = (f32x4){0.f, 0.f, 0.f, 0.f};
        SC_BAR();
        for (int c = 0; c < 128; c += 2) {
            scan_step(smem, S, OB + (size_t)(SC_CB(c) * 64) * 1024, lane); SC_BAR();
            scan_step(smem + BUFB, S, OB + (size_t)(SC_CB(c + 1) * 64) * 1024, lane); SC_BAR();
        }
        scan_step(smem, S, OB + (size_t)(SC_CB(128) * 64) * 1024, lane);
        SC_BAR();
        __builtin_amdgcn_s_setprio(0);
    }
#undef SC_LOAD
#undef SC_WRITE
#undef SC_CB
}

DI void phase_combine(const Params& p, int layer, unsigned char* smem) {
    const int tid0 = opaque_tid(p);
    bf16_t* pl = (bf16_t*)smem;
    float* rs = (float*)(smem + 66560);
    const bf16_t* OB = (const bf16_t*)(p.ws + WS_KB); const bf16_t* ZB = (const bf16_t*)(p.ws + WS_QB); const bf16_t* GA = (const bf16_t*)(p.ws + WS_VB); const bf16_t* GB = (const bf16_t*)(p.ws + WS_WB);
    const bf16_t* PB = (const bf16_t*)(p.ws + WS_QKB); bf16_t* YB = (bf16_t*)(p.ws + WS_KTB); const bf16_t* WPT = (const bf16_t*)(p.ws + WS_WPT);
    const float* hn = p.head_norm + layer * 128; const float* psc = p.pool_scale + layer * 1024;
    for (int cb = blockIdx.x; cb < 260; cb += gridDim.x) {
        int tid = tid0; asm volatile("" : "+v"(tid));
        const int lane = tid & 63, wid = tid >> 6, q4 = lane >> 4, l16 = lane & 15;
        if (cb >= 258) { const u32x4 z = {0u, 0u, 0u, 0u};
            for (int e = tid; e < 64 * 128; e += 512) *(u32x4*)(YB + (size_t)cb * 65536 + e * 8) = z;
            continue; }
        const bool meta = cb >= 256; const int b = meta ? cb - 256 : (cb >> 7);
#pragma unroll
        for (int rr = 0; rr < 8; ++rr) { const int t = 8 * wid + rr; const bf16_t* op = OB + (size_t)(cb * 64 + t) * 1024 + lane * 16;
            const u32x4 a = *(const u32x4*)op, c = *(const u32x4*)(op + 8);
            float ss = bflo(a.x) * bflo(a.x) + bfhi(a.x) * bfhi(a.x) + bflo(a.y) * bflo(a.y) + bfhi(a.y) * bfhi(a.y) + bflo(a.z) * bflo(a.z) + bfhi(a.z) * bfhi(a.z) + bflo(a.w) * bflo(a.w) + bfhi(a.w) * bfhi(a.w)
                     + bflo(c.x) * bflo(c.x) + bfhi(c.x) * bfhi(c.x) + bflo(c.y) * bflo(c.y) + bfhi(c.y) * bfhi(c.y) + bflo(c.z) * bflo(c.z) + bfhi(c.z) * bfhi(c.z) + bflo(c.w) * bflo(c.w) + bfhi(c.w) * bfhi(c.w);
            ss += __shfl_xor(ss, 1); ss += __shfl_xor(ss, 2); ss += __shfl_xor(ss, 4);
            if ((lane & 7) == 0) rs[t * 8 + (lane >> 3)] = rsqrtf(ss * (1.0f / 128.0f) + 1e-6f); }
        { const int t = tid >> 3, row0 = cb * 64 + t, pt = t - 48;
#pragma unroll
          for (int it = 0; it < 8; ++it) { const int g = it & 3, c8 = (tid & 7) + 8 * (it >> 2), win = 2 << g;
            int row = row0; asm volatile("" : "+v"(row));
            const int im = row - 8192 * b;
            u32x4 v[16];
#pragma unroll
            for (int d = 0; d < 16; ++d) if (d < win) {
                const bool ok = meta ? (d <= pt) : true; int pr; if (meta || im - d >= 0) pr = row - d; else pr = MMAIN + 64 * b + 64 + (im - d);
                v[d] = ok ? *(const u32x4*)(PB + (size_t)pr * 512 + g * 128 + c8 * 8) : (u32x4){0u, 0u, 0u, 0u}; }
            float acc[8];
#pragma unroll
            for (int j = 0; j < 8; ++j) acc[j] = 0.f;
#pragma unroll
            for (int d = 0; d < 16; ++d) if (d < win) { acc[0] += bflo(v[d].x); acc[1] += bfhi(v[d].x); acc[2] += bflo(v[d].y); acc[3] += bfhi(v[d].y); acc[4] += bflo(v[d].z); acc[5] += bfhi(v[d].z); acc[6] += bflo(v[d].w); acc[7] += bfhi(v[d].w); }
            int cnt = win; if (meta) { cnt = pt + 1 < win ? pt + 1 : win; if (cnt < 1) cnt = 1; }
            const float inv = 1.0f / (float)cnt; u32x4 w;
            w.x = pk2(acc[0] * inv - bflo(v[0].x), acc[1] * inv - bfhi(v[0].x)); w.y = pk2(acc[2] * inv - bflo(v[0].y), acc[3] * inv - bfhi(v[0].y));
            w.z = pk2(acc[4] * inv - bflo(v[0].z), acc[5] * inv - bfhi(v[0].z)); w.w = pk2(acc[6] * inv - bflo(v[0].w), acc[7] * inv - bfhi(v[0].w));
            *(u32x4*)(pl + t * 520 + g * 128 + c8 * 8) = w; asm volatile("" ::: "memory"); } }
        __syncthreads();
        { const int g = wid >> 1, colbase = 128 * wid; const bf16_t* wp = WPT + (size_t)g * 256 * 128 + (size_t)(colbase & 255) * 128;
#pragma unroll 1
          for (int j = 0; j < 4; ++j) { bf16x8 a0[4], a1[4];
              const int ca = 32 * j + 8 * (l16 >> 2) + (l16 & 3);
#pragma unroll
              for (int kb = 0; kb < 4; ++kb) { a0[kb] = *(const bf16x8*)(wp + ca * 128 + 32 * kb + 8 * q4); a1[kb] = *(const bf16x8*)(wp + (ca + 4) * 128 + 32 * kb + 8 * q4); }
              const int c0 = colbase + 32 * j + 8 * q4;
              const f32x4 hn0 = *(const f32x4*)(hn + (c0 & 127)), hn1 = *(const f32x4*)(hn + (c0 & 127) + 4), ps0 = *(const f32x4*)(psc + c0), ps1 = *(const f32x4*)(psc + c0 + 4);
              u32x4 o4[4], z4[4], a4[4], b4[4];
#pragma unroll
              for (int ntt = 0; ntt < 4; ++ntt) { const int t = 16 * ntt + l16; const size_t off = (size_t)(cb * 64 + t) * 1024 + c0;
                  if (!(meta && t < 48)) { o4[ntt] = *(const u32x4*)(OB + off); z4[ntt] = *(const u32x4*)(ZB + off); a4[ntt] = *(const u32x4*)(GA + off); b4[ntt] = *(const u32x4*)(GB + off); }
                  else { o4[ntt] = (u32x4){0u, 0u, 0u, 0u}; z4[ntt] = o4[ntt]; a4[ntt] = o4[ntt]; b4[ntt] = o4[ntt]; } }
#pragma unroll
              for (int ntt = 0; ntt < 4; ++ntt) { f32x4 d0 = {0.f, 0.f, 0.f, 0.f}, d1 = {0.f, 0.f, 0.f, 0.f};
#pragma unroll
                  for (int kb = 0; kb < 4; ++kb) { const bf16x8 bb = *(const bf16x8*)(pl + (16 * ntt + l16) * 520 + g * 128 + 32 * kb + 8 * q4); d0 = mfma16(a0[kb], bb, d0); d1 = mfma16(a1[kb], bb, d1); }
                  const int t = 16 * ntt + l16; const size_t off = (size_t)(cb * 64 + t) * 1024 + c0; u32x4 yo = {0u, 0u, 0u, 0u};
                  if (!(meta && t < 48)) {
                      const float rq = rs[t * 8 + wid];
                      const unsigned ow[4] = {o4[ntt].x, o4[ntt].y, o4[ntt].z, o4[ntt].w}, zw[4] = {z4[ntt].x, z4[ntt].y, z4[ntt].z, z4[ntt].w};
                      const unsigned aw[4] = {a4[ntt].x, a4[ntt].y, a4[ntt].z, a4[ntt].w}, bw[4] = {b4[ntt].x, b4[ntt].y, b4[ntt].z, b4[ntt].w};
                      float y[8];
#pragma unroll
                      for (int e = 0; e < 8; ++e) { const float ov = (e & 1) ? bfhi(ow[e >> 1]) : bflo(ow[e >> 1]), zv = (e & 1) ? bfhi(zw[e >> 1]) : bflo(zw[e >> 1]);
                          const float av = (e & 1) ? bfhi(aw[e >> 1]) : bflo(aw[e >> 1]), bv = (e & 1) ? bfhi(bw[e >> 1]) : bflo(bw[e >> 1]);
                          const float hv = e < 4 ? hn0[e & 3] : hn1[e & 3], pv = e < 4 ? ps0[e & 3] : ps1[e & 3], dv = e < 4 ? d0[e & 3] : d1[e & 3];
                          y[e] = sigm(av) * (ov * rq * hv * silu(zv)) + sigm(bv) * (dv * pv); }
                      yo.x = pk2(y[0], y[1]); yo.y = pk2(y[2], y[3]); yo.z = pk2(y[4], y[5]); yo.w = pk2(y[6], y[7]); }
                  *(u32x4*)(YB + off) = yo; } } }
        __syncthreads();
    }
}

DI void phase_convact(const Params& p, int layer) {
    const int tid = opaque_tid(p);
    bf16_t* HID = (bf16_t*)(p.ws + WS_QB); const bf16_t* HALO = (const bf16_t*)(p.ws + WS_HALO);
    const float* cw = p.conv_ffn + (size_t)layer * 3 * FF2;
    if (tid >= 352) return;
    const int j0 = tid * 8;
    float wg[3][8], wv[3][8];
#pragma unroll
    for (int j = 0; j < 3; ++j)
#pragma unroll
        for (int e = 0; e < 8; ++e) { wg[j][e] = cw[j * FF2 + j0 + e]; wv[j][e] = cw[j * FF2 + DFF + j0 + e]; }
    for (int cb = blockIdx.x; cb < 258; cb += gridDim.x) {
        const bool meta = cb >= 256; const int prev = meta ? -1 : ((cb & 127) == 0 ? 256 + (cb >> 7) : cb - 1);
        float g1[8], g2[8], v1[8], v2[8];
        if (prev >= 0) { const bf16_t* hp = HALO + (size_t)prev * 2 * FF2;
            const u32x4 a = *(const u32x4*)(hp + j0), c = *(const u32x4*)(hp + DFF + j0), a1 = *(const u32x4*)(hp + FF2 + j0), c1 = *(const u32x4*)(hp + FF2 + DFF + j0);
            g2[0] = bflo(a.x); g2[1] = bfhi(a.x); g2[2] = bflo(a.y); g2[3] = bfhi(a.y); g2[4] = bflo(a.z); g2[5] = bfhi(a.z); g2[6] = bflo(a.w); g2[7] = bfhi(a.w);
            v2[0] = bflo(c.x); v2[1] = bfhi(c.x); v2[2] = bflo(c.y); v2[3] = bfhi(c.y); v2[4] = bflo(c.z); v2[5] = bfhi(c.z); v2[6] = bflo(c.w); v2[7] = bfhi(c.w);
            g1[0] = bflo(a1.x); g1[1] = bfhi(a1.x); g1[2] = bflo(a1.y); g1[3] = bfhi(a1.y); g1[4] = bflo(a1.z); g1[5] = bfhi(a1.z); g1[6] = bflo(a1.w); g1[7] = bfhi(a1.w);
            v1[0] = bflo(c1.x); v1[1] = bfhi(c1.x); v1[2] = bflo(c1.y); v1[3] = bfhi(c1.y); v1[4] = bflo(c1.z); v1[5] = bfhi(c1.z); v1[6] = bflo(c1.w); v1[7] = bfhi(c1.w);
        } else {
#pragma unroll
            for (int e = 0; e < 8; ++e) { g1[e] = 0.f; g2[e] = 0.f; v1[e] = 0.f; v2[e] = 0.f; } }
        for (int tb = meta ? 48 : 0; tb < 64; tb += 8) {
            u32x4 rg[8], rv[8];
#pragma unroll
            for (int i = 0; i < 8; ++i) { const bf16_t* hp = HID + (size_t)(cb * 64 + tb + i) * FF2 + j0; rg[i] = *(const u32x4*)hp; rv[i] = *(const u32x4*)(hp + DFF); }
#pragma unroll
            for (int i = 0; i < 8; ++i) {
                const float g0[8] = {bflo(rg[i].x), bfhi(rg[i].x), bflo(rg[i].y), bfhi(rg[i].y), bflo(rg[i].z), bfhi(rg[i].z), bflo(rg[i].w), bfhi(rg[i].w)};
                const float v0[8] = {bflo(rv[i].x), bfhi(rv[i].x), bflo(rv[i].y), bfhi(rv[i].y), bflo(rv[i].z), bfhi(rv[i].z), bflo(rv[i].w), bfhi(rv[i].w)};
                float a[8];
#pragma unroll
                for (int e = 0; e < 8; ++e) { const float cg = wg[0][e] * g2[e] + wg[1][e] * g1[e] + wg[2][e] * g0[e], cv = wv[0][e] * v2[e] + wv[1][e] * v1[e] + wv[2][e] * v0[e];
                    a[e] = silu(cg) * cv; g2[e] = g1[e]; g1[e] = g0[e]; v2[e] = v1[e]; v1[e] = v0[e]; }
                u32x4 w; w.x = pk2(a[0], a[1]); w.y = pk2(a[2], a[3]); w.z = pk2(a[4], a[5]); w.w = pk2(a[6], a[7]);
                *(u32x4*)(HID + (size_t)(cb * 64 + tb + i) * FF2 + j0) = w;
            }
        }
    }
}

__global__ void __launch_bounds__(512, 2) mega_fwd(Params p0) {
    extern __shared__ __attribute__((aligned(16))) unsigned char smem[];
    cg::grid_group grid = cg::this_grid();
    PG8_LAS unsigned char* lds = (PG8_LAS unsigned char*)smem;
    const int G = (int)gridDim.x, c = (int)blockIdx.x;
    Params p = p0; p.wid0 = __builtin_amdgcn_readfirstlane((int)threadIdx.x >> 6);
    const bool t0 = (threadIdx.x == 0);
    volatile LAS unsigned* xst = (volatile LAS unsigned*)(lds + 131072);
    if (threadIdx.x < 4) xst[threadIdx.x] = 0u;
    __syncthreads();
    const XcdBarrier xbar = xcd_barrier_post((unsigned*)(p0.ws + WS_BAR), xst, t0);
    bool first_seam = true;
#define GSYNC() do { if (first_seam) { grid.sync(); first_seam = false; } else xcd_barrier(xbar, (p.wid0 == 0) && (__builtin_amdgcn_mbcnt_hi(~0u, __builtin_amdgcn_mbcnt_lo(~0u, 0u)) == 0u)); } while (0)
#define FRESH() do { size_t z_ = 0; asm volatile("" : "+s"(z_)); p.ws = p0.ws + z_; p.out = p0.out + z_; } while (0)
#define WSP(off) ((bf16_t*)(p.ws + (off)))
#pragma unroll 1
    for (int layer = 0; layer < 2; ++layer) {
        FRESH(); phase_norm(p, layer, 0, smem); GSYNC();
#if PROBE == 6
        FRESH(); phase_norm(p, layer, 0, smem); GSYNC();
#endif
        FRESH();
        { pg8::Gemm g{WSP(WS_U), WSP(WS_WIN), MPAD, 3072, 1024, 1024, 1024}; pg8::StaticOrder S; S.init(MPAD, 3072, G, c); EpiQKV E{WSP(WS_QB), WSP(WS_HALO)}; pg8::gemm_phase<EpiQKV, pg8::StaticOrder>(lds, g, S, E, opaque_tid(p)); }
        GSYNC();
        FRESH(); phase_p3(p, layer, smem); GSYNC();
#if PROBE == 2
        FRESH();
        { pg8::Gemm g{WSP(WS_U), WSP(WS_WIN), MPAD, 3072, 1024, 1024, 1024}; pg8::StaticOrder S; S.init(MPAD, 3072, G, c); EpiQKV E{WSP(WS_QB), WSP(WS_HALO)}; pg8::gemm_phase<EpiQKV, pg8::StaticOrder>(lds, g, S, E, opaque_tid(p)); }
        GSYNC();
        FRESH(); phase_p3(p, layer, smem); GSYNC();
#endif
        FRESH(); phase_scan(p, smem); GSYNC();
#if PROBE == 3
        FRESH(); phase_scan(p, smem); GSYNC();
#endif
        FRESH();
        { pg8::Gemm g{WSP(WS_U), WSP(WS_WIN) + (size_t)3072 * 1024, MPAD, 3584, 1024, 1024, 1024}; pg8::StaticOrder S; S.init(MPAD, 3584, G, c); EpiZPG E{WSP(WS_QB)}; pg8::gemm_phase<EpiZPG, pg8::StaticOrder>(lds, g, S, E, opaque_tid(p)); }
        GSYNC();
        FRESH(); phase_combine(p, layer, smem); GSYNC();
#if PROBE == 4
        FRESH(); phase_combine(p, layer, smem); GSYNC();
#endif
        FRESH();
        { pg8::Gemm g{WSP(WS_KTB), WSP(WS_WOUT), MPAD, 1024, 1024, 1024, 1024}; pg8::StaticOrder S; S.init(MPAD, 1024, G, c); EpiRes E{p.out, (float*)(p.ws + WS_HM)}; pg8::gemm_phase<EpiRes, pg8::StaticOrder>(lds, g, S, E, opaque_tid(p)); }
        GSYNC();
        FRESH(); phase_norm(p, layer, 1, smem); GSYNC();
        FRESH();
        { pg8::Gemm g{WSP(WS_U), WSP(WS_WUP), MPAD, FF2, 1024, 1024, 1024}; pg8::StaticOrder S; S.init(MPAD, FF2, G, c); EpiHid E{WSP(WS_QB), WSP(WS_HALO)}; pg8::gemm_phase<EpiHid, pg8::StaticOrder>(lds, g, S, E, opaque_tid(p)); }
        GSYNC();
#if PROBE == 7
        FRESH();
        { pg8::Gemm g{WSP(WS_U), WSP(WS_WUP), MPAD, FF2, 1024, 1024, 1024}; pg8::StaticOrder S; S.init(MPAD, FF2, G, c); EpiHid E{WSP(WS_QB), WSP(WS_HALO)}; pg8::gemm_phase<EpiHid, pg8::StaticOrder>(lds, g, S, E, opaque_tid(p)); }
        GSYNC();
#endif
        FRESH(); phase_convact(p, layer); GSYNC();
#if PROBE == 5
        FRESH();
        { pg8::Gemm g{WSP(WS_U), WSP(WS_WUP), MPAD, FF2, 1024, 1024, 1024}; pg8::StaticOrder S; S.init(MPAD, FF2, G, c); EpiHid E{WSP(WS_QB), WSP(WS_HALO)}; pg8::gemm_phase<EpiHid, pg8::StaticOrder>(lds, g, S, E, opaque_tid(p)); }
        GSYNC();
        FRESH(); phase_convact(p, layer); GSYNC();
#endif
        FRESH();
        { pg8::Gemm g{WSP(WS_QB), WSP(WS_WDN), MPAD, 1024, DFF, FF2, DFF}; pg8::StaticOrder S; S.init(MPAD, 1024, G, c); EpiRes E{p.out, (float*)(p.ws + WS_HM)}; pg8::gemm_phase<EpiRes, pg8::StaticOrder>(lds, g, S, E, opaque_tid(p)); }
        GSYNC();
    }
#if PROBE == 8
    for (int i = 0; i < 20; ++i) GSYNC();
#endif
    FRESH(); phase_final(p);
#undef FRESH
#undef WSP
#undef GSYNC
}

extern "C" void kernel_launch(void* const* d_in, const int* in_sizes, int n_in, void* d_out, int out_size, void* d_ws, size_t ws_size, hipStream_t stream) {
    static int grid_blocks = 0;
    if (!grid_blocks) {
        int dev = 0, cus = 0, per_cu = 0;
        hipGetDevice(&dev);
        hipDeviceGetAttribute(&cus, hipDeviceAttributeMultiprocessorCount, dev);
        if (hipFuncSetAttribute((const void*)mega_fwd, hipFuncAttributeMaxDynamicSharedMemorySize, LDS_BYTES) != hipSuccess) fprintf(stderr, "hipFuncSetAttribute failed\n");
        hipOccupancyMaxActiveBlocksPerMultiprocessor(&per_cu, (const void*)mega_fwd, 512, LDS_BYTES);
        if (per_cu < 1) { fprintf(stderr, "occupancy query reports %d blocks/CU\n", per_cu); per_cu = 1; }
        if (per_cu > 1) per_cu = 1;
        grid_blocks = cus * per_cu;
        if (ws_size < WS_END) fprintf(stderr, "workspace too small: %zu < %zu\n", ws_size, (size_t)WS_END);
    }
    Params p{};
    p.x = (const float*)d_in[0]; p.meta = (const float*)d_in[1]; p.norm_mix = (const float*)d_in[2]; p.w_in = (const float*)d_in[3]; p.conv_qkv = (const float*)d_in[4];
    p.a_log = (const float*)d_in[5]; p.dt_bias = (const float*)d_in[6]; p.head_norm = (const float*)d_in[7]; p.w_pool = (const float*)d_in[8]; p.pool_scale = (const float*)d_in[9];
    p.w_out = (const float*)d_in[10]; p.norm_ffn = (const float*)d_in[11]; p.w_up = (const float*)d_in[12]; p.conv_ffn = (const float*)d_in[13]; p.w_down = (const float*)d_in[14]; p.norm_final = (const float*)d_in[15];
    p.out = (float*)d_out; p.ws = (unsigned char*)d_ws;
    (void)hipMemsetAsync((unsigned char*)d_ws + WS_BAR, 0, (size_t)XCD_BAR_WORDS * 4, stream);
    void* args[] = {&p};
    hipError_t e = hipLaunchCooperativeKernel((const void*)mega_fwd, dim3(grid_blocks), dim3(512), args, LDS_BYTES, stream);
    if (e != hipSuccess) fprintf(stderr, "cooperative launch failed: %s (grid %d)\n", hipGetErrorString(e), grid_blocks);
}
```

```cpp
#include <hip/hip_runtime.h>
#include <hip/hip_cooperative_groups.h>
#include <cstdio>
namespace cg = cooperative_groups;
#ifndef PROBE
#define PROBE 0
#endif
#include <hip/hip_runtime.h>
namespace pg8 {
#define PG8_LAS __attribute__((address_space(3)))
typedef unsigned short bf16_t;
typedef short bf16x8 __attribute__((ext_vector_type(8)));
typedef float f32x4 __attribute__((ext_vector_type(4)));
typedef unsigned u32x4 __attribute__((ext_vector_type(4)));
constexpr int BM = 256, BK = 64, HALF = 128, HTB = HALF * BK * 2  , STAGE_BYTES = 8 * HTB, NXCD = 8, WGM = 8;

__host__ __device__ __forceinline__ int lds_byte(int r, int c) { const int st = (r >> 4) * 2 + (c >> 5), rr = r & 15, cc = c & 31, ob = rr * 64 + cc * 2; return st * 1024 + (ob ^ (((ob >> 9) & 1) << 5)); }
__host__ __device__ __forceinline__ void stage_rc(int b, int& R, int& C) { const int st = b / 1024, sb = b % 1024, swz = sb ^ (((sb >> 9) & 1) << 5); R = (st >> 1) * 16 + swz / 64; C = (st & 1) * 32 + (swz % 64) / 2; }
__host__ __device__ __forceinline__ int perm32(int rho) { const int n = rho >> 4, i = rho & 15; return 8 * (i >> 2) + 4 * n + (i & 3); }

struct Unit { int pm, pn; };
struct Gemm { const bf16_t* A; const bf16_t* Bt; int M, N, K, lda, ldb; };

struct StaticOrder {
    int nM, nN, nwg, G, c;
    __host__ __device__ void init(int M, int N, int G_, int c_) { nM = M / BM; nN = N / BM; nwg = nM * nN; G = G_; c = c_; }
    __host__ __device__ bool next(int i, Unit& u) const {
        const long L = (long)i * G + c; if (L >= nwg) return false;
        int wgid = (int)L; { const int q = nwg / NXCD, r = nwg % NXCD, xcd = wgid % NXCD, off = wgid / NXCD; wgid = (xcd < r ? xcd * (q + 1) : r * (q + 1) + (xcd - r) * q) + off; }
        const int nig = WGM * nN, gid = wgid / nig, fm = gid * WGM, gsz = (nM - fm) < WGM ? (nM - fm) : WGM;
        u.pm = fm + ((wgid % nig) % gsz); u.pn = (wgid % nig) / gsz; return true;
    }
    __device__ __forceinline__ void a_ready(const Unit&) const {}
    __device__ __forceinline__ void done(const Unit&) const {}
};

template <class Epi, class Sched>
__device__ __forceinline__ void gemm_phase(PG8_LAS unsigned char* lds, const Gemm g, const Sched& S, const Epi& E, int tid_in) {
    int tid = tid_in; asm volatile("" : "+v"(tid)); const int wid = __builtin_amdgcn_readfirstlane(tid >> 6), lane = tid & 63, wr = wid >> 2, wc = wid & 3, fr = lane & 15, fq = lane >> 4;
    const int K = g.K, nt = K / BK;
    unsigned voffA[2], voffB[2];
#pragma unroll
    for (int i = 0; i < 2; ++i) { int R, C; stage_rc(tid * 16 + i * 8192, R, C); const int Rb = Epi::PERM ? ((R & ~31) + perm32(R & 31)) : R;
        voffA[i] = (unsigned)(R * g.lda + C) * 2u; voffB[i] = (unsigned)(Rb * g.ldb + C) * 2u; }
    const size_t kstep = (size_t)(BK * 2);
    const size_t hstepA = (size_t)HALF * g.lda * 2, hstepB = (size_t)HALF * g.ldb * 2;
    const size_t tstepA = 2 * hstepA, tstepB = 2 * hstepB;
    const unsigned ldsw = (unsigned)wid * 1024u;
    const int aoff = lds_byte(wr * 64 + fr, fq * 8), boff = lds_byte(wc * 32 + fr, fq * 8);
#define PG8_SA(b, h) (((b) * 2 + (h)) * HTB)
#define PG8_SB(b, h) ((4 + (b) * 2 + (h)) * HTB)
#define PG8_STAGE(bufoff, gbase, voff) do { _Pragma("unroll") for (int _i = 0; _i < 2; ++_i) \
        __builtin_amdgcn_global_load_lds((const unsigned*)((const char*)(gbase) + (voff)[_i]), (PG8_LAS unsigned*)(lds + (bufoff) + ldsw + _i * 8192), 16, 0, 0); } while (0)
#define PG8_LDA(dst, b, h) do { _Pragma("unroll") for (int m = 0; m < 4; ++m) _Pragma("unroll") for (int k = 0; k < 2; ++k) dst[m][k] = *(const PG8_LAS bf16x8*)(lds + PG8_SA(b, h) + aoff + m * 2048 + k * 1024); } while (0)
#define PG8_LDB(dst, b, h) do { _Pragma("unroll") for (int n = 0; n < 2; ++n) _Pragma("unroll") for (int k = 0; k < 2; ++k) dst[n][k] = *(const PG8_LAS bf16x8*)(lds + PG8_SB(b, h) + boff + n * 2048 + k * 1024); } while (0)
#define PG8_MMA(ai, bj, At, Bt) do { __builtin_amdgcn_s_setprio(1); _Pragma("unroll") for (int m = 0; m < 4; ++m) _Pragma("unroll") for (int n = 0; n < 2; ++n) _Pragma("unroll") for (int k = 0; k < 2; ++k) \
        acc[ai][bj][m][n] = __builtin_amdgcn_mfma_f32_16x16x32_bf16(Bt[n][k], At[m][k], acc[ai][bj][m][n], 0, 0, 0); __builtin_amdgcn_s_setprio(0); } while (0)
#define PG8_WAIT_V(n) asm volatile("s_waitcnt vmcnt(" #n ")" ::: "memory")
#define PG8_WAIT_L(n) asm volatile("s_waitcnt lgkmcnt(" #n ")" ::: "memory")
#define PG8_BAR __builtin_amdgcn_s_barrier()
#define PG8_SCHED __builtin_amdgcn_sched_barrier(0)
    Unit cur, nxt; int ui = 0;
    if (!S.next(0, cur)) return;
    f32x4 acc[2][2][4][2];
#pragma unroll
    for (int a = 0; a < 2; ++a)
#pragma unroll
        for (int b = 0; b < 2; ++b)
#pragma unroll
            for (int m = 0; m < 4; ++m)
#pragma unroll
                for (int n = 0; n < 2; ++n) acc[a][b][m][n] = (f32x4){0.f, 0.f, 0.f, 0.f};
    bf16x8 At[4][2], B0[2][2], B1[2][2];
    const char* cA = (const char*)g.A + (size_t)cur.pm * tstepA; const char* cB = (const char*)g.Bt + (size_t)cur.pn * tstepB;
    S.a_ready(cur);
    PG8_STAGE(PG8_SB(0, 0), cB, voffB); PG8_STAGE(PG8_SA(0, 0), cA, voffA); PG8_STAGE(PG8_SB(0, 1), cB + hstepB, voffB); PG8_STAGE(PG8_SA(0, 1), cA + hstepA, voffA);
    if (wr == 1) PG8_BAR;
    PG8_WAIT_V(4); PG8_BAR;
    PG8_STAGE(PG8_SB(1, 0), cB + kstep, voffB); PG8_STAGE(PG8_SA(1, 0), cA + kstep, voffA); PG8_STAGE(PG8_SB(1, 1), cB + hstepB + kstep, voffB);
    PG8_WAIT_V(6); PG8_BAR;
    for (;;) {
        const bool has_next = S.next(ui + 1, nxt);
        const char* nA = has_next ? (const char*)g.A + (size_t)nxt.pm * tstepA : cA; const char* nB = has_next ? (const char*)g.Bt + (size_t)nxt.pn * tstepB : cB;
        for (int t = 0; t < nt; t += 2) {
            const bool last = (t == nt - 2);
            const char* a1 = cA + (size_t)(t + 1) * kstep;
            const char* a2 = last ? nA : cA + (size_t)(t + 2) * kstep; const char* b2 = last ? nB : cB + (size_t)(t + 2) * kstep;
            const char* a3 = a2 + kstep; const char* b3 = b2 + kstep;
            if (last && has_next) S.a_ready(nxt);
            PG8_LDB(B0, 0, 0); PG8_SCHED; PG8_LDA(At, 0, 0); PG8_STAGE(PG8_SA(1, 1), a1 + hstepA, voffA);
            PG8_WAIT_L(8); PG8_BAR; PG8_WAIT_L(0); PG8_MMA(0, 0, At, B0); PG8_BAR; PG8_SCHED;
            PG8_LDB(B1, 0, 1); PG8_STAGE(PG8_SB(0, 0), b2, voffB);
            PG8_BAR; PG8_WAIT_L(0); PG8_MMA(0, 1, At, B1); PG8_BAR;
            PG8_LDA(At, 0, 1); PG8_STAGE(PG8_SA(0, 0), a2, voffA);
            PG8_BAR; PG8_WAIT_L(0); PG8_MMA(1, 0, At, B0); PG8_BAR; PG8_SCHED;
            PG8_STAGE(PG8_SB(0, 1), b2 + hstepB, voffB);
            PG8_WAIT_V(6); PG8_BAR; PG8_MMA(1, 1, At, B1); PG8_BAR;
            PG8_LDB(B0, 1, 0); PG8_SCHED; PG8_LDA(At, 1, 0); PG8_STAGE(PG8_SA(0, 1), a2 + hstepA, voffA);
            PG8_WAIT_L(8); PG8_BAR; PG8_WAIT_L(0); PG8_MMA(0, 0, At, B0); PG8_BAR; PG8_SCHED;
            PG8_LDB(B1, 1, 1); PG8_STAGE(PG8_SB(1, 0), b3, voffB);
            PG8_BAR; PG8_WAIT_L(0); PG8_MMA(0, 1, At, B1); PG8_BAR;
            PG8_LDA(At, 1, 1); PG8_STAGE(PG8_SA(1, 0), a3, voffA);
            PG8_BAR; PG8_WAIT_L(0); PG8_MMA(1, 0, At, B0); PG8_BAR; PG8_SCHED;
            PG8_STAGE(PG8_SB(1, 1), b3 + hstepB, voffB);
            PG8_WAIT_V(6); PG8_BAR; PG8_MMA(1, 1, At, B1); PG8_BAR;
        }
        if constexpr (!Epi::AFTER_DRAIN) { E(acc, cur, wr, wc, fr, fq); S.done(cur); }
        if (!has_next) break;
#pragma unroll
        for (int a = 0; a < 2; ++a)
#pragma unroll
            for (int b = 0; b < 2; ++b)
#pragma unroll
                for (int m = 0; m < 4; ++m)
#pragma unroll
                    for (int n = 0; n < 2; ++n) acc[a][b][m][n] = (f32x4){0.f, 0.f, 0.f, 0.f};
        cur = nxt; cA = nA; cB = nB; ++ui;
    }
    PG8_WAIT_V(0);
    if (wr == 0) PG8_BAR;
    PG8_BAR;
    if constexpr (Epi::AFTER_DRAIN) { E.fused(acc, cur, wr, wc, fr, fq, lds, wid, lane); S.done(cur); }
#undef PG8_SA
#undef PG8_SB
#undef PG8_STAGE
#undef PG8_LDA
#undef PG8_LDB
#undef PG8_MMA
#undef PG8_WAIT_V
#undef PG8_WAIT_L
#undef PG8_BAR
#undef PG8_SCHED
}
}


#define XB_TMO      128
#define XB_XCNT(j)  (256  + 64 * (j))
#define XB_XSUB(j)  (1280 + 64 * (j))
#define XB_XGEN(j)  (2304 + 64 * (j))
#define XB_TOP      3328
#define XB_TOPGEN   3392
#define XCD_BAR_WORDS 3456
#define XB_SPIN_CAP (1u << 18)
#define LAS __attribute__((address_space(3)))

__device__ __forceinline__ unsigned xb_ld(unsigned* p)              { return __hip_atomic_load(p, __ATOMIC_RELAXED, __HIP_MEMORY_SCOPE_AGENT); }
__device__ __forceinline__ unsigned xb_add(unsigned* p, unsigned v) { return __hip_atomic_fetch_add(p, v, __ATOMIC_RELAXED, __HIP_MEMORY_SCOPE_AGENT); }
__device__ __forceinline__ unsigned xb_xcc_id() { return (unsigned)__builtin_amdgcn_s_getreg((3 << 11) | 20) & 0xFu; }
#define XB_SPIN(cond, bar) do { unsigned _sp = 0; while (cond) { __builtin_amdgcn_s_sleep(1); \
    if ((++_sp & 255u) == 0u) { if (xb_ld(&(bar)[XB_TMO])) break; if (_sp > XB_SPIN_CAP) { atomicAdd(&(bar)[XB_TMO], 1u); break; } } } } while (0)

struct XcdBarrier { unsigned* bar; unsigned x; volatile LAS unsigned* st; };
__device__ __forceinline__ XcdBarrier xcd_barrier_post(unsigned* bar, volatile LAS unsigned* st, bool t0) {
    XcdBarrier b; b.bar = bar; b.x = xb_xcc_id(); b.st = st;
    if (t0) (void)xb_add(&bar[XB_XCNT(b.x)], 1u);
    return b;
}
__device__ __forceinline__ void xcd_barrier_complete(unsigned* bar, unsigned x, unsigned& nloc, unsigned& nx) {
    const unsigned G = gridDim.x * gridDim.y * gridDim.z;
    unsigned sum, cnt, mine, sp = 0u;
    for (;;) {
        sum = 0u; cnt = 0u; mine = 0u;
#pragma unroll
        for (unsigned j = 0; j < 16; ++j) { const unsigned c = xb_ld(&bar[XB_XCNT(j)]); sum += c; cnt += (c > 0u) ? 1u : 0u; mine = (j == x) ? c : mine; }
        if (sum == G) break;
        __builtin_amdgcn_s_sleep(1);
        if ((++sp & 255u) == 0u) { if (xb_ld(&bar[XB_TMO])) break; if (sp > XB_SPIN_CAP) { atomicAdd(&bar[XB_TMO], 1u); break; } }
    }
    nloc = mine > 0u ? mine : 1u; nx = cnt > 0u ? cnt : 1u;
}
__device__ __forceinline__ void xcd_barrier(const XcdBarrier& b, bool t0) {
    asm volatile("s_waitcnt vmcnt(0)" ::: "memory");
    __syncthreads();
    if (t0) {
        unsigned* bar = b.bar;
        __builtin_amdgcn_s_waitcnt(0);
        unsigned nloc = b.st[0], nx = b.st[1];
        if (nloc == 0u) { xcd_barrier_complete(bar, b.x, nloc, nx); b.st[0] = nloc; b.st[1] = nx; }
        const unsigned old = xb_add(&bar[XB_XSUB(b.x)], 1u);
        const unsigned gen = old / nloc;
        if (old + 1u == (gen + 1u) * nloc) {
            __builtin_amdgcn_fence(__ATOMIC_RELEASE, "agent");
            asm volatile("s_waitcnt vmcnt(0)" ::: "memory");
            const unsigned og = xb_add(&bar[XB_TOP], 1u);
            const unsigned tg = og / nx;
            if (og + 1u == (tg + 1u) * nx) xb_add(&bar[XB_TOPGEN], 1u);
            else XB_SPIN(xb_ld(&bar[XB_TOPGEN]) == tg, bar);
            __builtin_amdgcn_fence(__ATOMIC_ACQUIRE, "agent");
            xb_add(&bar[XB_XGEN(b.x)], 1u);
            asm volatile("s_waitcnt vmcnt(0)" ::: "memory");
        } else {
            XB_SPIN(xb_ld(&bar[XB_XGEN(b.x)]) == gen, bar);
            __builtin_amdgcn_fence(__ATOMIC_ACQUIRE, "agent");
            asm volatile("s_waitcnt vmcnt(0)" ::: "memory");
        }
    }
    __syncthreads();
}

using pg8::bf16_t; using pg8::bf16x8; using pg8::f32x4; using pg8::u32x4;
typedef unsigned u32x2 __attribute__((ext_vector_type(2)));
typedef __bf16 bf16x2_t __attribute__((ext_vector_type(2)));
typedef float f32x2 __attribute__((ext_vector_type(2)));
#define DI __device__ __forceinline__

constexpr int MMAIN = 16384, MPAD = 16640, IN_DIM = 6672, DFF = 2816, FF2 = 5632;
constexpr size_t SZ_ACT = (size_t)MPAD * 1024 * 2;
constexpr size_t WS_WIN = 0;
constexpr size_t WS_WOUT = WS_WIN + (size_t)6656 * 1024 * 2;
constexpr size_t WS_WUP = WS_WOUT + (size_t)1024 * 1024 * 2;
constexpr size_t WS_WDN = WS_WUP + (size_t)5632 * 1024 * 2;
constexpr size_t WS_WPT = WS_WDN + (size_t)1024 * 2816 * 2;
constexpr size_t WS_U = WS_WPT + (size_t)4 * 256 * 128 * 2;
constexpr size_t WS_QB = WS_U + SZ_ACT;
constexpr size_t WS_KB = WS_QB + SZ_ACT;
constexpr size_t WS_VB = WS_KB + SZ_ACT;
constexpr size_t WS_WB = WS_VB + SZ_ACT;
constexpr size_t WS_KTB = WS_WB + SZ_ACT;
constexpr size_t WS_QKB = WS_KTB + SZ_ACT;
constexpr size_t WS_HALO = WS_QKB + (size_t)260 * 8 * 4096 * 2;
constexpr size_t WS_BA = WS_HALO + (size_t)260 * 2 * 5632 * 2;
constexpr size_t WS_HM = WS_BA + (size_t)MPAD * 16 * 4;
constexpr size_t WS_GT = WS_HM + (size_t)256 * 1024 * 4;
constexpr size_t WS_BAR = WS_GT + (size_t)260 * 8 * 4 + 64;
constexpr size_t WS_END = WS_BAR + (size_t)XCD_BAR_WORDS * 4;
static_assert(WS_QKB + (size_t)260 * 8 * 4096 * 2 - WS_QB == (size_t)MPAD * FF2 * 2, "hid overlay");
static_assert(WS_END <= 268435456ull, "workspace");
constexpr int LDS_BYTES = 131072 + 16;

struct Params {
    const float *x, *meta, *norm_mix, *w_in, *conv_qkv, *a_log, *dt_bias, *head_norm, *w_pool, *pool_scale, *w_out, *norm_ffn, *w_up, *conv_ffn, *w_down, *norm_final;
    float* out; unsigned char* ws; int wid0, pad0;
};

DI int lane_id_fresh() { int l; asm volatile("v_mbcnt_lo_u32_b32 %0, -1, 0\n\tv_mbcnt_hi_u32_b32 %0, -1, %0" : "=&v"(l)); return l; }
DI int opaque_tid(const Params& p) { return (p.wid0 << 6) | lane_id_fresh(); }
DI unsigned pk2(float a, float b) { f32x2 v = {a, b}; bf16x2_t r = __builtin_convertvector(v, bf16x2_t); return __builtin_bit_cast(unsigned, r); }
DI bf16_t f2bf(float a) { return (bf16_t)(pk2(a, 0.f) & 0xffffu); }
DI float bflo(unsigned w) { return __uint_as_float(w << 16); }
DI float bfhi(unsigned w) { return __uint_as_float(w & 0xffff0000u); }
DI float bf2f(bf16_t b) { return __uint_as_float(((unsigned)b) << 16); }
DI bf16x8 pack8(f32x4 a, f32x4 b) { u32x4 w; w.x = pk2(a[0], a[1]); w.y = pk2(a[2], a[3]); w.z = pk2(b[0], b[1]); w.w = pk2(b[2], b[3]); return __builtin_bit_cast(bf16x8, w); }
DI f32x4 mfma16(bf16x8 a, bf16x8 b, f32x4 c) { return __builtin_amdgcn_mfma_f32_16x16x32_bf16(a, b, c, 0, 0, 0); }
DI float sigm(float x) { return __builtin_amdgcn_rcpf(1.0f + __expf(-x)); }
DI float silu(float x) { return x * __builtin_amdgcn_rcpf(1.0f + __expf(-x)); }
DI float wsum(float v) { v += __shfl_xor(v, 32); v += __shfl_xor(v, 16); v += __shfl_xor(v, 8); v += __shfl_xor(v, 4); v += __shfl_xor(v, 2); v += __shfl_xor(v, 1); return v; }
DI float* hrow(const Params& p, int r) { return r < MMAIN ? p.out + (size_t)r * 1024 : (float*)(p.ws + WS_HM) + (size_t)(r - MMAIN) * 1024; }

struct EpiQKV {
    static constexpr bool PERM = true, AFTER_DRAIN = false;
    bf16_t *Q, *halo;
    DI void operator()(const f32x4 (&acc)[2][2][4][2], const pg8::Unit& u, int wr, int wc, int fr, int fq) const {
        const int which = u.pn >> 2; bf16_t* base = Q + (size_t)which * (SZ_ACT / 2);
#pragma unroll
        for (int ai = 0; ai < 2; ++ai)
#pragma unroll
            for (int m = 0; m < 4; ++m) {
                const int cb = u.pm * 4 + ai * 2 + wr, rr = m * 16 + fr;
#pragma unroll
                for (int bj = 0; bj < 2; ++bj) {
                    const int head = (u.pn & 3) * 2 + bj, cc = wc * 32 + 8 * fq;
                    const f32x4 v0 = acc[ai][bj][m][0], v1 = acc[ai][bj][m][1];
                    u32x4 w; w.x = pk2(v0[0], v0[1]); w.y = pk2(v0[2], v0[3]); w.z = pk2(v1[0], v1[1]); w.w = pk2(v1[2], v1[3]);
                    *(u32x4*)(base + ((size_t)(cb * 8 + head) * 64 + rr) * 128 + cc) = w;
                    if (m == 3 && fr >= 13) *(u32x4*)(halo + ((size_t)cb * 3 + (rr - 61)) * 3072 + u.pn * 256 + bj * 128 + cc) = w;
                }
            }
    }
};
struct EpiZPG {
    static constexpr bool PERM = true, AFTER_DRAIN = false;
    bf16_t *QB0;
    DI void operator()(const f32x4 (&acc)[2][2][4][2], const pg8::Unit& u, int wr, int wc, int fr, int fq) const {
        const int ge4 = u.pn >= 4, ge6 = u.pn >= 6, ge10 = u.pn >= 10, idx = ge4 + ge6 + ge10, is1 = (idx == 1);
        const int slot = idx + 4 * is1, ld = 1024 >> is1, c0 = (u.pn - (4 * ge4 + 2 * ge6 + 4 * ge10)) * 256;
        bf16_t* base = QB0 + (size_t)slot * (SZ_ACT / 2);
#pragma unroll
        for (int ai = 0; ai < 2; ++ai)
#pragma unroll
            for (int m = 0; m < 4; ++m) {
                const int row = u.pm * 256 + ai * 128 + wr * 64 + m * 16 + fr;
#pragma unroll
                for (int bj = 0; bj < 2; ++bj) {
                    const f32x4 v0 = acc[ai][bj][m][0], v1 = acc[ai][bj][m][1];
                    u32x4 w; w.x = pk2(v0[0], v0[1]); w.y = pk2(v0[2], v0[3]); w.z = pk2(v1[0], v1[1]); w.w = pk2(v1[2], v1[3]);
                    *(u32x4*)(base + (size_t)row * ld + c0 + bj * 128 + wc * 32 + 8 * fq) = w;
                }
            }
    }
};
struct EpiHid {
    static constexpr bool PERM = true, AFTER_DRAIN = false;
    bf16_t *H, *halo;
    DI void operator()(const f32x4 (&acc)[2][2][4][2], const pg8::Unit& u, int wr, int wc, int fr, int fq) const {
#pragma unroll
        for (int ai = 0; ai < 2; ++ai)
#pragma unroll
            for (int m = 0; m < 4; ++m) {
                const int cb = u.pm * 4 + ai * 2 + wr, rr = m * 16 + fr, row = cb * 64 + rr;
#pragma unroll
                for (int bj = 0; bj < 2; ++bj) {
                    const int col = u.pn * 256 + bj * 128 + wc * 32 + 8 * fq;
                    const f32x4 v0 = acc[ai][bj][m][0], v1 = acc[ai][bj][m][1];
                    u32x4 w; w.x = pk2(v0[0], v0[1]); w.y = pk2(v0[2], v0[3]); w.z = pk2(v1[0], v1[1]); w.w = pk2(v1[2], v1[3]);
                    *(u32x4*)(H + (size_t)row * FF2 + col) = w;
                    if (m == 3 && fr >= 14) *(u32x4*)(halo + ((size_t)cb * 2 + (rr - 62)) * FF2 + col) = w;
                }
            }
    }
};
struct EpiRes {
    static constexpr bool PERM = false, AFTER_DRAIN = false;
    float *hmain, *hmeta; float scale;
    DI void operator()(const f32x4 (&acc)[2][2][4][2], const pg8::Unit& u, int wr, int wc, int fr, int fq) const {
        const int col0 = u.pn * 256 + wc * 32 + 4 * fq;
#pragma unroll
        for (int ai = 0; ai < 2; ++ai)
#pragma unroll
            for (int m = 0; m < 4; ++m) {
                const int row = u.pm * 256 + ai * 128 + wr * 64 + m * 16 + fr;
                float* rp = (row < MMAIN ? hmain + (size_t)row * 1024 : hmeta + (size_t)(row - MMAIN) * 1024) + col0;
#pragma unroll
                for (int bj = 0; bj < 2; ++bj)
#pragma unroll
                    for (int n = 0; n < 2; ++n) { f32x4* q = (f32x4*)(rp + bj * 128 + n * 16); *q = *q + acc[ai][bj][m][n] * scale; }
            }
    }
};

struct MstQKV { bf16_t *Q, *halo; DI void operator()(int b, int i, int col, float v) const {
    const int which = col >> 10, head = (col >> 7) & 7, cc = col & 127, cb = 256 + b, rr = 48 + i; const bf16_t w = f2bf(v);
    Q[(size_t)which * (SZ_ACT / 2) + ((size_t)(cb * 8 + head) * 64 + rr) * 128 + cc] = w;
    if (rr >= 61) halo[((size_t)cb * 3 + rr - 61) * 3072 + col] = w; } };
struct MstZPG { bf16_t* QB0; DI void operator()(int b, int i, int col, float v) const {
    const int ge1 = col >= 1024, ge2 = col >= 1536, ge3 = col >= 2560, idx = ge1 + ge2 + ge3, is1 = (idx == 1);
    const int slot = idx + 4 * is1, ld = 1024 >> is1, c = col - (1024 * ge1 + 512 * ge2 + 1024 * ge3); const size_t row = MMAIN + 64 * b + 48 + i;
    QB0[(size_t)slot * (SZ_ACT / 2) + row * ld + c] = f2bf(v); } };
struct MstRes { float* hm; DI void operator()(int b, int i, int col, float v) const { hm[(size_t)(64 * b + 48 + i) * 1024 + col] += v; } };
struct MstHid { bf16_t *H, *halo; DI void operator()(int b, int i, int col, float v) const {
    const size_t row = MMAIN + 64 * b + 48 + i; const int rr = 48 + i; const bf16_t w = f2bf(v);
    H[row * FF2 + col] = w; if (rr >= 62) halo[((size_t)(256 + b) * 2 + rr - 62) * FF2 + col] = w; } };
template <class St> DI void meta_gemm(unsigned char* smem, const bf16_t* A, int lda, const bf16_t* Bt, int ldb, int K, int nitems, const St& st, int tid) {
    const int lane = tid & 63, wid = tid >> 6, q4 = lane >> 4, l16 = lane & 15, nt = wid & 3, kh = wid >> 2;
    float* red = (float*)smem + (nt * 64 + lane) * 8;
    for (int it = (int)gridDim.x - 1 - (int)blockIdx.x; it < nitems; it += gridDim.x) {
        const int n0 = it * 64 + 16 * nt;
        const bf16_t* a0 = A + (size_t)(MMAIN + 48 + l16) * lda + 8 * q4; const bf16_t* a1 = a0 + (size_t)64 * lda;
        const bf16_t* bp = Bt + (size_t)(n0 + l16) * ldb + 8 * q4;
        const int kbeg = kh * (K / 2), kend = kbeg + K / 2;
        f32x4 d0 = {0.f, 0.f, 0.f, 0.f}, d1 = {0.f, 0.f, 0.f, 0.f};
        for (int k = kbeg; k < kend; k += 128) { bf16x8 fa0[4], fa1[4], fb[4];
#pragma unroll
            for (int s = 0; s < 4; ++s) { fa0[s] = *(const bf16x8*)(a0 + k + 32 * s); fa1[s] = *(const bf16x8*)(a1 + k + 32 * s); fb[s] = *(const bf16x8*)(bp + k + 32 * s); }
#pragma unroll
            for (int s = 0; s < 4; ++s) { d0 = mfma16(fa0[s], fb[s], d0); d1 = mfma16(fa1[s], fb[s], d1); } }
        if (kh == 1) { *(f32x4*)red = d0; *(f32x4*)(red + 4) = d1; }
        __syncthreads();
        if (kh == 0) { d0 += *(const f32x4*)red; d1 += *(const f32x4*)(red + 4);
#pragma unroll
            for (int e = 0; e < 4; ++e) { st(0, 4 * q4 + e, n0 + l16, d0[e]); st(1, 4 * q4 + e, n0 + l16, d1[e]); } }
        __syncthreads();
    }
}

struct CvtTile { const float* src; bf16_t* dst; int ldw, ldb; };
DI CvtTile cvt_decode(const Params& p, int layer, int t) {
    const float* win = p.w_in + (size_t)layer * 1024 * IN_DIM; const float* wout = p.w_out + (size_t)layer * 1024 * 1024;
    const float* wup = p.w_up + (size_t)layer * 1024 * FF2; const float* wdn = p.w_down + (size_t)layer * DFF * 1024; const float* wpl = p.w_pool + (size_t)layer * 4 * 128 * 256;
    bf16_t* Win = (bf16_t*)(p.ws + WS_WIN); bf16_t* Wout = (bf16_t*)(p.ws + WS_WOUT); bf16_t* Wup = (bf16_t*)(p.ws + WS_WUP); bf16_t* Wdn = (bf16_t*)(p.ws + WS_WDN); bf16_t* Wpt = (bf16_t*)(p.ws + WS_WPT);
    CvtTile c;
    if (t < 1664) { const int kt = t / 104, nt = t % 104, n0 = nt * 64; c.src = win + (size_t)(kt * 64) * IN_DIM + n0 + (n0 >= 4096 ? 16 : 0); c.ldw = IN_DIM; c.dst = Win + (size_t)n0 * 1024 + kt * 64; c.ldb = 1024; }
    else if (t < 1920) { const int q = t - 1664, kt = q >> 4, nt = q & 15; c.src = wout + (size_t)(kt * 64) * 1024 + nt * 64; c.ldw = 1024; c.dst = Wout + (size_t)(nt * 64) * 1024 + kt * 64; c.ldb = 1024; }
    else if (t < 3328) { const int q = t - 1920, kt = q / 88, nt = q % 88; c.src = wup + (size_t)(kt * 64) * FF2 + nt * 64; c.ldw = FF2; c.dst = Wup + (size_t)(nt * 64) * 1024 + kt * 64; c.ldb = 1024; }
    else if (t < 4032) { const int q = t - 3328, kt = q >> 4, nt = q & 15; c.src = wdn + (size_t)(kt * 64) * 1024 + nt * 64; c.ldw = 1024; c.dst = Wdn + (size_t)(nt * 64) * DFF + kt * 64; c.ldb = DFF; }
    else { const int q = t - 4032, g = q >> 3, kt = (q >> 2) & 1, nt = q & 3; c.src = wpl + (size_t)g * 128 * 256 + (size_t)(kt * 64) * 256 + nt * 64; c.ldw = 256; c.dst = Wpt + (size_t)g * 256 * 128 + (size_t)(nt * 64) * 128 + kt * 64; c.ldb = 128; }
    return c;
}
DI void convert_weights(const Params& p, int layer, unsigned char* smem, int tid, int t_begin, int t_end, int blk, int nblk) {
    float* tl = (float*)smem;
    const int kk = tid >> 4, c4 = (tid & 15) * 4, nn = tid >> 3, k8 = (tid & 7) * 8;
    int t = t_begin + blk; if (t >= t_end) return;
    CvtTile cur = cvt_decode(p, layer, t);
    float4 v0 = *(const float4*)(cur.src + (size_t)kk * cur.ldw + c4), v1 = *(const float4*)(cur.src + (size_t)(kk + 32) * cur.ldw + c4);
    for (;;) {
        const int tn = t + nblk; const bool more = tn < t_end;
        CvtTile nxt = cur; float4 n0 = v0, n1 = v1;
        if (more) { nxt = cvt_decode(p, layer, tn); n0 = *(const float4*)(nxt.src + (size_t)kk * nxt.ldw + c4); n1 = *(const float4*)(nxt.src + (size_t)(kk + 32) * nxt.ldw + c4); }
        tl[kk * 65 + c4 + 0] = v0.x; tl[kk * 65 + c4 + 1] = v0.y; tl[kk * 65 + c4 + 2] = v0.z; tl[kk * 65 + c4 + 3] = v0.w;
        tl[(kk + 32) * 65 + c4 + 0] = v1.x; tl[(kk + 32) * 65 + c4 + 1] = v1.y; tl[(kk + 32) * 65 + c4 + 2] = v1.z; tl[(kk + 32) * 65 + c4 + 3] = v1.w;
        __syncthreads();
        { float f[8];
#pragma unroll
          for (int j = 0; j < 8; ++j) f[j] = tl[(k8 + j) * 65 + nn];
          u32x4 w; w.x = pk2(f[0], f[1]); w.y = pk2(f[2], f[3]); w.z = pk2(f[4], f[5]); w.w = pk2(f[6], f[7]);
          *(u32x4*)(cur.dst + (size_t)nn * cur.ldb + k8) = w; }
        __syncthreads();
        if (!more) break;
        t = tn; cur = nxt; v0 = n0; v1 = n1;
    }
}

DI const float* norm_src(const Params& p, bool init, int r) {
    if (!init) return hrow(p, r);
    if (r < MMAIN) return p.x + (size_t)r * 1024;
    const int rm = r - MMAIN, s = rm & 63; return (rm < 128 && s >= 48) ? p.meta + (size_t)(s - 48) * 1024 : nullptr;
}
DI void phase_norm(const Params& p, int layer, int which, unsigned char* smem) {
    const int tid = opaque_tid(p), lane = tid & 63, wid = tid >> 6;
    float* wba = (float*)smem;
    float* BA = (float*)(p.ws + WS_BA); bf16_t* U = (bf16_t*)(p.ws + WS_U);
    if (which == 0) {
        convert_weights(p, layer, smem, tid, 0, 1664, (int)blockIdx.x, (int)gridDim.x);
        __syncthreads();
        const float* win = p.w_in + (size_t)layer * 1024 * IN_DIM;
        for (int e = tid; e < 4096; e += 512) { const int k = e >> 2, j4 = (e & 3) * 4; *(float4*)(wba + k * 20 + j4) = *(const float4*)(win + (size_t)k * IN_DIM + 4096 + j4); }
        __syncthreads();
    }
    const float* gain = (which == 0 ? p.norm_mix : p.norm_ffn) + layer * 1024;
    const bool init = (layer == 0 && which == 0);
    int r = blockIdx.x * 8 + wid; const int rstep = gridDim.x * 8;
    float nv[16];
    { const float* s0 = r < MPAD ? norm_src(p, init, r) : nullptr;
#pragma unroll
      for (int i = 0; i < 16; ++i) nv[i] = s0 ? s0[lane + 64 * i] : 0.f; }
    for (; r < MPAD; r += rstep) {
        float v[16]; float ss = 0.f;
#pragma unroll
        for (int i = 0; i < 16; ++i) { v[i] = nv[i]; ss += v[i] * v[i]; }
        { const int rn = r + rstep; const float* s1 = rn < MPAD ? norm_src(p, init, rn) : nullptr;
#pragma unroll
          for (int i = 0; i < 16; ++i) nv[i] = s1 ? s1[lane + 64 * i] : 0.f; }
        if (init) { float* hr = hrow(p, r);
#pragma unroll
            for (int i = 0; i < 16; ++i) hr[lane + 64 * i] = v[i]; }
        ss = wsum(ss);
        const float rstd = rsqrtf(ss * (1.0f / 1024.0f) + 1e-6f);
#pragma unroll
        for (int i = 0; i < 16; ++i) { v[i] = v[i] * rstd * gain[lane + 64 * i]; U[(size_t)r * 1024 + lane + 64 * i] = f2bf(v[i]); }
        if (which == 0) {
            float acc[16]; int vz = 0; asm volatile("" : "+v"(vz)); const float* wbz = wba + vz;
#pragma unroll
            for (int j = 0; j < 16; ++j) acc[j] = 0.f;
#pragma unroll
            for (int i = 0; i < 16; ++i) { const float* wr_ = wbz + (lane + 64 * i) * 20;
#pragma unroll
                for (int j4 = 0; j4 < 4; ++j4) { const float4 w = *(const float4*)(wr_ + 4 * j4);
                    acc[4 * j4 + 0] += v[i] * w.x; acc[4 * j4 + 1] += v[i] * w.y; acc[4 * j4 + 2] += v[i] * w.z; acc[4 * j4 + 3] += v[i] * w.w; } }
            float o = 0.f;
#pragma unroll
            for (int j = 0; j < 16; ++j) { const float s = wsum(acc[j]); o = (lane == j) ? s : o; }
            if (lane < 16) BA[(size_t)r * 16 + lane] = o;
        }
    }
}
DI void phase_final(const Params& p) {
    const int tid = opaque_tid(p), lane = tid & 63, wid = tid >> 6;
    for (int r = blockIdx.x * 8 + wid; r < MMAIN; r += gridDim.x * 8) {
        float* hr = p.out + (size_t)r * 1024; float v[16]; float ss = 0.f;
#pragma unroll
        for (int i = 0; i < 16; ++i) { v[i] = hr[lane + 64 * i]; ss += v[i] * v[i]; }
        ss = wsum(ss); const float rstd = rsqrtf(ss * (1.0f / 1024.0f) + 1e-6f);
#pragma unroll
        for (int i = 0; i < 16; ++i) hr[lane + 64 * i] = v[i] * rstd * p.norm_final[lane + 64 * i];
    }
}

DI void phase_p3(const Params& p, int layer, unsigned char* smem) {
    const int tid = opaque_tid(p), lane = tid & 63, wid = tid >> 6; int q4 = lane >> 4, l16 = lane & 15;
    bf16_t* qs = (bf16_t*)(smem); bf16_t* ks = (bf16_t*)(smem + 17408); bf16_t* vbT = (bf16_t*)(smem + 34816); bf16_t* kgT = (bf16_t*)(smem + 53248);
    float* Lm = (float*)(smem + 71680); bf16_t* Tb = (bf16_t*)(smem + 89088); float* sc = (float*)(smem + 98304);
    bf16_t* QB = (bf16_t*)(p.ws + WS_QB); bf16_t* KB = (bf16_t*)(p.ws + WS_KB); bf16_t* VB = (bf16_t*)(p.ws + WS_VB); bf16_t* WB = (bf16_t*)(p.ws + WS_WB);
    bf16_t* KTB = (bf16_t*)(p.ws + WS_KTB); bf16_t* QKB = (bf16_t*)(p.ws + WS_QKB); const bf16_t* HALO = (const bf16_t*)(p.ws + WS_HALO);
    const float* BA = (const float*)(p.ws + WS_BA); float* GT = (float*)(p.ws + WS_GT);
    const float* cw = p.conv_qkv + (size_t)layer * 4 * 3072;
    const float SCALE = 0.08838834764831845f;
    for (int item = blockIdx.x; item < 258 * 8; item += gridDim.x) {
        const int cb = item >> 3, h = item & 7;
        int b, c; if (cb < 256) { b = cb >> 7; c = (cb & 127) + 1; } else { b = cb - 256; c = 0; }
        const int prev_cb = (c == 0) ? -1 : (c == 1 ? 256 + b : cb - 1);
        const size_t blk = (size_t)item * 8192;
            const int c0 = 2 * lane, r0 = 8 * wid;
            float wq[4][2], wk[4][2], wv[4][2];
#pragma unroll
            for (int j = 0; j < 4; ++j)
#pragma unroll
                for (int e = 0; e < 2; ++e) { wq[j][e] = cw[j * 3072 + h * 128 + c0 + e]; wk[j][e] = cw[j * 3072 + 1024 + h * 128 + c0 + e]; wv[j][e] = cw[j * 3072 + 2048 + h * 128 + c0 + e]; }
            unsigned xq[11], xk[11], xv[11];
#pragma unroll
            for (int i = 0; i < 11; ++i) { const int rr = r0 - 3 + i;
                if (c == 0 && rr < 48) { xq[i] = 0u; xk[i] = 0u; xv[i] = 0u; }
                else if (rr >= 0) { xq[i] = *(const unsigned*)(QB + blk + rr * 128 + c0); xk[i] = *(const unsigned*)(KB + blk + rr * 128 + c0); xv[i] = *(const unsigned*)(VB + blk + rr * 128 + c0); }
                else if (prev_cb >= 0) { const bf16_t* hp = HALO + ((size_t)prev_cb * 3 + (rr + 3)) * 3072 + h * 128 + c0; xq[i] = *(const unsigned*)hp; xk[i] = *(const unsigned*)(hp + 1024); xv[i] = *(const unsigned*)(hp + 2048); }
                else { xq[i] = 0u; xk[i] = 0u; xv[i] = 0u; } }
        if (wid == 0) {
            const int row = cb * 64 + lane;
            const float braw = BA[(size_t)row * 16 + h], araw = BA[(size_t)row * 16 + 8 + h];
            float beta = 1.0f / (1.0f + expf(-braw));
            const float xx = araw + p.dt_bias[layer * 8 + h]; const float sp = xx > 20.f ? xx : log1pf(expf(xx));
            float g = -expf(p.a_log[layer * 8 + h]) * sp;
            if (c == 0 && lane < 48) { g = 0.f; beta = 0.f; }
            float G = g;
#pragma unroll
            for (int off = 1; off < 64; off <<= 1) { const float t = __shfl_up(G, off); if (lane >= off) G += t; }
            const float Gl = __shfl(G, 63);
            sc[lane] = beta; sc[64 + lane] = G; sc[128 + lane] = expf(G); sc[192 + lane] = expf(Gl - G);
            if (lane == 63) GT[item] = expf(G);
        }
        __syncthreads();
        {
            float cq[8][2], ck[8][2], cv[8][2], sq[8], sk[8];
#pragma unroll
            for (int i = 0; i < 8; ++i) {
                float cq0 = 0.f, cq1 = 0.f, ck0 = 0.f, ck1 = 0.f, cv0 = 0.f, cv1 = 0.f;
#pragma unroll
                for (int j = 0; j < 4; ++j) { cq0 += wq[j][0] * bflo(xq[i + j]); cq1 += wq[j][1] * bfhi(xq[i + j]); ck0 += wk[j][0] * bflo(xk[i + j]); ck1 += wk[j][1] * bfhi(xk[i + j]);
                    cv0 += wv[j][0] * bflo(xv[i + j]); cv1 += wv[j][1] * bfhi(xv[i + j]); }
                cq[i][0] = silu(cq0); cq[i][1] = silu(cq1); ck[i][0] = silu(ck0); ck[i][1] = silu(ck1); cv[i][0] = silu(cv0); cv[i][1] = silu(cv1);
                sq[i] = cq[i][0] * cq[i][0] + cq[i][1] * cq[i][1]; sk[i] = ck[i][0] * ck[i][0] + ck[i][1] * ck[i][1];
            }
#pragma unroll
            for (int off = 32; off >= 1; off >>= 1) { float tq[8], tk[8];
#pragma unroll
                for (int i = 0; i < 8; ++i) { tq[i] = __shfl_xor(sq[i], off); tk[i] = __shfl_xor(sk[i], off); }
#pragma unroll
                for (int i = 0; i < 8; ++i) { sq[i] += tq[i]; sk[i] += tk[i]; } }
#pragma unroll
            for (int i = 0; i < 8; ++i) {
                const int r = r0 + i;
                const float rq = rsqrtf(sq[i] + 1e-6f), rk = rsqrtf(sk[i] + 1e-6f);
                const float cq0 = cq[i][0] * rq, cq1 = cq[i][1] * rq, ck0 = ck[i][0] * rk, ck1 = ck[i][1] * rk, cv0 = cv[i][0], cv1 = cv[i][1];
                const float beta = sc[r], eg = sc[128 + r];
                *(unsigned*)(qs + r * 136 + c0) = pk2(cq0, cq1); *(unsigned*)(ks + r * 136 + c0) = pk2(ck0, ck1);
                vbT[(c0 + 0) * 72 + r] = f2bf(cv0 * beta); vbT[(c0 + 1) * 72 + r] = f2bf(cv1 * beta);
                kgT[(c0 + 0) * 72 + r] = f2bf(ck0 * beta * eg); kgT[(c0 + 1) * 72 + r] = f2bf(ck1 * beta * eg);
            }
        }
        __syncthreads();
        { int lz = lane; asm volatile("" : "+v"(lz)); q4 = lz >> 4; l16 = lz & 15; }
        if (wid < 4) {
            const int mt = wid; bf16x8 a[4];
#pragma unroll
            for (int kb = 0; kb < 4; ++kb) a[kb] = *(const bf16x8*)(ks + (16 * mt + l16) * 136 + 32 * kb + 8 * q4);
            for (int nt = 0; nt <= mt; ++nt) {
                f32x4 d = {0.f, 0.f, 0.f, 0.f};
#pragma unroll
                for (int kb = 0; kb < 4; ++kb) d = mfma16(a[kb], *(const bf16x8*)(ks + (16 * nt + l16) * 136 + 32 * kb + 8 * q4), d);
                const int j_ = 16 * nt + l16; const float Gj = sc[64 + j_];
#pragma unroll
                for (int i = 0; i < 4; ++i) { const int i_ = 16 * mt + 4 * q4 + i; Lm[i_ * 68 + j_] = (i_ > j_) ? sc[i_] * d[i] * expf(sc[64 + i_] - Gj) : 0.f; }
            }
        } else {
            const int nti = wid - 4; bf16x8 bq[4]; f32x4 d[4];
#pragma unroll
            for (int kb = 0; kb < 4; ++kb) bq[kb] = *(const bf16x8*)(qs + (16 * nti + l16) * 136 + 32 * kb + 8 * q4);
            const int i_ = 16 * nti + l16; const float Gi = sc[64 + i_];
#pragma unroll
            for (int mtj = 0; mtj < 4; ++mtj) {
                f32x4 t = {0.f, 0.f, 0.f, 0.f};
                if (mtj <= nti) {
#pragma unroll
                    for (int kb = 0; kb < 4; ++kb) t = mfma16(*(const bf16x8*)(ks + (16 * mtj + l16) * 136 + 32 * kb + 8 * q4), bq[kb], t);
#pragma unroll
                    for (int i = 0; i < 4; ++i) { const int j_ = 16 * mtj + 4 * q4 + i; t[i] = (i_ >= j_) ? t[i] * SCALE * expf(Gi - sc[64 + j_]) : 0.f; }
                }
                d[mtj] = t;
            }
            *(bf16x8*)(QKB + (size_t)item * 4096 + ((nti * 2 + 0) * 64 + lane) * 8) = pack8(d[0], d[1]);
            *(bf16x8*)(QKB + (size_t)item * 4096 + ((nti * 2 + 1) * 64 + lane) * 8) = pack8(d[2], d[3]);
        }
        __syncthreads();
        if (wid == 0) {
            float t[64]; int vz; asm volatile("v_mov_b32 %0, 0" : "=v"(vz));
            const float* Lv = Lm + vz; const int lz = lane + vz;
#pragma unroll
            for (int i = 0; i < 64; ++i) {
                float a0 = 0.f, a1 = 0.f, a2 = 0.f, a3 = 0.f;
#pragma unroll
                for (int s4 = 0; s4 < i; s4 += 4) { const float4 l = *(const float4*)(Lv + i * 68 + s4);
                    a0 += l.x * t[s4]; if (s4 + 1 < i) a1 += l.y * t[s4 + 1]; if (s4 + 2 < i) a2 += l.z * t[s4 + 2]; if (s4 + 3 < i) a3 += l.w * t[s4 + 3]; }
                t[i] = ((i == lz) ? 1.f : 0.f) - ((a0 + a1) + (a2 + a3));
                if ((i & 1) == 1) asm volatile("" ::: "memory");
            }
#pragma unroll
            for (int i = 0; i < 64; ++i) Tb[i * 72 + lz] = f2bf(t[i]);
        } else {
            { int lz = lane; asm volatile("" : "+v"(lz)); q4 = lz >> 4; l16 = lz & 15; }
            for (int f = wid - 1; f < 32; f += 7) {
                if (f < 16) {
                    const int mt = f >> 2, kb = f & 3, row = 16 * mt + l16; const float s = SCALE * sc[128 + row];
                    const u32x2 lo = *(const u32x2*)(qs + row * 136 + 32 * kb + 4 * q4), hi = *(const u32x2*)(qs + row * 136 + 32 * kb + 16 + 4 * q4);
                    u32x4 w; w.x = pk2(bflo(lo.x) * s, bfhi(lo.x) * s); w.y = pk2(bflo(lo.y) * s, bfhi(lo.y) * s); w.z = pk2(bflo(hi.x) * s, bfhi(hi.x) * s); w.w = pk2(bflo(hi.y) * s, bfhi(hi.y) * s);
                    *(u32x4*)(QB + blk + (f * 64 + lane) * 8) = w;
                } else {
                    const int ff = f - 16, mtd = ff >> 1, kb2 = ff & 1, dk = 16 * mtd + l16; float v[8];
#pragma unroll
                    for (int j = 0; j < 8; ++j) { const int tok = 32 * kb2 + 16 * (j >> 2) + 4 * q4 + (j & 3); v[j] = bf2f(ks[tok * 136 + dk]) * sc[192 + tok]; }
                    u32x4 w; w.x = pk2(v[0], v[1]); w.y = pk2(v[2], v[3]); w.z = pk2(v[4], v[5]); w.w = pk2(v[6], v[7]);
                    *(u32x4*)(KTB + blk + (ff * 64 + lane) * 8) = w;
                }
            }
        }
        __syncthreads();
        { int lz = lane; asm volatile("" : "+v"(lz)); q4 = lz >> 4; l16 = lz & 15; }
        {
            const int nt = wid; bf16x8 bv[2]; f32x4 d[4];
#pragma unroll
            for (int kb2 = 0; kb2 < 2; ++kb2) bv[kb2] = *(const bf16x8*)(vbT + (16 * nt + l16) * 72 + 32 * kb2 + 8 * q4);
#pragma unroll
            for (int mt = 0; mt < 4; ++mt) { f32x4 t = {0.f, 0.f, 0.f, 0.f};
#pragma unroll
                for (int kb2 = 0; kb2 < 2; ++kb2) t = mfma16(*(const bf16x8*)(Tb + (16 * mt + l16) * 72 + 32 * kb2 + 8 * q4), bv[kb2], t);
                d[mt] = t; }
            *(bf16x8*)(VB + blk + nt * 1024 + lane * 16) = pack8(d[0], d[1]);
            *(bf16x8*)(VB + blk + nt * 1024 + lane * 16 + 8) = pack8(d[2], d[3]);
        }
        {
            const int mtt = wid & 3, half = wid >> 2; bf16x8 bt[2]; f32x4 d[4];
#pragma unroll
            for (int kb2 = 0; kb2 < 2; ++kb2) bt[kb2] = *(const bf16x8*)(Tb + (16 * mtt + l16) * 72 + 32 * kb2 + 8 * q4);
#pragma unroll
            for (int m4 = 0; m4 < 4; ++m4) { const int mtd = 4 * half + m4; f32x4 t = {0.f, 0.f, 0.f, 0.f};
#pragma unroll
                for (int kb2 = 0; kb2 < 2; ++kb2) t = mfma16(*(const bf16x8*)(kgT + (16 * mtd + l16) * 72 + 32 * kb2 + 8 * q4), bt[kb2], t);
                d[m4] = t; }
            *(bf16x8*)(WB + blk + ((mtt * 4 + 2 * half + 0) * 64 + lane) * 8) = pack8(d[0], d[1]);
            *(bf16x8*)(WB + blk + ((mtt * 4 + 2 * half + 1) * 64 + lane) * 8) = pack8(d[2], d[3]);
        }
        __syncthreads();
    }
}

DI void scan_step(const unsigned char* buf, f32x4 (&S)[8], bf16_t* op, int lane) {
    const bf16x8* Wf = (const bf16x8*)(buf) + lane; const bf16x8* Qf = (const bf16x8*)(buf + 16384) + lane;
    const bf16x8* Kf = (const bf16x8*)(buf + 32768) + lane; const bf16x8* Pf = (const bf16x8*)(buf + 49152) + lane;
#define SC_SB() __builtin_amdgcn_sched_barrier(0)
    bf16x8 fa[16], fb[16], Sb[4], Vb[2]; f32x4 vn[4], o[4];
#pragma unroll
    for (int f = 0; f < 16; ++f) fa[f] = Wf[f * 64];
#pragma unroll
    for (int kb = 0; kb < 4; ++kb) Sb[kb] = pack8(S[2 * kb], S[2 * kb + 1]);
    SC_SB();
#pragma unroll
    for (int f = 0; f < 16; ++f) fb[f] = Qf[f * 64];
    SC_SB();
    const u32x4 u0 = *(const u32x4*)(buf + 57344 + lane * 32), u1 = *(const u32x4*)(buf + 57344 + lane * 32 + 16); const float gt = *(const float*)(buf + 57344 + 2048);
    const unsigned uw[8] = {u0.x, u0.y, u0.z, u0.w, u1.x, u1.y, u1.z, u1.w};
#pragma unroll
    for (int mt = 0; mt < 4; ++mt) { f32x4 a = {0.f, 0.f, 0.f, 0.f};
#pragma unroll
        for (int kb = 0; kb < 4; ++kb) a = mfma16(fa[mt * 4 + kb], Sb[kb], a);
        vn[mt][0] = bflo(uw[2 * mt]) - a[0]; vn[mt][1] = bfhi(uw[2 * mt]) - a[1]; vn[mt][2] = bflo(uw[2 * mt + 1]) - a[2]; vn[mt][3] = bfhi(uw[2 * mt + 1]) - a[3]; }
    SC_SB();
#pragma unroll
    for (int f = 0; f < 8; ++f) fa[f] = Pf[f * 64];
#pragma unroll
    for (int f = 0; f < 8; ++f) fa[8 + f] = Kf[f * 64];
    Vb[0] = pack8(vn[0], vn[1]); Vb[1] = pack8(vn[2], vn[3]);
    SC_SB();
#pragma unroll
    for (int mt = 0; mt < 4; ++mt) { f32x4 a = {0.f, 0.f, 0.f, 0.f};
#pragma unroll
        for (int kb = 0; kb < 4; ++kb) a = mfma16(fb[mt * 4 + kb], Sb[kb], a);
        o[mt] = a; }
    SC_SB();
#pragma unroll
    for (int f = 0; f < 8; ++f) fb[f] = Kf[(8 + f) * 64];
    SC_SB();
#pragma unroll
    for (int mt = 0; mt < 4; ++mt) { f32x4 a = o[mt];
#pragma unroll
        for (int kb2 = 0; kb2 < 2; ++kb2) a = mfma16(fa[mt * 2 + kb2], Vb[kb2], a);
        o[mt] = a; }
#pragma unroll
    for (int mtd = 0; mtd < 4; ++mtd) { f32x4 a = S[mtd] * gt;
#pragma unroll
        for (int kb2 = 0; kb2 < 2; ++kb2) a = mfma16(fa[8 + mtd * 2 + kb2], Vb[kb2], a);
        S[mtd] = a; }
    SC_SB();
#pragma unroll
    for (int mtd = 4; mtd < 8; ++mtd) { f32x4 a = S[mtd] * gt;
#pragma unroll
        for (int kb2 = 0; kb2 < 2; ++kb2) a = mfma16(fb[(mtd - 4) * 2 + kb2], Vb[kb2], a);
        S[mtd] = a; }
#pragma unroll
    for (int mt = 0; mt < 4; ++mt)
#pragma unroll
        for (int i = 0; i < 4; ++i) op[(size_t)(16 * mt + i) * 1024] = f2bf(o[mt][i]);
#undef SC_SB
}
#define SC_BAR() do { asm volatile("s_waitcnt lgkmcnt(0)" ::: "memory"); __builtin_amdgcn_s_barrier(); asm volatile("" ::: "memory"); } while (0)
DI void phase_scan(const Params& p, int layer, unsigned char* smem) {
    if (blockIdx.x >= 128) { convert_weights(p, layer, smem, opaque_tid(p), 1664, 4064, (int)blockIdx.x - 128, (int)gridDim.x - 128); return; }
    const int tid = opaque_tid(p), lane = tid & 63, wid = __builtin_amdgcn_readfirstlane(tid >> 6), q4 = lane >> 4, l16 = lane & 15;
    const int bx = blockIdx.x & 7, by = blockIdx.x >> 3, nt = by & 7, g = bx + 8 * (by >> 3), b = g >> 3, h = g & 7;
    constexpr int BUFB = 59904;
#define SC_CB(c) (((c) == 0) ? 256 + b : 128 * b + (c) - 1)
    if (wid != 0) {
        const int r = wid - 1, rr = r >> 1, slot = 3 * (rr == 0) + 4 * (rr == 2) + 5 * (rr == 3), isq = (rr == 3);
        const unsigned char* sb = p.ws + WS_QB + (size_t)slot * SZ_ACT + (size_t)(r & 1) * 8192 + lane * 16;
        const unsigned char* ub = p.ws + WS_VB + nt * 2048 + lane * 32; const float* GT = (const float*)(p.ws + WS_GT);
        const size_t istride = (size_t)16384 >> isq;
        unsigned char* d0 = smem + r * 8192 + lane * 16; unsigned char* d1 = d0 + BUFB;
        unsigned char* e0 = smem + 57344 + lane * 32; unsigned char* e1 = e0 + BUFB;
        u32x4 ra[8], rb[8], rc[8], rd[8]; u32x4 xa[2], xb[2], xc[2], xd[2]; float ga = 0.f, gb = 0.f, gc = 0.f, gd = 0.f;
#define SC_LOAD(dst, xd_, gd_, c) do { const int cc_ = (c) < 129 ? (c) : 128; const int it_ = SC_CB(cc_) * 8 + h; const unsigned char* s_ = sb + (size_t)it_ * istride; \
        _Pragma("unroll") for (int i_ = 0; i_ < 8; ++i_) dst[i_] = *(const u32x4*)(s_ + i_ * 1024); \
        if (r == 6) { const unsigned char* us_ = ub + (size_t)it_ * 16384; xd_[0] = *(const u32x4*)us_; xd_[1] = *(const u32x4*)(us_ + 16); gd_ = GT[it_]; } } while (0)
#define SC_WRITE(dptr, eptr, src, xs_, gs_) do { _Pragma("unroll") for (int i_ = 0; i_ < 8; ++i_) *(u32x4*)((dptr) + i_ * 1024) = src[i_]; \
        if (r == 6) { *(u32x4*)(eptr) = xs_[0]; *(u32x4*)((eptr) + 16) = xs_[1]; if (lane == 0) *(float*)((eptr) + 2048) = gs_; } } while (0)
        SC_LOAD(ra, xa, ga, 0); SC_WRITE(d0, e0, ra, xa, ga); SC_LOAD(ra, xa, ga, 1); SC_LOAD(rb, xb, gb, 2); SC_LOAD(rc, xc, gc, 3); SC_LOAD(rd, xd, gd, 4);
        SC_BAR();
        for (int c = 0; c < 128; c += 4) {
            SC_WRITE(d1, e1, ra, xa, ga); SC_LOAD(ra, xa, ga, c + 5); SC_BAR();
            SC_WRITE(d0, e0, rb, xb, gb); SC_LOAD(rb, xb, gb, c + 6); SC_BAR();
            SC_WRITE(d1, e1, rc, xc, gc); SC_LOAD(rc, xc, gc, c + 7); SC_BAR();
            SC_WRITE(d0, e0, rd, xd, gd); SC_LOAD(rd, xd, gd, c + 8); SC_BAR();
        }
        SC_BAR();
    } else {
        __builtin_amdgcn_s_setprio(3);
        bf16_t* OB = (bf16_t*)(p.ws + WS_KB) + (size_t)(4 * q4) * 1024 + h * 128 + 16 * nt + l16;
        f32x4 S[8];
#pragma unroll
        for (int i = 0; i < 8; ++i) S[i] = (f32x4){0.f, 0.f, 0.f, 0.f};
        SC_BAR();
        for (int c = 0; c < 128; c += 2) {
            scan_step(smem, S, OB + (size_t)(SC_CB(c) * 64) * 1024, lane); SC_BAR();
            scan_step(smem + BUFB, S, OB + (size_t)(SC_CB(c + 1) * 64) * 1024, lane); SC_BAR();
        }
        scan_step(smem, S, OB + (size_t)(SC_CB(128) * 64) * 1024, lane);
        SC_BAR();
        __builtin_amdgcn_s_setprio(0);
    }
#undef SC_LOAD
#undef SC_WRITE
#undef SC_CB
}

DI void phase_combine(const Params& p, int layer, unsigned char* smem) {
    const int tid0 = opaque_tid(p);
    bf16_t* pl = (bf16_t*)smem;
    float* rs = (float*)(smem + 66560);
    const bf16_t* OB = (const bf16_t*)(p.ws + WS_KB); const bf16_t* ZB = (const bf16_t*)(p.ws + WS_QB); const bf16_t* GA = (const bf16_t*)(p.ws + WS_VB); const bf16_t* GB = (const bf16_t*)(p.ws + WS_WB);
    const bf16_t* PB = (const bf16_t*)(p.ws + WS_QKB); bf16_t* YB = (bf16_t*)(p.ws + WS_KTB); const bf16_t* WPT = (const bf16_t*)(p.ws + WS_WPT);
    const float* hn = p.head_norm + layer * 128; const float* psc = p.pool_scale + layer * 1024;
    for (int cb = blockIdx.x; cb < 260; cb += gridDim.x) {
        int tid = tid0; asm volatile("" : "+v"(tid));
        const int lane = tid & 63, wid = tid >> 6, q4 = lane >> 4, l16 = lane & 15;
        if (cb >= 258) { const u32x4 z = {0u, 0u, 0u, 0u};
            for (int e = tid; e < 64 * 128; e += 512) *(u32x4*)(YB + (size_t)cb * 65536 + e * 8) = z;
            continue; }
        const bool meta = cb >= 256; const int b = meta ? cb - 256 : (cb >> 7);
#pragma unroll
        for (int rr = 0; rr < 8; ++rr) { const int t = 8 * wid + rr; const bf16_t* op = OB + (size_t)(cb * 64 + t) * 1024 + lane * 16;
            const u32x4 a = *(const u32x4*)op, c = *(const u32x4*)(op + 8);
            float ss = bflo(a.x) * bflo(a.x) + bfhi(a.x) * bfhi(a.x) + bflo(a.y) * bflo(a.y) + bfhi(a.y) * bfhi(a.y) + bflo(a.z) * bflo(a.z) + bfhi(a.z) * bfhi(a.z) + bflo(a.w) * bflo(a.w) + bfhi(a.w) * bfhi(a.w)
                     + bflo(c.x) * bflo(c.x) + bfhi(c.x) * bfhi(c.x) + bflo(c.y) * bflo(c.y) + bfhi(c.y) * bfhi(c.y) + bflo(c.z) * bflo(c.z) + bfhi(c.z) * bfhi(c.z) + bflo(c.w) * bflo(c.w) + bfhi(c.w) * bfhi(c.w);
            ss += __shfl_xor(ss, 1); ss += __shfl_xor(ss, 2); ss += __shfl_xor(ss, 4);
            if ((lane & 7) == 0) rs[t * 8 + (lane >> 3)] = rsqrtf(ss * (1.0f / 128.0f) + 1e-6f); }
        { const int t = tid >> 3, row0 = cb * 64 + t, pt = t - 48;
#pragma unroll
          for (int it = 0; it < 8; ++it) { const int g = it & 3, c8 = (tid & 7) + 8 * (it >> 2), win = 2 << g;
            int row = row0; asm volatile("" : "+v"(row));
            const int im = row - 8192 * b;
            u32x4 v[16];
#pragma unroll
            for (int d = 0; d < 16; ++d) if (d < win) {
                const bool ok = meta ? (d <= pt) : true; int pr; if (meta || im - d >= 0) pr = row - d; else pr = MMAIN + 64 * b + 64 + (im - d);
                v[d] = ok ? *(const u32x4*)(PB + (size_t)pr * 512 + g * 128 + c8 * 8) : (u32x4){0u, 0u, 0u, 0u}; }
            float acc[8];
#pragma unroll
            for (int j = 0; j < 8; ++j) acc[j] = 0.f;
#pragma unroll
            for (int d = 0; d < 16; ++d) if (d < win) { acc[0] += bflo(v[d].x); acc[1] += bfhi(v[d].x); acc[2] += bflo(v[d].y); acc[3] += bfhi(v[d].y); acc[4] += bflo(v[d].z); acc[5] += bfhi(v[d].z); acc[6] += bflo(v[d].w); acc[7] += bfhi(v[d].w); }
            int cnt = win; if (meta) { cnt = pt + 1 < win ? pt + 1 : win; if (cnt < 1) cnt = 1; }
            const float inv = 1.0f / (float)cnt; u32x4 w;
            w.x = pk2(acc[0] * inv - bflo(v[0].x), acc[1] * inv - bfhi(v[0].x)); w.y = pk2(acc[2] * inv - bflo(v[0].y), acc[3] * inv - bfhi(v[0].y));
            w.z = pk2(acc[4] * inv - bflo(v[0].z), acc[5] * inv - bfhi(v[0].z)); w.w = pk2(acc[6] * inv - bflo(v[0].w), acc[7] * inv - bfhi(v[0].w));
            *(u32x4*)(pl + t * 520 + g * 128 + c8 * 8) = w; asm volatile("" ::: "memory"); } }
        __syncthreads();
        { const int g = wid >> 1, colbase = 128 * wid; const bf16_t* wp = WPT + (size_t)g * 256 * 128 + (size_t)(colbase & 255) * 128;
#pragma unroll 1
          for (int j = 0; j < 4; ++j) { bf16x8 a0[4], a1[4];
              const int ca = 32 * j + 8 * (l16 >> 2) + (l16 & 3);
#pragma unroll
              for (int kb = 0; kb < 4; ++kb) { a0[kb] = *(const bf16x8*)(wp + ca * 128 + 32 * kb + 8 * q4); a1[kb] = *(const bf16x8*)(wp + (ca + 4) * 128 + 32 * kb + 8 * q4); }
              const int c0 = colbase + 32 * j + 8 * q4;
              const f32x4 hn0 = *(const f32x4*)(hn + (c0 & 127)), hn1 = *(const f32x4*)(hn + (c0 & 127) + 4), ps0 = *(const f32x4*)(psc + c0), ps1 = *(const f32x4*)(psc + c0 + 4);
              u32x4 o4[4], z4[4], a4[4], b4[4];
#pragma unroll
              for (int ntt = 0; ntt < 4; ++ntt) { const int t = 16 * ntt + l16; const size_t off = (size_t)(cb * 64 + t) * 1024 + c0;
                  if (!(meta && t < 48)) { o4[ntt] = *(const u32x4*)(OB + off); z4[ntt] = *(const u32x4*)(ZB + off); a4[ntt] = *(const u32x4*)(GA + off); b4[ntt] = *(const u32x4*)(GB + off); }
                  else { o4[ntt] = (u32x4){0u, 0u, 0u, 0u}; z4[ntt] = o4[ntt]; a4[ntt] = o4[ntt]; b4[ntt] = o4[ntt]; } }
#pragma unroll
              for (int ntt = 0; ntt < 4; ++ntt) { f32x4 d0 = {0.f, 0.f, 0.f, 0.f}, d1 = {0.f, 0.f, 0.f, 0.f};
#pragma unroll
                  for (int kb = 0; kb < 4; ++kb) { const bf16x8 bb = *(const bf16x8*)(pl + (16 * ntt + l16) * 520 + g * 128 + 32 * kb + 8 * q4); d0 = mfma16(a0[kb], bb, d0); d1 = mfma16(a1[kb], bb, d1); }
                  const int t = 16 * ntt + l16; const size_t off = (size_t)(cb * 64 + t) * 1024 + c0; u32x4 yo = {0u, 0u, 0u, 0u};
                  if (!(meta && t < 48)) {
                      const float rq = rs[t * 8 + wid];
                      const unsigned ow[4] = {o4[ntt].x, o4[ntt].y, o4[ntt].z, o4[ntt].w}, zw[4] = {z4[ntt].x, z4[ntt].y, z4[ntt].z, z4[ntt].w};
                      const unsigned aw[4] = {a4[ntt].x, a4[ntt].y, a4[ntt].z, a4[ntt].w}, bw[4] = {b4[ntt].x, b4[ntt].y, b4[ntt].z, b4[ntt].w};
                      float y[8];
#pragma unroll
                      for (int e = 0; e < 8; ++e) { const float ov = (e & 1) ? bfhi(ow[e >> 1]) : bflo(ow[e >> 1]), zv = (e & 1) ? bfhi(zw[e >> 1]) : bflo(zw[e >> 1]);
                          const float av = (e & 1) ? bfhi(aw[e >> 1]) : bflo(aw[e >> 1]), bv = (e & 1) ? bfhi(bw[e >> 1]) : bflo(bw[e >> 1]);
                          const float hv = e < 4 ? hn0[e & 3] : hn1[e & 3], pv = e < 4 ? ps0[e & 3] : ps1[e & 3], dv = e < 4 ? d0[e & 3] : d1[e & 3];
                          y[e] = sigm(av) * (ov * rq * hv * silu(zv)) + sigm(bv) * (dv * pv); }
                      yo.x = pk2(y[0], y[1]); yo.y = pk2(y[2], y[3]); yo.z = pk2(y[4], y[5]); yo.w = pk2(y[6], y[7]); }
                  *(u32x4*)(YB + off) = yo; } } }
        __syncthreads();
    }
}

DI void phase_convact(const Params& p, int layer) {
    const int tid = opaque_tid(p);
    bf16_t* HID = (bf16_t*)(p.ws + WS_QB); const bf16_t* HALO = (const bf16_t*)(p.ws + WS_HALO);
    const float* cw = p.conv_ffn + (size_t)layer * 3 * FF2;
    if (tid >= 352) return;
    const int j0 = tid * 8;
    float wg[3][8], wv[3][8];
#pragma unroll
    for (int j = 0; j < 3; ++j)
#pragma unroll
        for (int e = 0; e < 8; ++e) { wg[j][e] = cw[j * FF2 + j0 + e]; wv[j][e] = cw[j * FF2 + DFF + j0 + e]; }
    for (int cb = blockIdx.x; cb < 258; cb += gridDim.x) {
        const bool meta = cb >= 256; const int prev = meta ? -1 : ((cb & 127) == 0 ? 256 + (cb >> 7) : cb - 1);
        float g1[8], g2[8], v1[8], v2[8];
        if (prev >= 0) { const bf16_t* hp = HALO + (size_t)prev * 2 * FF2;
            const u32x4 a = *(const u32x4*)(hp + j0), c = *(const u32x4*)(hp + DFF + j0), a1 = *(const u32x4*)(hp + FF2 + j0), c1 = *(const u32x4*)(hp + FF2 + DFF + j0);
            g2[0] = bflo(a.x); g2[1] = bfhi(a.x); g2[2] = bflo(a.y); g2[3] = bfhi(a.y); g2[4] = bflo(a.z); g2[5] = bfhi(a.z); g2[6] = bflo(a.w); g2[7] = bfhi(a.w);
            v2[0] = bflo(c.x); v2[1] = bfhi(c.x); v2[2] = bflo(c.y); v2[3] = bfhi(c.y); v2[4] = bflo(c.z); v2[5] = bfhi(c.z); v2[6] = bflo(c.w); v2[7] = bfhi(c.w);
            g1[0] = bflo(a1.x); g1[1] = bfhi(a1.x); g1[2] = bflo(a1.y); g1[3] = bfhi(a1.y); g1[4] = bflo(a1.z); g1[5] = bfhi(a1.z); g1[6] = bflo(a1.w); g1[7] = bfhi(a1.w);
            v1[0] = bflo(c1.x); v1[1] = bfhi(c1.x); v1[2] = bflo(c1.y); v1[3] = bfhi(c1.y); v1[4] = bflo(c1.z); v1[5] = bfhi(c1.z); v1[6] = bflo(c1.w); v1[7] = bfhi(c1.w);
        } else {
#pragma unroll
            for (int e = 0; e < 8; ++e) { g1[e] = 0.f; g2[e] = 0.f; v1[e] = 0.f; v2[e] = 0.f; } }
        for (int tb = meta ? 48 : 0; tb < 64; tb += 8) {
            u32x4 rg[8], rv[8];
#pragma unroll
            for (int i = 0; i < 8; ++i) { const bf16_t* hp = HID + (size_t)(cb * 64 + tb + i) * FF2 + j0; rg[i] = *(const u32x4*)hp; rv[i] = *(const u32x4*)(hp + DFF); }
#pragma unroll
            for (int i = 0; i < 8; ++i) {
                const float g0[8] = {bflo(rg[i].x), bfhi(rg[i].x), bflo(rg[i].y), bfhi(rg[i].y), bflo(rg[i].z), bfhi(rg[i].z), bflo(rg[i].w), bfhi(rg[i].w)};
                const float v0[8] = {bflo(rv[i].x), bfhi(rv[i].x), bflo(rv[i].y), bfhi(rv[i].y), bflo(rv[i].z), bfhi(rv[i].z), bflo(rv[i].w), bfhi(rv[i].w)};
                float a[8];
#pragma unroll
                for (int e = 0; e < 8; ++e) { const float cg = wg[0][e] * g2[e] + wg[1][e] * g1[e] + wg[2][e] * g0[e], cv = wv[0][e] * v2[e] + wv[1][e] * v1[e] + wv[2][e] * v0[e];
                    a[e] = silu(cg) * cv; g2[e] = g1[e]; g1[e] = g0[e]; v2[e] = v1[e]; v1[e] = v0[e]; }
                u32x4 w; w.x = pk2(a[0], a[1]); w.y = pk2(a[2], a[3]); w.z = pk2(a[4], a[5]); w.w = pk2(a[6], a[7]);
                *(u32x4*)(HID + (size_t)(cb * 64 + tb + i) * FF2 + j0) = w;
            }
        }
    }
}

__global__ void __launch_bounds__(512, 2) mega_fwd(Params p0) {
    extern __shared__ __attribute__((aligned(16))) unsigned char smem[];
    cg::grid_group grid = cg::this_grid();
    PG8_LAS unsigned char* lds = (PG8_LAS unsigned char*)smem;
    const int G = (int)gridDim.x, c = (int)blockIdx.x;
    Params p = p0; p.wid0 = __builtin_amdgcn_readfirstlane((int)threadIdx.x >> 6);
    const bool t0 = (threadIdx.x == 0);
    volatile LAS unsigned* xst = (volatile LAS unsigned*)(lds + 131072);
    if (threadIdx.x < 4) xst[threadIdx.x] = 0u;
    __syncthreads();
    const XcdBarrier xbar = xcd_barrier_post((unsigned*)(p0.ws + WS_BAR), xst, t0);
    grid.sync();
#define GSYNC() do { xcd_barrier(xbar, (p.wid0 == 0) && (lane_id_fresh() == 0)); } while (0)
#define FRESH() do { size_t z_ = 0; asm volatile("" : "+s"(z_)); p.ws = p0.ws + z_; p.out = p0.out + z_; } while (0)
#define WSP(off) ((bf16_t*)(p.ws + (off)))
#pragma unroll 1
    for (int layer = 0; layer < 2; ++layer) {
        FRESH(); phase_norm(p, layer, 0, smem); GSYNC();
#if PROBE == 6
        FRESH(); phase_norm(p, layer, 0, smem); GSYNC();
#endif
        FRESH();
        { pg8::Gemm g{WSP(WS_U), WSP(WS_WIN), MMAIN, 3072, 1024, 1024, 1024}; pg8::StaticOrder S; S.init(MMAIN, 3072, G, c); EpiQKV E{WSP(WS_QB), WSP(WS_HALO)}; pg8::gemm_phase<EpiQKV, pg8::StaticOrder>(lds, g, S, E, opaque_tid(p));
          meta_gemm(smem, WSP(WS_U), 1024, WSP(WS_WIN), 1024, 1024, 48, MstQKV{WSP(WS_QB), WSP(WS_HALO)}, opaque_tid(p)); }
        GSYNC();
#if PROBE == 11 || PROBE == 1
        FRESH();
        { pg8::Gemm g{WSP(WS_U), WSP(WS_WIN), MMAIN, 3072, 1024, 1024, 1024}; pg8::StaticOrder S; S.init(MMAIN, 3072, G, c); EpiQKV E{WSP(WS_QB), WSP(WS_HALO)}; pg8::gemm_phase<EpiQKV, pg8::StaticOrder>(lds, g, S, E, opaque_tid(p));
          meta_gemm(smem, WSP(WS_U), 1024, WSP(WS_WIN), 1024, 1024, 48, MstQKV{WSP(WS_QB), WSP(WS_HALO)}, opaque_tid(p)); }
        GSYNC();
#endif
        FRESH(); phase_p3(p, layer, smem); GSYNC();
#if PROBE == 2
        FRESH();
        { pg8::Gemm g{WSP(WS_U), WSP(WS_WIN), MMAIN, 3072, 1024, 1024, 1024}; pg8::StaticOrder S; S.init(MMAIN, 3072, G, c); EpiQKV E{WSP(WS_QB), WSP(WS_HALO)}; pg8::gemm_phase<EpiQKV, pg8::StaticOrder>(lds, g, S, E, opaque_tid(p));
          meta_gemm(smem, WSP(WS_U), 1024, WSP(WS_WIN), 1024, 1024, 48, MstQKV{WSP(WS_QB), WSP(WS_HALO)}, opaque_tid(p)); }
        GSYNC();
        FRESH(); phase_p3(p, layer, smem); GSYNC();
#endif
        FRESH(); phase_scan(p, layer, smem); GSYNC();
#if PROBE == 3
        FRESH(); phase_scan(p, layer, smem); GSYNC();
#endif
        FRESH();
        { pg8::Gemm g{WSP(WS_U), WSP(WS_WIN) + (size_t)3072 * 1024, MMAIN, 3584, 1024, 1024, 1024}; pg8::StaticOrder S; S.init(MMAIN, 3584, G, c); EpiZPG E{WSP(WS_QB)}; pg8::gemm_phase<EpiZPG, pg8::StaticOrder>(lds, g, S, E, opaque_tid(p));
          meta_gemm(smem, WSP(WS_U), 1024, WSP(WS_WIN) + (size_t)3072 * 1024, 1024, 1024, 56, MstZPG{WSP(WS_QB)}, opaque_tid(p)); }
        GSYNC();
#if PROBE == 11 || PROBE == 9
        FRESH();
        { pg8::Gemm g{WSP(WS_U), WSP(WS_WIN) + (size_t)3072 * 1024, MMAIN, 3584, 1024, 1024, 1024}; pg8::StaticOrder S; S.init(MMAIN, 3584, G, c); EpiZPG E{WSP(WS_QB)}; pg8::gemm_phase<EpiZPG, pg8::StaticOrder>(lds, g, S, E, opaque_tid(p));
          meta_gemm(smem, WSP(WS_U), 1024, WSP(WS_WIN) + (size_t)3072 * 1024, 1024, 1024, 56, MstZPG{WSP(WS_QB)}, opaque_tid(p)); }
        GSYNC();
#endif
        FRESH(); phase_combine(p, layer, smem); GSYNC();
#if PROBE == 4
        FRESH(); phase_combine(p, layer, smem); GSYNC();
#endif
        FRESH();
        { pg8::Gemm g{WSP(WS_KTB), WSP(WS_WOUT), MMAIN, 1024, 1024, 1024, 1024}; pg8::StaticOrder S; S.init(MMAIN, 1024, G, c); EpiRes E{p.out, (float*)(p.ws + WS_HM), 1.0f}; pg8::gemm_phase<EpiRes, pg8::StaticOrder>(lds, g, S, E, opaque_tid(p));
          meta_gemm(smem, WSP(WS_KTB), 1024, WSP(WS_WOUT), 1024, 1024, 16, MstRes{(float*)(p.ws + WS_HM)}, opaque_tid(p)); }
        GSYNC();
#if PROBE == 11 || PROBE == 12
        FRESH();
        { pg8::Gemm g{WSP(WS_KTB), WSP(WS_WOUT), MMAIN, 1024, 1024, 1024, 1024}; pg8::StaticOrder S; S.init(MMAIN, 1024, G, c); EpiRes E{p.out, (float*)(p.ws + WS_HM), 0.0f}; pg8::gemm_phase<EpiRes, pg8::StaticOrder>(lds, g, S, E, opaque_tid(p));
           }
        GSYNC();
#endif
        FRESH(); phase_norm(p, layer, 1, smem); GSYNC();
#if PROBE == 10
        FRESH(); phase_norm(p, layer, 1, smem); GSYNC();
#endif
        FRESH();
        { pg8::Gemm g{WSP(WS_U), WSP(WS_WUP), MMAIN, FF2, 1024, 1024, 1024}; pg8::StaticOrder S; S.init(MMAIN, FF2, G, c); EpiHid E{WSP(WS_QB), WSP(WS_HALO)}; pg8::gemm_phase<EpiHid, pg8::StaticOrder>(lds, g, S, E, opaque_tid(p));
          meta_gemm(smem, WSP(WS_U), 1024, WSP(WS_WUP), 1024, 1024, 88, MstHid{WSP(WS_QB), WSP(WS_HALO)}, opaque_tid(p)); }
        GSYNC();
#if PROBE == 7
        FRESH();
        { pg8::Gemm g{WSP(WS_U), WSP(WS_WUP), MMAIN, FF2, 1024, 1024, 1024}; pg8::StaticOrder S; S.init(MMAIN, FF2, G, c); EpiHid E{WSP(WS_QB), WSP(WS_HALO)}; pg8::gemm_phase<EpiHid, pg8::StaticOrder>(lds, g, S, E, opaque_tid(p));
          meta_gemm(smem, WSP(WS_U), 1024, WSP(WS_WUP), 1024, 1024, 88, MstHid{WSP(WS_QB), WSP(WS_HALO)}, opaque_tid(p)); }
        GSYNC();
#endif
        FRESH(); phase_convact(p, layer); GSYNC();
#if PROBE == 5
        FRESH();
        { pg8::Gemm g{WSP(WS_U), WSP(WS_WUP), MMAIN, FF2, 1024, 1024, 1024}; pg8::StaticOrder S; S.init(MMAIN, FF2, G, c); EpiHid E{WSP(WS_QB), WSP(WS_HALO)}; pg8::gemm_phase<EpiHid, pg8::StaticOrder>(lds, g, S, E, opaque_tid(p));
          meta_gemm(smem, WSP(WS_U), 1024, WSP(WS_WUP), 1024, 1024, 88, MstHid{WSP(WS_QB), WSP(WS_HALO)}, opaque_tid(p)); }
        GSYNC();
        FRESH(); phase_convact(p, layer); GSYNC();
#endif
        FRESH();
        { pg8::Gemm g{WSP(WS_QB), WSP(WS_WDN), MMAIN, 1024, DFF, FF2, DFF}; pg8::StaticOrder S; S.init(MMAIN, 1024, G, c); EpiRes E{p.out, (float*)(p.ws + WS_HM), 1.0f}; pg8::gemm_phase<EpiRes, pg8::StaticOrder>(lds, g, S, E, opaque_tid(p));
          meta_gemm(smem, WSP(WS_QB), FF2, WSP(WS_WDN), DFF, DFF, 16, MstRes{(float*)(p.ws + WS_HM)}, opaque_tid(p)); }
        GSYNC();
#if PROBE == 11 || PROBE == 13
        FRESH();
        { pg8::Gemm g{WSP(WS_QB), WSP(WS_WDN), MMAIN, 1024, DFF, FF2, DFF}; pg8::StaticOrder S; S.init(MMAIN, 1024, G, c); EpiRes E{p.out, (float*)(p.ws + WS_HM), 0.0f}; pg8::gemm_phase<EpiRes, pg8::StaticOrder>(lds, g, S, E, opaque_tid(p));
           }
        GSYNC();
#endif
    }
#if PROBE == 8
    for (int i = 0; i < 20; ++i) GSYNC();
#endif
    FRESH(); phase_final(p);
#undef FRESH
#undef WSP
#undef GSYNC
}

extern "C" void kernel_launch(void* const* d_in, const int* in_sizes, int n_in, void* d_out, int out_size, void* d_ws, size_t ws_size, hipStream_t stream) {
    static int grid_blocks = 0;
    if (!grid_blocks) {
        int dev = 0, cus = 0, per_cu = 0;
        hipGetDevice(&dev);
        hipDeviceGetAttribute(&cus, hipDeviceAttributeMultiprocessorCount, dev);
        if (hipFuncSetAttribute((const void*)mega_fwd, hipFuncAttributeMaxDynamicSharedMemorySize, LDS_BYTES) != hipSuccess) fprintf(stderr, "hipFuncSetAttribute failed\n");
        hipOccupancyMaxActiveBlocksPerMultiprocessor(&per_cu, (const void*)mega_fwd, 512, LDS_BYTES);
        if (per_cu < 1) { fprintf(stderr, "occupancy query reports %d blocks/CU\n", per_cu); per_cu = 1; }
        if (per_cu > 1) per_cu = 1;
        grid_blocks = cus * per_cu;
        if (ws_size < WS_END) fprintf(stderr, "workspace too small: %zu < %zu\n", ws_size, (size_t)WS_END);
    }
    Params p{};
    p.x = (const float*)d_in[0]; p.meta = (const float*)d_in[1]; p.norm_mix = (const float*)d_in[2]; p.w_in = (const float*)d_in[3]; p.conv_qkv = (const float*)d_in[4];
    p.a_log = (const float*)d_in[5]; p.dt_bias = (const float*)d_in[6]; p.head_norm = (const float*)d_in[7]; p.w_pool = (const float*)d_in[8]; p.pool_scale = (const float*)d_in[9];
    p.w_out = (const float*)d_in[10]; p.norm_ffn = (const float*)d_in[11]; p.w_up = (const float*)d_in[12]; p.conv_ffn = (const float*)d_in[13]; p.w_down = (const float*)d_in[14]; p.norm_final = (const float*)d_in[15];
    p.out = (float*)d_out; p.ws = (unsigned char*)d_ws;
    (void)hipMemsetAsync((unsigned char*)d_ws + WS_BAR, 0, (size_t)XCD_BAR_WORDS * 4, stream);
    void* args[] = {&p};
    hipError_t e = hipLaunchCooperativeKernel((const void*)mega_fwd, dim3(grid_blocks), dim3(512), args, LDS_BYTES, stream);
    if (e != hipSuccess) fprintf(stderr, "cooperative launch failed: %s (grid %d)\n", hipGetErrorString(e), grid_blocks);
}
```

```cpp
#include <hip/hip_runtime.h>
#include <hip/hip_cooperative_groups.h>
#include <cstdio>
namespace cg = cooperative_groups;
#ifndef PROBE
#define PROBE 0
#endif
#ifndef TSA
#define TSA 0
#define TSB 0
#endif
#ifndef DIAG_SPLIT
#define DIAG_SPLIT 0
#endif
#include <hip/hip_runtime.h>
namespace pg8 {
#define PG8_LAS __attribute__((address_space(3)))
typedef unsigned short bf16_t;
typedef short bf16x8 __attribute__((ext_vector_type(8)));
typedef float f32x4 __attribute__((ext_vector_type(4)));
typedef unsigned u32x4 __attribute__((ext_vector_type(4)));
constexpr int BM = 256, BK = 64, HALF = 128, HTB = HALF * BK * 2  , STAGE_BYTES = 8 * HTB, NXCD = 8, WGM = 8;

__host__ __device__ __forceinline__ int lds_byte(int r, int c) { const int st = (r >> 4) * 2 + (c >> 5), rr = r & 15, cc = c & 31, ob = rr * 64 + cc * 2; return st * 1024 + (ob ^ (((ob >> 9) & 1) << 5)); }
__host__ __device__ __forceinline__ void stage_rc(int b, int& R, int& C) { const int st = b / 1024, sb = b % 1024, swz = sb ^ (((sb >> 9) & 1) << 5); R = (st >> 1) * 16 + swz / 64; C = (st & 1) * 32 + (swz % 64) / 2; }
__host__ __device__ __forceinline__ int perm32(int rho) { const int n = rho >> 4, i = rho & 15; return 8 * (i >> 2) + 4 * n + (i & 3); }

struct Unit { int pm, pn; };
struct Gemm { const bf16_t* A; const bf16_t* Bt; int M, N, K, lda, ldb, mdiv, mlo, mhi; };

struct StaticOrder {
    int nM, nN, nwg, G, c;
    __host__ __device__ void init(int M, int N, int G_, int c_) { nM = M / BM; nN = N / BM; nwg = nM * nN; G = G_; c = c_; }
    __host__ __device__ bool next(int i, Unit& u) const {
        const long L = (long)i * G + c; if (L >= nwg) return false;
        int wgid = (int)L; { const int q = nwg / NXCD, r = nwg % NXCD, xcd = wgid % NXCD, off = wgid / NXCD; wgid = (xcd < r ? xcd * (q + 1) : r * (q + 1) + (xcd - r) * q) + off; }
        const int nig = WGM * nN, gid = wgid / nig, fm = gid * WGM, gsz = (nM - fm) < WGM ? (nM - fm) : WGM;
        u.pm = fm + ((wgid % nig) % gsz); u.pn = (wgid % nig) / gsz; return true;
    }
    __device__ __forceinline__ void a_ready(const Unit&) const {}
    __device__ __forceinline__ void done(const Unit&) const {}
};

template <class Epi, class Sched, bool ALIGN_EPI = false, bool SP2 = true>
__device__ __forceinline__ void gemm_phase(PG8_LAS unsigned char* lds, const Gemm g, const Sched& S, const Epi& E, int tid_in) {
    int tid = tid_in; asm volatile("" : "+v"(tid)); const int wid = __builtin_amdgcn_readfirstlane(tid >> 6), lane = tid & 63, wr = wid >> 2, wc = wid & 3, fr = lane & 15, fq = lane >> 4;
    const int K = g.K, nt = K / BK;
    unsigned voffA[2], voffB[2];
#pragma unroll
    for (int i = 0; i < 2; ++i) { int R, C; stage_rc(tid * 16 + i * 8192, R, C); const int Rb = Epi::PERM ? ((R & ~31) + perm32(R & 31)) : R;
        voffA[i] = (unsigned)(R * g.lda + C) * 2u; voffB[i] = (unsigned)(Rb * g.ldb + C) * 2u; }
    const size_t kstep = (size_t)(BK * 2);
    const size_t hstepA = (size_t)HALF * g.lda * 2, hstepB = (size_t)HALF * g.ldb * 2;
    const size_t tstepB = 2 * hstepB;
    const unsigned ldsw = (unsigned)wid * 1024u;
    const int aoff = lds_byte(wr * 64 + fr, fq * 8), boff = lds_byte(wc * 32 + fr, fq * 8);
#define PG8_SA(b, h) (((b) * 2 + (h)) * HTB)
#define PG8_SB(b, h) ((4 + (b) * 2 + (h)) * HTB)
#define PG8_STAGE(bufoff, gbase, voff) do { _Pragma("unroll") for (int _i = 0; _i < 2; ++_i) \
        __builtin_amdgcn_global_load_lds((const unsigned*)((const char*)(gbase) + (voff)[_i]), (PG8_LAS unsigned*)(lds + (bufoff) + ldsw + _i * 8192), 16, 0, 0); } while (0)
#define PG8_LDA(dst, b, h) do { _Pragma("unroll") for (int m = 0; m < 4; ++m) _Pragma("unroll") for (int k = 0; k < 2; ++k) dst[m][k] = *(const PG8_LAS bf16x8*)(lds + PG8_SA(b, h) + aoff + m * 2048 + k * 1024); } while (0)
#define PG8_LDB(dst, b, h) do { _Pragma("unroll") for (int n = 0; n < 2; ++n) _Pragma("unroll") for (int k = 0; k < 2; ++k) dst[n][k] = *(const PG8_LAS bf16x8*)(lds + PG8_SB(b, h) + boff + n * 2048 + k * 1024); } while (0)
#define PG8_MMA(ai, bj, At, Bt) do { __builtin_amdgcn_s_setprio(1); _Pragma("unroll") for (int m = 0; m < 4; ++m) _Pragma("unroll") for (int n = 0; n < 2; ++n) _Pragma("unroll") for (int k = 0; k < 2; ++k) \
        acc[ai][bj][m][n] = __builtin_amdgcn_mfma_f32_16x16x32_bf16(Bt[n][k], At[m][k], acc[ai][bj][m][n], 0, 0, 0); __builtin_amdgcn_s_setprio(0); } while (0)
#define PG8_WAIT_V(n) asm volatile("s_waitcnt vmcnt(" #n ")" ::: "memory")
#define PG8_WAIT_L(n) asm volatile("s_waitcnt lgkmcnt(" #n ")" ::: "memory")
#define PG8_BAR __builtin_amdgcn_s_barrier()
#define PG8_SCHED __builtin_amdgcn_sched_barrier(0)
    Unit cur, nxt; int ui = 0;
    if (!S.next(0, cur)) return;
    f32x4 acc[2][2][4][2];
#pragma unroll
    for (int a = 0; a < 2; ++a)
#pragma unroll
        for (int b = 0; b < 2; ++b)
#pragma unroll
            for (int m = 0; m < 4; ++m)
#pragma unroll
                for (int n = 0; n < 2; ++n) acc[a][b][m][n] = (f32x4){0.f, 0.f, 0.f, 0.f};
    bf16x8 At[4][2], B0[2][2], B1[2][2];
    const char* cA = (const char*)g.A + (size_t)((cur.pm / g.mdiv) * g.mhi + (cur.pm % g.mdiv) * g.mlo) * (size_t)g.lda * 2; const char* cB = (const char*)g.Bt + (size_t)cur.pn * tstepB;
    S.a_ready(cur);
    if constexpr (SP2) {
        PG8_STAGE(PG8_SB(0, 0), cB, voffB); PG8_STAGE(PG8_SB(0, 1), cB + hstepB, voffB); PG8_STAGE(PG8_SA(0, 0), cA, voffA); PG8_STAGE(PG8_SA(0, 1), cA + hstepA, voffA);
        if (wr == 1) PG8_BAR;
        PG8_WAIT_V(2); PG8_BAR;
        PG8_STAGE(PG8_SB(1, 0), cB + kstep, voffB); PG8_STAGE(PG8_SA(1, 0), cA + kstep, voffA); PG8_STAGE(PG8_SB(1, 1), cB + hstepB + kstep, voffB);
        PG8_WAIT_V(6); PG8_BAR;
    } else {
        PG8_STAGE(PG8_SB(0, 0), cB, voffB); PG8_STAGE(PG8_SA(0, 0), cA, voffA); PG8_STAGE(PG8_SB(0, 1), cB + hstepB, voffB); PG8_STAGE(PG8_SA(0, 1), cA + hstepA, voffA);
        if (wr == 1) PG8_BAR;
        PG8_WAIT_V(4); PG8_BAR;
        PG8_STAGE(PG8_SB(1, 0), cB + kstep, voffB); PG8_STAGE(PG8_SA(1, 0), cA + kstep, voffA); PG8_STAGE(PG8_SB(1, 1), cB + hstepB + kstep, voffB);
        PG8_WAIT_V(6); PG8_BAR;
    }
    for (;;) {
        const bool has_next = S.next(ui + 1, nxt);
        const char* nA = has_next ? (const char*)g.A + (size_t)((nxt.pm / g.mdiv) * g.mhi + (nxt.pm % g.mdiv) * g.mlo) * (size_t)g.lda * 2 : cA; const char* nB = has_next ? (const char*)g.Bt + (size_t)nxt.pn * tstepB : cB;
        for (int t = 0; t < nt; t += 2) {
            const bool last = (t == nt - 2);
            const char* a1 = cA + (size_t)(t + 1) * kstep;
            const char* a2 = last ? nA : cA + (size_t)(t + 2) * kstep; const char* b2 = last ? nB : cB + (size_t)(t + 2) * kstep;
            const char* a3 = a2 + kstep; const char* b3 = b2 + kstep;
            if (last && has_next) S.a_ready(nxt);
            if constexpr (SP2) {
            PG8_LDB(B0, 0, 0); PG8_LDB(B1, 0, 1); PG8_SCHED; PG8_LDA(At, 0, 0); PG8_STAGE(PG8_SA(1, 1), a1 + hstepA, voffA);
            PG8_WAIT_V(8); PG8_WAIT_L(0); PG8_BAR; PG8_MMA(0, 0, At, B0); PG8_MMA(0, 1, At, B1); PG8_BAR; PG8_SCHED;
            PG8_LDA(At, 0, 1); PG8_STAGE(PG8_SB(0, 0), b2, voffB); PG8_STAGE(PG8_SB(0, 1), b2 + hstepB, voffB); PG8_STAGE(PG8_SA(0, 0), a2, voffA);
            PG8_WAIT_V(8); PG8_WAIT_L(0); PG8_BAR; PG8_MMA(1, 0, At, B0); PG8_MMA(1, 1, At, B1); PG8_BAR; PG8_SCHED;
            PG8_LDB(B0, 1, 0); PG8_LDB(B1, 1, 1); PG8_SCHED; PG8_LDA(At, 1, 0); PG8_STAGE(PG8_SA(0, 1), a2 + hstepA, voffA);
            PG8_WAIT_V(8); PG8_WAIT_L(0); PG8_BAR; PG8_MMA(0, 0, At, B0); PG8_MMA(0, 1, At, B1); PG8_BAR; PG8_SCHED;
            PG8_LDA(At, 1, 1); PG8_STAGE(PG8_SB(1, 0), b3, voffB); PG8_STAGE(PG8_SB(1, 1), b3 + hstepB, voffB); PG8_STAGE(PG8_SA(1, 0), a3, voffA);
            PG8_WAIT_V(8); PG8_WAIT_L(0); PG8_BAR; PG8_MMA(1, 0, At, B0); PG8_MMA(1, 1, At, B1); PG8_BAR; PG8_SCHED;
            } else {
            PG8_LDB(B0, 0, 0); PG8_SCHED; PG8_LDA(At, 0, 0); PG8_STAGE(PG8_SA(1, 1), a1 + hstepA, voffA);
            PG8_WAIT_L(8); PG8_BAR; PG8_WAIT_L(0); PG8_MMA(0, 0, At, B0); PG8_BAR; PG8_SCHED;
            PG8_LDB(B1, 0, 1); PG8_STAGE(PG8_SB(0, 0), b2, voffB);
            PG8_BAR; PG8_WAIT_L(0); PG8_MMA(0, 1, At, B1); PG8_BAR;
            PG8_LDA(At, 0, 1); PG8_STAGE(PG8_SA(0, 0), a2, voffA);
            PG8_BAR; PG8_WAIT_L(0); PG8_MMA(1, 0, At, B0); PG8_BAR; PG8_SCHED;
            PG8_STAGE(PG8_SB(0, 1), b2 + hstepB, voffB);
            PG8_WAIT_V(6); PG8_BAR; PG8_MMA(1, 1, At, B1); PG8_BAR;
            PG8_LDB(B0, 1, 0); PG8_SCHED; PG8_LDA(At, 1, 0); PG8_STAGE(PG8_SA(0, 1), a2 + hstepA, voffA);
            PG8_WAIT_L(8); PG8_BAR; PG8_WAIT_L(0); PG8_MMA(0, 0, At, B0); PG8_BAR; PG8_SCHED;
            PG8_LDB(B1, 1, 1); PG8_STAGE(PG8_SB(1, 0), b3, voffB);
            PG8_BAR; PG8_WAIT_L(0); PG8_MMA(0, 1, At, B1); PG8_BAR;
            PG8_LDA(At, 1, 1); PG8_STAGE(PG8_SA(1, 0), a3, voffA);
            PG8_BAR; PG8_WAIT_L(0); PG8_MMA(1, 0, At, B0); PG8_BAR; PG8_SCHED;
            PG8_STAGE(PG8_SB(1, 1), b3 + hstepB, voffB);
            PG8_WAIT_V(6); PG8_BAR; PG8_MMA(1, 1, At, B1); PG8_BAR;
            }
        }
        if constexpr (ALIGN_EPI) { if (wr == 0) PG8_BAR; }
        if constexpr (!Epi::AFTER_DRAIN) { E(acc, cur, wr, wc, fr, fq); S.done(cur); }
        if (!has_next) break;
#pragma unroll
        for (int a = 0; a < 2; ++a)
#pragma unroll
            for (int b = 0; b < 2; ++b)
#pragma unroll
                for (int m = 0; m < 4; ++m)
#pragma unroll
                    for (int n = 0; n < 2; ++n) acc[a][b][m][n] = (f32x4){0.f, 0.f, 0.f, 0.f};
        cur = nxt; cA = nA; cB = nB; ++ui;
        if constexpr (ALIGN_EPI) { if (wr == 1) PG8_BAR; }
    }
    PG8_WAIT_V(0);
    if constexpr (!ALIGN_EPI) { if (wr == 0) PG8_BAR; }
    PG8_BAR;
    if constexpr (Epi::AFTER_DRAIN) { E.fused(acc, cur, wr, wc, fr, fq, lds, wid, lane); S.done(cur); }
#undef PG8_SA
#undef PG8_SB
#undef PG8_STAGE
#undef PG8_LDA
#undef PG8_LDB
#undef PG8_MMA
#undef PG8_WAIT_V
#undef PG8_WAIT_L
#undef PG8_BAR
#undef PG8_SCHED
}
}


#define XB_TMO      128
#define XB_XCNT(j)  (256  + 64 * (j))
#define XB_XSUB(j)  (1280 + 64 * (j))
#define XB_XGEN(j)  (2304 + 64 * (j))
#define XB_TOP      3328
#define XB_TOPGEN   3392
#define XCD_BAR_WORDS 3456
#define XB_SPIN_CAP (1u << 18)
#define LAS __attribute__((address_space(3)))

__device__ __forceinline__ unsigned xb_ld(unsigned* p)              { return __hip_atomic_load(p, __ATOMIC_RELAXED, __HIP_MEMORY_SCOPE_AGENT); }
__device__ __forceinline__ unsigned xb_add(unsigned* p, unsigned v) { return __hip_atomic_fetch_add(p, v, __ATOMIC_RELAXED, __HIP_MEMORY_SCOPE_AGENT); }
__device__ __forceinline__ unsigned xb_xcc_id() { return (unsigned)__builtin_amdgcn_s_getreg((3 << 11) | 20) & 0xFu; }
#define XB_SPIN(cond, bar) do { unsigned _sp = 0; while (cond) { __builtin_amdgcn_s_sleep(1); \
    if ((++_sp & 255u) == 0u) { if (xb_ld(&(bar)[XB_TMO])) break; if (_sp > XB_SPIN_CAP) { atomicAdd(&(bar)[XB_TMO], 1u); break; } } } } while (0)

struct XcdBarrier { unsigned* bar; unsigned x; volatile LAS unsigned* st; };
__device__ __forceinline__ XcdBarrier xcd_barrier_post(unsigned* bar, volatile LAS unsigned* st, bool t0) {
    XcdBarrier b; b.bar = bar; b.x = xb_xcc_id(); b.st = st;
    if (t0) (void)xb_add(&bar[XB_XCNT(b.x)], 1u);
    return b;
}
__device__ __forceinline__ void xcd_barrier_complete(unsigned* bar, unsigned x, unsigned& nloc, unsigned& nx) {
    const unsigned G = gridDim.x * gridDim.y * gridDim.z;
    unsigned sum, cnt, mine, sp = 0u;
    for (;;) {
        sum = 0u; cnt = 0u; mine = 0u;
#pragma unroll
        for (unsigned j = 0; j < 16; ++j) { const unsigned c = xb_ld(&bar[XB_XCNT(j)]); sum += c; cnt += (c > 0u) ? 1u : 0u; mine = (j == x) ? c : mine; }
        if (sum == G) break;
        __builtin_amdgcn_s_sleep(1);
        if ((++sp & 255u) == 0u) { if (xb_ld(&bar[XB_TMO])) break; if (sp > XB_SPIN_CAP) { atomicAdd(&bar[XB_TMO], 1u); break; } }
    }
    nloc = mine > 0u ? mine : 1u; nx = cnt > 0u ? cnt : 1u;
}
__device__ __forceinline__ void xcd_barrier(const XcdBarrier& b, bool t0) {
    asm volatile("s_waitcnt vmcnt(0)" ::: "memory");
    __syncthreads();
    if (t0) {
        unsigned* bar = b.bar;
        __builtin_amdgcn_s_waitcnt(0);
        unsigned nloc = b.st[0], nx = b.st[1];
        if (nloc == 0u) { xcd_barrier_complete(bar, b.x, nloc, nx); b.st[0] = nloc; b.st[1] = nx; }
        const unsigned old = xb_add(&bar[XB_XSUB(b.x)], 1u);
        const unsigned gen = old / nloc;
        if (old + 1u == (gen + 1u) * nloc) {
            __builtin_amdgcn_fence(__ATOMIC_RELEASE, "agent");
            asm volatile("s_waitcnt vmcnt(0)" ::: "memory");
            const unsigned og = xb_add(&bar[XB_TOP], 1u);
            const unsigned tg = og / nx;
            if (og + 1u == (tg + 1u) * nx) xb_add(&bar[XB_TOPGEN], 1u);
            else XB_SPIN(xb_ld(&bar[XB_TOPGEN]) == tg, bar);
            __builtin_amdgcn_fence(__ATOMIC_ACQUIRE, "agent");
            xb_add(&bar[XB_XGEN(b.x)], 1u);
            asm volatile("s_waitcnt vmcnt(0)" ::: "memory");
        } else {
            XB_SPIN(xb_ld(&bar[XB_XGEN(b.x)]) == gen, bar);
            __builtin_amdgcn_fence(__ATOMIC_ACQUIRE, "agent");
            asm volatile("s_waitcnt vmcnt(0)" ::: "memory");
        }
    }
    __syncthreads();
}

using pg8::bf16_t; using pg8::bf16x8; using pg8::f32x4; using pg8::u32x4;
typedef unsigned u32x2 __attribute__((ext_vector_type(2)));
typedef __bf16 bf16x2_t __attribute__((ext_vector_type(2)));
typedef float f32x2 __attribute__((ext_vector_type(2)));
#define DI __device__ __forceinline__

constexpr int MMAIN = 16384, MPAD = 16640, IN_DIM = 6672, DFF = 2816, FF2 = 5632;
constexpr size_t SZ_ACT = (size_t)MPAD * 1024 * 2;
constexpr size_t WS_WIN = 0;
constexpr size_t WS_WOUT = WS_WIN + (size_t)6656 * 1024 * 2;
constexpr size_t WS_WUP = WS_WOUT + (size_t)1024 * 1024 * 2;
constexpr size_t WS_WDN = WS_WUP + (size_t)5632 * 1024 * 2;
constexpr size_t WS_WPT = WS_WDN + (size_t)1024 * 2816 * 2;
constexpr size_t WS_U = WS_WPT + (size_t)4 * 256 * 128 * 2;
constexpr int USEQ = 8448;
constexpr size_t SZ_U = (size_t)2 * USEQ * 1024 * 2;
static_assert(SZ_U >= SZ_ACT, "U region");
constexpr size_t WS_QB = WS_U + SZ_U;
constexpr size_t WS_KB = WS_QB + SZ_ACT;
constexpr size_t WS_VB = WS_KB + SZ_ACT;
constexpr size_t WS_WB = WS_VB + SZ_ACT;
constexpr size_t WS_KTB = WS_WB + SZ_ACT;
constexpr size_t WS_QKB = WS_KTB + SZ_ACT;
constexpr size_t WS_HALO = WS_QKB + (size_t)260 * 8 * 4096 * 2;
constexpr size_t WS_BA = WS_HALO + (size_t)260 * 2 * 5632 * 2;
constexpr size_t WS_HM = WS_BA + (size_t)MPAD * 16 * 4;
constexpr size_t WS_GT = WS_HM + (size_t)256 * 1024 * 4;
constexpr size_t WS_BAR = WS_GT + (size_t)2080 * 128;
constexpr size_t WS_TS = WS_BAR + (size_t)XCD_BAR_WORDS * 4;
constexpr size_t WS_FLAG = WS_TS + 1024;
constexpr size_t WS_XT = WS_FLAG + (size_t)2 * 2080 * 4;
constexpr size_t WS_END = WS_XT + 256;
static_assert(WS_QKB + (size_t)260 * 8 * 4096 * 2 - WS_QB == (size_t)MPAD * FF2 * 2, "hid overlay");
static_assert(WS_END <= 268435456ull, "workspace");
constexpr int LDS_BYTES = 131072 + 16 + 8192 + 3072;

struct Params {
    const float *x, *meta, *norm_mix, *w_in, *conv_qkv, *a_log, *dt_bias, *head_norm, *w_pool, *pool_scale, *w_out, *norm_ffn, *w_up, *conv_ffn, *w_down, *norm_final;
    float* out; unsigned char* ws; int wid0, pad0;
};

DI int lane_id_fresh() { int l; asm volatile("v_mbcnt_lo_u32_b32 %0, -1, 0\n\tv_mbcnt_hi_u32_b32 %0, -1, %0" : "=&v"(l)); return l; }
DI int opaque_tid(const Params& p) { return (p.wid0 << 6) | lane_id_fresh(); }
DI unsigned pk2(float a, float b) { f32x2 v = {a, b}; bf16x2_t r = __builtin_convertvector(v, bf16x2_t); return __builtin_bit_cast(unsigned, r); }
DI bf16_t f2bf(float a) { return (bf16_t)(pk2(a, 0.f) & 0xffffu); }
DI float bflo(unsigned w) { return __uint_as_float(w << 16); }
DI float bfhi(unsigned w) { return __uint_as_float(w & 0xffff0000u); }
DI float bf2f(bf16_t b) { return __uint_as_float(((unsigned)b) << 16); }
DI bf16x8 pack8(f32x4 a, f32x4 b) { u32x4 w; w.x = pk2(a[0], a[1]); w.y = pk2(a[2], a[3]); w.z = pk2(b[0], b[1]); w.w = pk2(b[2], b[3]); return __builtin_bit_cast(bf16x8, w); }
DI f32x4 mfma16(bf16x8 a, bf16x8 b, f32x4 c) { return __builtin_amdgcn_mfma_f32_16x16x32_bf16(a, b, c, 0, 0, 0); }
DI float sigm(float x) { return __builtin_amdgcn_rcpf(1.0f + __expf(-x)); }
DI float silu(float x) { return x * __builtin_amdgcn_rcpf(1.0f + __expf(-x)); }
DI float shxl(float v, int off, int lane) { return __builtin_bit_cast(float, __builtin_amdgcn_ds_bpermute((lane ^ off) << 2, __builtin_bit_cast(int, v))); }
DI float wsum(float v, int lane) { v += shxl(v, 32, lane); v += shxl(v, 16, lane); v += shxl(v, 8, lane); v += shxl(v, 4, lane); v += shxl(v, 2, lane); v += shxl(v, 1, lane); return v; }
DI void st_wt16(void* ptr, u32x4 v) {
    unsigned long long* q = (unsigned long long*)ptr;
    __hip_atomic_store(q, ((unsigned long long)v.y << 32) | v.x, __ATOMIC_RELAXED, __HIP_MEMORY_SCOPE_AGENT);
    __hip_atomic_store(q + 1, ((unsigned long long)v.w << 32) | v.z, __ATOMIC_RELAXED, __HIP_MEMORY_SCOPE_AGENT); }
DI void st_wt4(float* ptr, float v) { __hip_atomic_store(ptr, v, __ATOMIC_RELAXED, __HIP_MEMORY_SCOPE_AGENT); }
DI float* hrow(const Params& p, int r) { return r < MMAIN ? p.out + (size_t)r * 1024 : (float*)(p.ws + WS_HM) + (size_t)(r - MMAIN) * 1024; }

struct EpiQKV {
    static constexpr bool PERM = true, AFTER_DRAIN = false;
    bf16_t *Q, *halo;
    DI void operator()(const f32x4 (&acc)[2][2][4][2], const pg8::Unit& u, int wr, int wc, int fr, int fq) const {
        const int which = u.pn >> 2; bf16_t* base = Q + (size_t)which * (SZ_ACT / 2);
#pragma unroll
        for (int ai = 0; ai < 2; ++ai)
#pragma unroll
            for (int m = 0; m < 4; ++m) {
                const int cb = u.pm * 4 + ai * 2 + wr, rr = m * 16 + fr;
#pragma unroll
                for (int bj = 0; bj < 2; ++bj) {
                    const int head = (u.pn & 3) * 2 + bj, cc = wc * 32 + 8 * fq;
                    const f32x4 v0 = acc[ai][bj][m][0], v1 = acc[ai][bj][m][1];
                    u32x4 w; w.x = pk2(v0[0], v0[1]); w.y = pk2(v0[2], v0[3]); w.z = pk2(v1[0], v1[1]); w.w = pk2(v1[2], v1[3]);
                    *(u32x4*)(base + ((size_t)(cb * 8 + head) * 64 + rr) * 128 + cc) = w;
                    if (m == 3 && fr >= 13) *(u32x4*)(halo + ((size_t)cb * 3 + (rr - 61)) * 3072 + u.pn * 256 + bj * 128 + cc) = w;
                }
            }
    }
};
struct EpiZPG {
    static constexpr bool PERM = true, AFTER_DRAIN = false;
    bf16_t *QB0;
    DI void operator()(const f32x4 (&acc)[2][2][4][2], const pg8::Unit& u, int wr, int wc, int fr, int fq) const {
        const int ge4 = u.pn >= 4, ge6 = u.pn >= 6, ge10 = u.pn >= 10, idx = ge4 + ge6 + ge10, is1 = (idx == 1);
        const int slot = idx + 4 * is1, ld = 1024 >> is1, c0 = (u.pn - (4 * ge4 + 2 * ge6 + 4 * ge10)) * 256;
        bf16_t* base = QB0 + (size_t)slot * (SZ_ACT / 2);
#pragma unroll
        for (int ai = 0; ai < 2; ++ai)
#pragma unroll
            for (int m = 0; m < 4; ++m) {
                const int row = u.pm * 256 + ai * 128 + wr * 64 + m * 16 + fr;
#pragma unroll
                for (int bj = 0; bj < 2; ++bj) {
                    const f32x4 v0 = acc[ai][bj][m][0], v1 = acc[ai][bj][m][1];
                    u32x4 w; w.x = pk2(v0[0], v0[1]); w.y = pk2(v0[2], v0[3]); w.z = pk2(v1[0], v1[1]); w.w = pk2(v1[2], v1[3]);
                    *(u32x4*)(base + (size_t)row * ld + c0 + bj * 128 + wc * 32 + 8 * fq) = w;
                }
            }
    }
};
DI float dpp_shr1(float old, float src) { return __builtin_bit_cast(float, __builtin_amdgcn_update_dpp(__builtin_bit_cast(int, old), __builtin_bit_cast(int, src), 0x111, 0xf, 0xf, false)); }
DI float dpp_shr2(float old, float src) { return __builtin_bit_cast(float, __builtin_amdgcn_update_dpp(__builtin_bit_cast(int, old), __builtin_bit_cast(int, src), 0x112, 0xf, 0xf, false)); }
DI float dpp_ror1(float src) { return __builtin_bit_cast(float, __builtin_amdgcn_update_dpp(0, __builtin_bit_cast(int, src), 0x121, 0xf, 0xf, false)); }
DI float dpp_ror2(float src) { return __builtin_bit_cast(float, __builtin_amdgcn_update_dpp(0, __builtin_bit_cast(int, src), 0x122, 0xf, 0xf, false)); }
struct EpiAct {
    static constexpr bool PERM = true, AFTER_DRAIN = false;
    bf16_t* ACT; const float* cw; PG8_LAS float* X;
    DI void operator()(const f32x4 (&acc)[2][2][4][2], const pg8::Unit& u, int wr, int wc, int fr, int fq) const {
        int fqz = fq; asm volatile("" : "+v"(fqz));
        const int xcol = wc * 32 + 8 * fqz, f0 = u.pn * 128 + xcol;
        PG8_LAS float* CW = X + 2048;
        if (fr == 0 && wr == 0) {
#pragma unroll
            for (int j = 0; j < 3; ++j)
#pragma unroll
                for (int bj = 0; bj < 2; ++bj)
#pragma unroll
                    for (int n = 0; n < 2; ++n) *(PG8_LAS f32x4*)(CW + (j * 2 + bj) * 128 + xcol + 4 * n) = *(const f32x4*)(cw + j * FF2 + bj * DFF + f0 + 4 * n);
        }
        if (fr >= 14) {
#pragma unroll
            for (int ai = 0; ai < 2; ++ai)
#pragma unroll
                for (int bj = 0; bj < 2; ++bj)
#pragma unroll
                    for (int n = 0; n < 2; ++n) *(PG8_LAS f32x4*)(X + (((2 * ai + wr) * 2 + (fr - 14)) * 256 + bj * 128 + xcol + 4 * n)) = acc[ai][bj][3][n];
        }
        asm volatile("s_waitcnt lgkmcnt(0)" ::: "memory"); __builtin_amdgcn_s_barrier(); asm volatile("" ::: "memory"); __builtin_amdgcn_s_barrier(); asm volatile("" ::: "memory");
        const int batch = u.pm / 33, jt = u.pm % 33;
#pragma unroll
        for (int ai = 0; ai < 2; ++ai)
#pragma unroll
            for (int m = 0; m < 4; ++m) {
                const int r = 128 * ai + 64 * wr + 16 * m + fr, pos = 254 * jt - 2 + r, blk = 2 * ai + wr;
                float gv[2][8];
#pragma unroll
                for (int bj = 0; bj < 2; ++bj)
#pragma unroll
                    for (int n = 0; n < 2; ++n) {
                        const f32x4 cur = acc[ai][bj][m][n]; f32x4 q1, q2;
                        if (m > 0) { const f32x4 pv = acc[ai][bj][m - 1][n];
#pragma unroll
                            for (int e = 0; e < 4; ++e) { q1[e] = dpp_ror1(pv[e]); q2[e] = dpp_ror2(pv[e]); } }
                        else if (blk > 0) { q1 = *(const PG8_LAS f32x4*)(X + (((blk - 1) * 2 + 1) * 256 + bj * 128 + xcol + 4 * n)); q2 = *(const PG8_LAS f32x4*)(X + (((blk - 1) * 2 + (fr & 1)) * 256 + bj * 128 + xcol + 4 * n)); }
                        else { q1 = (f32x4){0.f, 0.f, 0.f, 0.f}; q2 = q1; }
                        const f32x4 w0 = *(const PG8_LAS f32x4*)(CW + (0 * 2 + bj) * 128 + xcol + 4 * n), w1 = *(const PG8_LAS f32x4*)(CW + (1 * 2 + bj) * 128 + xcol + 4 * n), w2 = *(const PG8_LAS f32x4*)(CW + (2 * 2 + bj) * 128 + xcol + 4 * n);
#pragma unroll
                        for (int e = 0; e < 4; ++e) { const float p1 = dpp_shr1(q1[e], cur[e]), p2 = dpp_shr2(q2[e], cur[e]); gv[bj][4 * n + e] = w0[e] * p2 + w1[e] * p1 + w2[e] * cur[e]; }
                    }
                u32x4 w; float a[8];
#pragma unroll
                for (int e = 0; e < 8; ++e) a[e] = silu(gv[0][e]) * gv[1][e];
                w.x = pk2(a[0], a[1]); w.y = pk2(a[2], a[3]); w.z = pk2(a[4], a[5]); w.w = pk2(a[6], a[7]);
                if (r >= 2 && pos <= 8207) { const size_t orow = pos >= 16 ? (size_t)batch * 8192 + (pos - 16) : (size_t)MMAIN + 64 * batch + 48 + pos;
                    *(u32x4*)(ACT + orow * DFF + f0) = w; }
            }
    }
};
struct EpiRes {
    static constexpr bool PERM = true, AFTER_DRAIN = false;
    float *hmain, *hmeta; float scale;
    DI void operator()(const f32x4 (&acc)[2][2][4][2], const pg8::Unit& u, int wr, int wc, int fr, int fq) const {
        const int col0 = u.pn * 256 + wc * 32 + 8 * fq;
#pragma unroll
        for (int ai = 0; ai < 2; ++ai) {
            f32x4 t[4][2][2];
#pragma unroll
            for (int m = 0; m < 4; ++m) { const int row = u.pm * 256 + ai * 128 + wr * 64 + m * 16 + fr;
                const float* rp = (row < MMAIN ? hmain + (size_t)row * 1024 : hmeta + (size_t)(row - MMAIN) * 1024) + col0;
#pragma unroll
                for (int bj = 0; bj < 2; ++bj)
#pragma unroll
                    for (int n = 0; n < 2; ++n) t[m][bj][n] = *(const f32x4*)(rp + bj * 128 + n * 4); }
#pragma unroll
            for (int m = 0; m < 4; ++m) { const int row = u.pm * 256 + ai * 128 + wr * 64 + m * 16 + fr;
                float* rp = (row < MMAIN ? hmain + (size_t)row * 1024 : hmeta + (size_t)(row - MMAIN) * 1024) + col0;
#pragma unroll
                for (int bj = 0; bj < 2; ++bj)
#pragma unroll
                    for (int n = 0; n < 2; ++n) *(f32x4*)(rp + bj * 128 + n * 4) = t[m][bj][n] + acc[ai][bj][m][n] * scale; }
        }
    }
};

struct MstQKV { bf16_t *Q, *halo; DI void operator()(int b, int i, int col, float v) const {
    const int which = col >> 10, head = (col >> 7) & 7, cc = col & 127, cb = 256 + b, rr = 48 + i; const bf16_t w = f2bf(v);
    Q[(size_t)which * (SZ_ACT / 2) + ((size_t)(cb * 8 + head) * 64 + rr) * 128 + cc] = w;
    if (rr >= 61) halo[((size_t)cb * 3 + rr - 61) * 3072 + col] = w; } };
struct MstZPG { bf16_t* QB0; DI void operator()(int b, int i, int col, float v) const {
    const int ge1 = col >= 1024, ge2 = col >= 1536, ge3 = col >= 2560, idx = ge1 + ge2 + ge3, is1 = (idx == 1);
    const int slot = idx + 4 * is1, ld = 1024 >> is1, c = col - (1024 * ge1 + 512 * ge2 + 1024 * ge3); const size_t row = MMAIN + 64 * b + 48 + i;
    QB0[(size_t)slot * (SZ_ACT / 2) + row * ld + c] = f2bf(v); } };
struct MstRes { float* hm; DI void operator()(int b, int i, int col, float v) const { (void)__hip_atomic_fetch_add(hm + (size_t)(64 * b + 48 + i) * 1024 + col, v, __ATOMIC_RELAXED, __HIP_MEMORY_SCOPE_AGENT); } };
struct MstHid { bf16_t *H, *halo; DI void operator()(int b, int i, int col, float v) const {
    const size_t row = MMAIN + 64 * b + 48 + i; const int rr = 48 + i; const bf16_t w = f2bf(v);
    H[row * FF2 + col] = w; if (rr >= 62) halo[((size_t)(256 + b) * 2 + rr - 62) * FF2 + col] = w; } };
template <class St> DI void meta_gemm(unsigned char* smem, const bf16_t* A, int lda, const bf16_t* Bt, int ldb, int K, int nitems, const St& st, int tid) {
    const int lane = tid & 63, wid = tid >> 6, q4 = lane >> 4, l16 = lane & 15;
    float* red = (float*)smem;
    for (int it = (int)gridDim.x - 1 - (int)blockIdx.x; it < nitems; it += gridDim.x) {
        const int n0 = it * 16;
        const bf16_t* a0 = A + (size_t)(MMAIN + 48 + l16) * lda + 8 * q4; const bf16_t* a1 = a0 + (size_t)64 * lda;
        const bf16_t* bp = Bt + (size_t)(n0 + l16) * ldb + 8 * q4;
        const int ks = K >> 3, kbeg = wid * ks, kend = kbeg + ks;
        f32x4 d0 = {0.f, 0.f, 0.f, 0.f}, d1 = {0.f, 0.f, 0.f, 0.f};
        for (int k = kbeg; k < kend; k += 128) { bf16x8 fa0[4], fa1[4], fb[4]; const int nst = (kend - k) >> 5;
#pragma unroll
            for (int s = 0; s < 4; ++s) if (s < nst) { fa0[s] = *(const bf16x8*)(a0 + k + 32 * s); fa1[s] = *(const bf16x8*)(a1 + k + 32 * s); fb[s] = *(const bf16x8*)(bp + k + 32 * s); }
#pragma unroll
            for (int s = 0; s < 4; ++s) if (s < nst) { d0 = mfma16(fa0[s], fb[s], d0); d1 = mfma16(fa1[s], fb[s], d1); } }
        *(f32x4*)(red + (wid * 64 + lane) * 8) = d0; *(f32x4*)(red + (wid * 64 + lane) * 8 + 4) = d1;
        __syncthreads();
        if (wid == 0) {
#pragma unroll
            for (int w = 1; w < 8; ++w) { d0 += *(const f32x4*)(red + (w * 64 + lane) * 8); d1 += *(const f32x4*)(red + (w * 64 + lane) * 8 + 4); }
#pragma unroll
            for (int e = 0; e < 4; ++e) { st(0, 4 * q4 + e, n0 + l16, d0[e]); st(1, 4 * q4 + e, n0 + l16, d1[e]); } }
        __syncthreads();
    }
}

struct CvtTile { const float* src; bf16_t* dst; int ldw, ldb; };
DI CvtTile cvt_decode(const Params& p, int layer, int t) {
    const float* win = p.w_in + (size_t)layer * 1024 * IN_DIM; const float* wout = p.w_out + (size_t)layer * 1024 * 1024;
    const float* wup = p.w_up + (size_t)layer * 1024 * FF2; const float* wdn = p.w_down + (size_t)layer * DFF * 1024; const float* wpl = p.w_pool + (size_t)layer * 4 * 128 * 256;
    bf16_t* Win = (bf16_t*)(p.ws + WS_WIN); bf16_t* Wout = (bf16_t*)(p.ws + WS_WOUT); bf16_t* Wup = (bf16_t*)(p.ws + WS_WUP); bf16_t* Wdn = (bf16_t*)(p.ws + WS_WDN); bf16_t* Wpt = (bf16_t*)(p.ws + WS_WPT);
    CvtTile c;
    if (t < 1664) { const int kt = t / 104, nt = t % 104, n0 = nt * 64; c.src = win + (size_t)(kt * 64) * IN_DIM + n0 + (n0 >= 4096 ? 16 : 0); c.ldw = IN_DIM; c.dst = Win + (size_t)n0 * 1024 + kt * 64; c.ldb = 1024; }
    else if (t < 1920) { const int q = t - 1664, kt = q >> 4, nt = q & 15; c.src = wout + (size_t)(kt * 64) * 1024 + nt * 64; c.ldw = 1024; c.dst = Wout + (size_t)(nt * 64) * 1024 + kt * 64; c.ldb = 1024; }
    else if (t < 3328) { const int q = t - 1920, kt = q / 88, nt = q % 88; const int n0 = nt * 64; c.src = wup + (size_t)(kt * 64) * FF2 + ((n0 >> 7) & 1) * DFF + (n0 >> 8) * 128 + (n0 & 127); c.ldw = FF2; c.dst = Wup + (size_t)(nt * 64) * 1024 + kt * 64; c.ldb = 1024; }
    else if (t < 4032) { const int q = t - 3328, kt = q >> 4, nt = q & 15; c.src = wdn + (size_t)(kt * 64) * 1024 + nt * 64; c.ldw = 1024; c.dst = Wdn + (size_t)(nt * 64) * DFF + kt * 64; c.ldb = DFF; }
    else { const int q = t - 4032, g = q >> 3, kt = (q >> 2) & 1, nt = q & 3; c.src = wpl + (size_t)g * 128 * 256 + (size_t)(kt * 64) * 256 + nt * 64; c.ldw = 256; c.dst = Wpt + (size_t)g * 256 * 128 + (size_t)(nt * 64) * 128 + kt * 64; c.ldb = 128; }
    return c;
}
DI void convert_weights(const Params& p, int layer, unsigned char* smem, int tid, int t_begin, int t_end, int blk, int nblk) {
    float* tl0 = (float*)smem; float* tl1 = tl0 + 64 * 65;
    const int kk = tid >> 4, c4 = (tid & 15) * 4, nn = tid >> 3, k8 = (tid & 7) * 8;
    int t = t_begin + blk; if (t >= t_end) return;
    CvtTile a = cvt_decode(p, layer, t); bool hb = (t + nblk < t_end); CvtTile b = hb ? cvt_decode(p, layer, t + nblk) : a;
    float4 a0 = *(const float4*)(a.src + (size_t)kk * a.ldw + c4), a1 = *(const float4*)(a.src + (size_t)(kk + 32) * a.ldw + c4);
    float4 b0 = *(const float4*)(b.src + (size_t)kk * b.ldw + c4), b1 = *(const float4*)(b.src + (size_t)(kk + 32) * b.ldw + c4);
    for (;;) {
        const int tn = t + 2 * nblk; const bool more = tn < t_end;
        CvtTile na = a, nb = b; bool nhb = false; float4 na0 = a0, na1 = a1, nb0 = b0, nb1 = b1;
        if (more) { na = cvt_decode(p, layer, tn); nhb = (tn + nblk < t_end); nb = nhb ? cvt_decode(p, layer, tn + nblk) : na;
            na0 = *(const float4*)(na.src + (size_t)kk * na.ldw + c4); na1 = *(const float4*)(na.src + (size_t)(kk + 32) * na.ldw + c4);
            nb0 = *(const float4*)(nb.src + (size_t)kk * nb.ldw + c4); nb1 = *(const float4*)(nb.src + (size_t)(kk + 32) * nb.ldw + c4); }
        tl0[kk * 65 + c4 + 0] = a0.x; tl0[kk * 65 + c4 + 1] = a0.y; tl0[kk * 65 + c4 + 2] = a0.z; tl0[kk * 65 + c4 + 3] = a0.w;
        tl0[(kk + 32) * 65 + c4 + 0] = a1.x; tl0[(kk + 32) * 65 + c4 + 1] = a1.y; tl0[(kk + 32) * 65 + c4 + 2] = a1.z; tl0[(kk + 32) * 65 + c4 + 3] = a1.w;
        if (hb) { tl1[kk * 65 + c4 + 0] = b0.x; tl1[kk * 65 + c4 + 1] = b0.y; tl1[kk * 65 + c4 + 2] = b0.z; tl1[kk * 65 + c4 + 3] = b0.w;
            tl1[(kk + 32) * 65 + c4 + 0] = b1.x; tl1[(kk + 32) * 65 + c4 + 1] = b1.y; tl1[(kk + 32) * 65 + c4 + 2] = b1.z; tl1[(kk + 32) * 65 + c4 + 3] = b1.w; }
        __syncthreads();
        { float f[8];
#pragma unroll
          for (int j = 0; j < 8; ++j) f[j] = tl0[(k8 + j) * 65 + nn];
          u32x4 w; w.x = pk2(f[0], f[1]); w.y = pk2(f[2], f[3]); w.z = pk2(f[4], f[5]); w.w = pk2(f[6], f[7]);
          *(u32x4*)(a.dst + (size_t)nn * a.ldb + k8) = w; }
        if (hb) { float f[8];
#pragma unroll
          for (int j = 0; j < 8; ++j) f[j] = tl1[(k8 + j) * 65 + nn];
          u32x4 w; w.x = pk2(f[0], f[1]); w.y = pk2(f[2], f[3]); w.z = pk2(f[4], f[5]); w.w = pk2(f[6], f[7]);
          *(u32x4*)(b.dst + (size_t)nn * b.ldb + k8) = w; }
        __syncthreads();
        if (!more) break;
        t = tn; a = na; b = nb; hb = nhb; a0 = na0; a1 = na1; b0 = nb0; b1 = nb1;
    }
}

DI const float* norm_src(const Params& p, bool init, int r) {
    if (!init) return hrow(p, r);
    if (r < MMAIN) return p.x + (size_t)r * 1024;
    const int rm = r - MMAIN, s = rm & 63; return (rm < 128 && s >= 48) ? p.meta + (size_t)(s - 48) * 1024 : nullptr;
}
DI void phase_norm(const Params& p, int layer, int which, unsigned char* smem) {
    const int tid = opaque_tid(p), lane = tid & 63, wid = tid >> 6;
    float* wba = (float*)smem;
    float* BA = (float*)(p.ws + WS_BA); bf16_t* U = (bf16_t*)(p.ws + WS_U);
    if (which == 0) {
        convert_weights(p, layer, smem, tid, 0, 1664, (int)blockIdx.x, (int)gridDim.x);
        __syncthreads();
        const float* win = p.w_in + (size_t)layer * 1024 * IN_DIM;
        for (int e = tid; e < 4096; e += 512) { const int k = e >> 2, j4 = (e & 3) * 4; const float4 w = *(const float4*)(win + (size_t)k * IN_DIM + 4096 + j4);
            wba[(j4 + 0) * 1024 + k] = w.x; wba[(j4 + 1) * 1024 + k] = w.y; wba[(j4 + 2) * 1024 + k] = w.z; wba[(j4 + 3) * 1024 + k] = w.w; }
        __syncthreads();
    }
    if (which == 1 && blockIdx.x == 0) { for (int e = tid; e < 4 * 128; e += 512) { const int rr = e >> 7, c8 = (e & 127) * 8; *(u32x4*)(U + ((size_t)(rr >> 1) * USEQ + (rr & 1)) * 1024 + c8) = (u32x4){0u, 0u, 0u, 0u}; } }
    const float* gain = (which == 0 ? p.norm_mix : p.norm_ffn) + layer * 1024;
    const bool init = (layer == 0 && which == 0);
    int r = blockIdx.x * 8 + wid; const int rstep = gridDim.x * 8;
    f32x4 nv[4];
    { const float* s0 = r < MPAD ? norm_src(p, init, r) : nullptr;
#pragma unroll
      for (int i = 0; i < 4; ++i) nv[i] = s0 ? *(const f32x4*)(s0 + 256 * i + 4 * lane) : (f32x4){0.f, 0.f, 0.f, 0.f}; }
    for (; r < MPAD; r += rstep) {
        f32x4 v[4]; float ss = 0.f;
#pragma unroll
        for (int i = 0; i < 4; ++i) { v[i] = nv[i]; ss += (v[i][0] * v[i][0] + v[i][1] * v[i][1]) + (v[i][2] * v[i][2] + v[i][3] * v[i][3]); }
        { const int rn = r + rstep; const float* s1 = rn < MPAD ? norm_src(p, init, rn) : nullptr;
#pragma unroll
          for (int i = 0; i < 4; ++i) nv[i] = s1 ? *(const f32x4*)(s1 + 256 * i + 4 * lane) : (f32x4){0.f, 0.f, 0.f, 0.f}; }
        if (r >= MMAIN) { const int rm_ = r - MMAIN; if (!(rm_ < 128 && (rm_ & 63) >= 48)) continue; }
        if (init) { float* hr = hrow(p, r);
#pragma unroll
            for (int i = 0; i < 4; ++i) *(f32x4*)(hr + 256 * i + 4 * lane) = v[i]; }
        ss = wsum(ss, lane);
        const float rstd = rsqrtf(ss * (1.0f / 1024.0f) + 1e-6f);
        long urow = r;
        if (which == 1) { if (r < MMAIN) urow = (long)(r >> 13) * USEQ + 18 + (r & 8191); else { const int rm = r - MMAIN, s = rm & 63; urow = (rm < 128 && s >= 48) ? (long)(rm >> 6) * USEQ + 2 + (s - 48) : -1; } }
#pragma unroll
        for (int i = 0; i < 4; ++i) { const f32x4 g4 = *(const f32x4*)(gain + 256 * i + 4 * lane); v[i] = v[i] * rstd * g4;
            if (urow >= 0) { u32x2 w; w.x = pk2(v[i][0], v[i][1]); w.y = pk2(v[i][2], v[i][3]); *(u32x2*)(U + (size_t)urow * 1024 + 256 * i + 4 * lane) = w; } }
        if (which == 0) {
            float acc[16]; int vz = 0; asm volatile("" : "+v"(vz)); const float* wbz = wba + vz + 4 * lane;
#pragma unroll
            for (int j = 0; j < 16; ++j) { float a = 0.f;
#pragma unroll
                for (int i = 0; i < 4; ++i) { const f32x4 w = *(const f32x4*)(wbz + j * 1024 + 256 * i); a += (v[i][0] * w[0] + v[i][1] * w[1]) + (v[i][2] * w[2] + v[i][3] * w[3]); }
                acc[j] = a; }
#pragma unroll
            for (int off = 32; off >= 1; off >>= 1) { float t[16];
#pragma unroll
                for (int j = 0; j < 16; ++j) t[j] = shxl(acc[j], off, lane);
#pragma unroll
                for (int j = 0; j < 16; ++j) acc[j] += t[j]; }
            float o = 0.f;
#pragma unroll
            for (int j = 0; j < 16; ++j) o = (lane == j) ? acc[j] : o;
            if (lane < 16) BA[(size_t)r * 16 + lane] = o;
        }
    }
}
DI void phase_final(const Params& p) {
    const int tid = opaque_tid(p), lane = tid & 63, wid = tid >> 6;
    for (int r = blockIdx.x * 8 + wid; r < MMAIN; r += gridDim.x * 8) {
        float* hr = p.out + (size_t)r * 1024; f32x4 v[4]; float ss = 0.f;
#pragma unroll
        for (int i = 0; i < 4; ++i) { v[i] = *(const f32x4*)(hr + 256 * i + 4 * lane); ss += (v[i][0] * v[i][0] + v[i][1] * v[i][1]) + (v[i][2] * v[i][2] + v[i][3] * v[i][3]); }
        ss = wsum(ss, lane); const float rstd = rsqrtf(ss * (1.0f / 1024.0f) + 1e-6f);
#pragma unroll
        for (int i = 0; i < 4; ++i) *(f32x4*)(hr + 256 * i + 4 * lane) = v[i] * rstd * *(const f32x4*)(p.norm_final + 256 * i + 4 * lane);
    }
}

DI void phase_p3(const Params& p, int layer, unsigned char* smem, int pblk, int npblk) {
    const int tid = opaque_tid(p), lane = tid & 63, wid = tid >> 6; int q4 = lane >> 4, l16 = lane & 15;
    bf16_t* qs = (bf16_t*)(smem); bf16_t* ks = (bf16_t*)(smem + 17408); bf16_t* vbT = (bf16_t*)(smem + 34816); bf16_t* kgT = (bf16_t*)(smem + 53248);
    float* Lm = (float*)(smem + 71680); bf16_t* Tb = (bf16_t*)(smem + 89088); float* sc = (float*)(smem + 98304);
    bf16_t* QB = (bf16_t*)(p.ws + WS_QB); bf16_t* KB = (bf16_t*)(p.ws + WS_KB); bf16_t* VB = (bf16_t*)(p.ws + WS_VB); bf16_t* WB = (bf16_t*)(p.ws + WS_WB);
    bf16_t* KTB = (bf16_t*)(p.ws + WS_KTB); bf16_t* QKB = (bf16_t*)(p.ws + WS_QKB); const bf16_t* HALO = (const bf16_t*)(p.ws + WS_HALO);
    const float* BA = (const float*)(p.ws + WS_BA); float* GT = (float*)(p.ws + WS_GT);
    const float* cw = p.conv_qkv + (size_t)layer * 4 * 3072;
    const float SCALE = 0.08838834764831845f;
    unsigned* flags = (unsigned*)(p.ws + WS_FLAG) + layer * 2080;
    const unsigned* XT = (const unsigned*)(p.ws + WS_XT); const unsigned myx = xb_xcc_id();
    for (int o = pblk; o < 129 * 16; o += npblk) {
        const int c = o >> 4, b = (o >> 3) & 1, h = o & 7, cb = (c == 0) ? 256 + b : 128 * b + c - 1, item = cb * 8 + h;
        const int prev_cb = (c == 0) ? -1 : (c == 1 ? 256 + b : cb - 1);
        const size_t blk = (size_t)item * 8192;
            const int c0 = 2 * lane, r0 = 8 * wid;
            float wq[4][2], wk[4][2], wv[4][2];
#pragma unroll
            for (int j = 0; j < 4; ++j)
#pragma unroll
                for (int e = 0; e < 2; ++e) { wq[j][e] = cw[j * 3072 + h * 128 + c0 + e]; wk[j][e] = cw[j * 3072 + 1024 + h * 128 + c0 + e]; wv[j][e] = cw[j * 3072 + 2048 + h * 128 + c0 + e]; }
            unsigned xq[11], xk[11], xv[11];
#pragma unroll
            for (int i = 0; i < 11; ++i) { const int rr = r0 - 3 + i;
                if (c == 0 && rr < 48) { xq[i] = 0u; xk[i] = 0u; xv[i] = 0u; }
                else if (rr >= 0) { xq[i] = *(const unsigned*)(QB + blk + rr * 128 + c0); xk[i] = *(const unsigned*)(KB + blk + rr * 128 + c0); xv[i] = *(const unsigned*)(VB + blk + rr * 128 + c0); }
                else if (prev_cb >= 0) { const bf16_t* hp = HALO + ((size_t)prev_cb * 3 + (rr + 3)) * 3072 + h * 128 + c0; xq[i] = *(const unsigned*)hp; xk[i] = *(const unsigned*)(hp + 1024); xv[i] = *(const unsigned*)(hp + 2048); }
                else { xq[i] = 0u; xk[i] = 0u; xv[i] = 0u; } }
        if (wid == 0) {
            const int row = cb * 64 + lane;
            const float braw = BA[(size_t)row * 16 + h], araw = BA[(size_t)row * 16 + 8 + h];
            float beta = 1.0f / (1.0f + expf(-braw));
            const float xx = araw + p.dt_bias[layer * 8 + h]; const float sp = fmaxf(xx, 0.f) + __logf(1.0f + __expf(-fabsf(xx)));
            float g = -expf(p.a_log[layer * 8 + h]) * sp;
            if (c == 0 && lane < 48) { g = 0.f; beta = 0.f; }
            float G = g;
#pragma unroll
            for (int off = 1; off < 64; off <<= 1) { const float t = __builtin_bit_cast(float, __builtin_amdgcn_ds_bpermute(((lane - off) & 63) << 2, __builtin_bit_cast(int, G))); if (lane >= off) G += t; }
            const float Gl = __builtin_bit_cast(float, __builtin_amdgcn_readlane(__builtin_bit_cast(int, G), 63));
            sc[lane] = beta; sc[64 + lane] = G; sc[128 + lane] = expf(G); sc[192 + lane] = expf(Gl - G);
            if (lane == 63) st_wt4(GT + (size_t)item * 32, expf(G));
        }
        __syncthreads();
        {
            float cq[8][2], ck[8][2], cv[8][2], sq[8], sk[8];
#pragma unroll
            for (int i = 0; i < 8; ++i) {
                float cq0 = 0.f, cq1 = 0.f, ck0 = 0.f, ck1 = 0.f, cv0 = 0.f, cv1 = 0.f;
#pragma unroll
                for (int j = 0; j < 4; ++j) { cq0 += wq[j][0] * bflo(xq[i + j]); cq1 += wq[j][1] * bfhi(xq[i + j]); ck0 += wk[j][0] * bflo(xk[i + j]); ck1 += wk[j][1] * bfhi(xk[i + j]);
                    cv0 += wv[j][0] * bflo(xv[i + j]); cv1 += wv[j][1] * bfhi(xv[i + j]); }
                cq[i][0] = silu(cq0); cq[i][1] = silu(cq1); ck[i][0] = silu(ck0); ck[i][1] = silu(ck1); cv[i][0] = silu(cv0); cv[i][1] = silu(cv1);
                sq[i] = cq[i][0] * cq[i][0] + cq[i][1] * cq[i][1]; sk[i] = ck[i][0] * ck[i][0] + ck[i][1] * ck[i][1];
            }
#pragma unroll
            for (int off = 32; off >= 1; off >>= 1) { float tq[8], tk[8];
#pragma unroll
                for (int i = 0; i < 8; ++i) { tq[i] = shxl(sq[i], off, lane); tk[i] = shxl(sk[i], off, lane); }
#pragma unroll
                for (int i = 0; i < 8; ++i) { sq[i] += tq[i]; sk[i] += tk[i]; } }
#pragma unroll
            for (int i = 0; i < 8; ++i) {
                const int r = r0 + i;
                const float rq = rsqrtf(sq[i] + 1e-6f), rk = rsqrtf(sk[i] + 1e-6f);
                const float cq0 = cq[i][0] * rq, cq1 = cq[i][1] * rq, ck0 = ck[i][0] * rk, ck1 = ck[i][1] * rk, cv0 = cv[i][0], cv1 = cv[i][1];
                const float beta = sc[r], eg = sc[128 + r];
                *(unsigned*)(qs + r * 136 + c0) = pk2(cq0, cq1); *(unsigned*)(ks + r * 136 + c0) = pk2(ck0, ck1);
                vbT[(c0 + 0) * 72 + r] = f2bf(cv0 * beta); vbT[(c0 + 1) * 72 + r] = f2bf(cv1 * beta);
                kgT[(c0 + 0) * 72 + r] = f2bf(ck0 * beta * eg); kgT[(c0 + 1) * 72 + r] = f2bf(ck1 * beta * eg);
            }
        }
        __syncthreads();
        { int lz = lane; asm volatile("" : "+v"(lz)); q4 = lz >> 4; l16 = lz & 15; }
        if (wid < 4) {
            const int mt = wid; bf16x8 a[4];
#pragma unroll
            for (int kb = 0; kb < 4; ++kb) a[kb] = *(const bf16x8*)(ks + (16 * mt + l16) * 136 + 32 * kb + 8 * q4);
            for (int nt = 0; nt <= mt; ++nt) {
                f32x4 d = {0.f, 0.f, 0.f, 0.f};
#pragma unroll
                for (int kb = 0; kb < 4; ++kb) d = mfma16(a[kb], *(const bf16x8*)(ks + (16 * nt + l16) * 136 + 32 * kb + 8 * q4), d);
                const int j_ = 16 * nt + l16; const float Gj = sc[64 + j_];
#pragma unroll
                for (int i = 0; i < 4; ++i) { const int i_ = 16 * mt + 4 * q4 + i; Lm[i_ * 68 + j_] = (i_ > j_) ? sc[i_] * d[i] * expf(sc[64 + i_] - Gj) : 0.f; }
            }
            for (int nt = mt + 1; nt < 4; ++nt) {
#pragma unroll
                for (int i = 0; i < 4; ++i) Lm[(16 * mt + 4 * q4 + i) * 68 + 16 * nt + l16] = 0.f; }
        } else {
            const int nti = wid - 4; bf16x8 bq[4]; f32x4 d[4];
#pragma unroll
            for (int kb = 0; kb < 4; ++kb) bq[kb] = *(const bf16x8*)(qs + (16 * nti + l16) * 136 + 32 * kb + 8 * q4);
            const int i_ = 16 * nti + l16; const float Gi = sc[64 + i_];
#pragma unroll
            for (int mtj = 0; mtj < 4; ++mtj) {
                f32x4 t = {0.f, 0.f, 0.f, 0.f};
                if (mtj <= nti) {
#pragma unroll
                    for (int kb = 0; kb < 4; ++kb) t = mfma16(*(const bf16x8*)(ks + (16 * mtj + l16) * 136 + 32 * kb + 8 * q4), bq[kb], t);
#pragma unroll
                    for (int i = 0; i < 4; ++i) { const int j_ = 16 * mtj + 4 * q4 + i; t[i] = (i_ >= j_) ? t[i] * SCALE * expf(Gi - sc[64 + j_]) : 0.f; }
                }
                d[mtj] = t;
            }
            st_wt16(QKB + (size_t)item * 4096 + ((nti * 2 + 0) * 64 + lane) * 8, __builtin_bit_cast(u32x4, pack8(d[0], d[1])));
            st_wt16(QKB + (size_t)item * 4096 + ((nti * 2 + 1) * 64 + lane) * 8, __builtin_bit_cast(u32x4, pack8(d[2], d[3])));
        }
        __syncthreads();
        if (wid < 4) {
            int vz; asm volatile("v_mov_b32 %0, 0" : "=v"(vz));
            const int lz = lane + vz, jcol = 16 * wid + (lz >> 2), part = lz & 3;
            const float* Lv = Lm + vz + 4 * part;
            float tq[4][4];
#pragma unroll
            for (int a = 0; a < 4; ++a)
#pragma unroll
                for (int e = 0; e < 4; ++e) tq[a][e] = 0.f;
#pragma unroll
            for (int i = 0; i < 64; ++i) {
                float a = 0.f;
#pragma unroll
                for (int kq = 0; kq * 16 < i; ++kq) { const float4 l = *(const float4*)(Lv + i * 68 + 16 * kq); a += (l.x * tq[kq][0] + l.y * tq[kq][1]) + (l.z * tq[kq][2] + l.w * tq[kq][3]); }
                a += __builtin_bit_cast(float, __builtin_amdgcn_update_dpp(0, __builtin_bit_cast(int, a), 0xB1, 0xf, 0xf, true));
                a += __builtin_bit_cast(float, __builtin_amdgcn_update_dpp(0, __builtin_bit_cast(int, a), 0x4E, 0xf, 0xf, true));
                const float ti = ((i == jcol) ? 1.f : 0.f) - a;
                tq[i >> 4][i & 3] = (part == ((i >> 2) & 3)) ? ti : tq[i >> 4][i & 3];
            }
#pragma unroll
            for (int kq = 0; kq < 4; ++kq)
#pragma unroll
                for (int e = 0; e < 4; ++e) Tb[(16 * kq + 4 * part + e) * 72 + jcol] = f2bf(tq[kq][e]);
        } else {
            { int lz = lane; asm volatile("" : "+v"(lz)); q4 = lz >> 4; l16 = lz & 15; }
            for (int f = wid - 4; f < 32; f += 4) {
                if (f < 16) {
                    const int mt = f >> 2, kb = f & 3, row = 16 * mt + l16; const float s = SCALE * sc[128 + row];
                    const u32x2 lo = *(const u32x2*)(qs + row * 136 + 32 * kb + 4 * q4), hi = *(const u32x2*)(qs + row * 136 + 32 * kb + 16 + 4 * q4);
                    u32x4 w; w.x = pk2(bflo(lo.x) * s, bfhi(lo.x) * s); w.y = pk2(bflo(lo.y) * s, bfhi(lo.y) * s); w.z = pk2(bflo(hi.x) * s, bfhi(hi.x) * s); w.w = pk2(bflo(hi.y) * s, bfhi(hi.y) * s);
                    st_wt16(QB + blk + (f * 64 + lane) * 8, w);
                } else {
                    const int ff = f - 16, mtd = ff >> 1, kb2 = ff & 1, dk = 16 * mtd + l16; float v[8];
#pragma unroll
                    for (int j = 0; j < 8; ++j) { const int tok = 32 * kb2 + 16 * (j >> 2) + 4 * q4 + (j & 3); v[j] = bf2f(ks[tok * 136 + dk]) * sc[192 + tok]; }
                    u32x4 w; w.x = pk2(v[0], v[1]); w.y = pk2(v[2], v[3]); w.z = pk2(v[4], v[5]); w.w = pk2(v[6], v[7]);
                    st_wt16(KTB + blk + (ff * 64 + lane) * 8, w);
                }
            }
        }
        __syncthreads();
        { int lz = lane; asm volatile("" : "+v"(lz)); q4 = lz >> 4; l16 = lz & 15; }
        {
            const int nt = wid; bf16x8 bv[2]; f32x4 d[4];
#pragma unroll
            for (int kb2 = 0; kb2 < 2; ++kb2) bv[kb2] = *(const bf16x8*)(vbT + (16 * nt + l16) * 72 + 32 * kb2 + 8 * q4);
#pragma unroll
            for (int mt = 0; mt < 4; ++mt) { f32x4 t = {0.f, 0.f, 0.f, 0.f};
#pragma unroll
                for (int kb2 = 0; kb2 < 2; ++kb2) t = mfma16(*(const bf16x8*)(Tb + (16 * mt + l16) * 72 + 32 * kb2 + 8 * q4), bv[kb2], t);
                d[mt] = t; }
            st_wt16(VB + blk + nt * 1024 + lane * 16, __builtin_bit_cast(u32x4, pack8(d[0], d[1])));
            st_wt16(VB + blk + nt * 1024 + lane * 16 + 8, __builtin_bit_cast(u32x4, pack8(d[2], d[3])));
        }
        {
            const int mtt = wid & 3, half = wid >> 2; bf16x8 bt[2]; f32x4 d[4];
#pragma unroll
            for (int kb2 = 0; kb2 < 2; ++kb2) bt[kb2] = *(const bf16x8*)(Tb + (16 * mtt + l16) * 72 + 32 * kb2 + 8 * q4);
#pragma unroll
            for (int m4 = 0; m4 < 4; ++m4) { const int mtd = 4 * half + m4; f32x4 t = {0.f, 0.f, 0.f, 0.f};
#pragma unroll
                for (int kb2 = 0; kb2 < 2; ++kb2) t = mfma16(*(const bf16x8*)(kgT + (16 * mtd + l16) * 72 + 32 * kb2 + 8 * q4), bt[kb2], t);
                d[m4] = t; }
            st_wt16(WB + blk + ((mtt * 4 + 2 * half + 0) * 64 + lane) * 8, __builtin_bit_cast(u32x4, pack8(d[0], d[1])));
            st_wt16(WB + blk + ((mtt * 4 + 2 * half + 1) * 64 + lane) * 8, __builtin_bit_cast(u32x4, pack8(d[2], d[3])));
        }
        asm volatile("s_waitcnt vmcnt(0)" ::: "memory");
        __syncthreads();
        if (tid == 0) { const int g_ = b * 8 + h, sb0_ = (g_ & 7) + 16 * (g_ >> 3);
            if (XT[sb0_] != myx || XT[sb0_ + 8] != myx) { __builtin_amdgcn_fence(__ATOMIC_RELEASE, "agent"); asm volatile("s_waitcnt vmcnt(0)" ::: "memory"); }
            __hip_atomic_store(flags + item, 1u, __ATOMIC_RELAXED, __HIP_MEMORY_SCOPE_AGENT); }
    }
}

template <bool MIDBAR> DI void scan_step(const unsigned char* buf, const unsigned char* ubuf, const float gt, f32x4 (&S)[8], bf16_t* op, int ostride, int lane) {
    const bf16x8* Wf = (const bf16x8*)(buf) + lane; const bf16x8* Qf = (const bf16x8*)(buf + 16384) + lane;
    const bf16x8* Kf = (const bf16x8*)(buf + 32768) + lane; const bf16x8* Pf = (const bf16x8*)(buf + 49152) + lane;
#define SC_SB() __builtin_amdgcn_sched_barrier(0)
    bf16x8 fa[16], fb[16], Sb[4], Vb[2]; f32x4 vn[4], o[4];
#pragma unroll
    for (int f = 0; f < 16; ++f) fa[f] = Wf[f * 64];
#pragma unroll
    for (int kb = 0; kb < 4; ++kb) Sb[kb] = pack8(S[2 * kb], S[2 * kb + 1]);
    SC_SB();
#pragma unroll
    for (int f = 0; f < 16; ++f) fb[f] = Qf[f * 64];
    SC_SB();
    if (MIDBAR) { asm volatile("s_waitcnt lgkmcnt(0)" ::: "memory"); __builtin_amdgcn_s_barrier(); asm volatile("" ::: "memory"); SC_SB(); }
    const u32x4 u0 = *(const u32x4*)(ubuf + lane * 32), u1 = *(const u32x4*)(ubuf + lane * 32 + 16);
    const unsigned uw[8] = {u0.x, u0.y, u0.z, u0.w, u1.x, u1.y, u1.z, u1.w};
#pragma unroll
    for (int mt = 0; mt < 4; ++mt) { f32x4 a = {0.f, 0.f, 0.f, 0.f};
#pragma unroll
        for (int kb = 0; kb < 4; ++kb) a = mfma16(fa[mt * 4 + kb], Sb[kb], a);
        vn[mt][0] = bflo(uw[2 * mt]) - a[0]; vn[mt][1] = bfhi(uw[2 * mt]) - a[1]; vn[mt][2] = bflo(uw[2 * mt + 1]) - a[2]; vn[mt][3] = bfhi(uw[2 * mt + 1]) - a[3]; }
    SC_SB();
#pragma unroll
    for (int f = 0; f < 8; ++f) if (f != 1 && f != 3) fa[f] = Pf[f * 64];
#pragma unroll
    for (int f = 0; f < 8; ++f) fa[8 + f] = Kf[f * 64];
    Vb[0] = pack8(vn[0], vn[1]); Vb[1] = pack8(vn[2], vn[3]);
    SC_SB();
#pragma unroll
    for (int mt = 0; mt < 4; ++mt) { f32x4 a = {0.f, 0.f, 0.f, 0.f};
#pragma unroll
        for (int kb = 0; kb < 4; ++kb) a = mfma16(fb[mt * 4 + kb], Sb[kb], a);
        o[mt] = a; }
    SC_SB();
#pragma unroll
    for (int f = 0; f < 8; ++f) fb[f] = Kf[(8 + f) * 64];
    SC_SB();
#pragma unroll
    for (int mt = 0; mt < 4; ++mt) { f32x4 a = o[mt];
#pragma unroll
        for (int kb2 = 0; kb2 < 2; ++kb2) if (mt >= 2 || kb2 == 0) a = mfma16(fa[mt * 2 + kb2], Vb[kb2], a);
        o[mt] = a; }
#pragma unroll
    for (int mtd = 0; mtd < 4; ++mtd) { f32x4 a = S[mtd] * gt;
#pragma unroll
        for (int kb2 = 0; kb2 < 2; ++kb2) a = mfma16(fa[8 + mtd * 2 + kb2], Vb[kb2], a);
        S[mtd] = a; }
    SC_SB();
#pragma unroll
    for (int mtd = 4; mtd < 8; ++mtd) { f32x4 a = S[mtd] * gt;
#pragma unroll
        for (int kb2 = 0; kb2 < 2; ++kb2) a = mfma16(fb[(mtd - 4) * 2 + kb2], Vb[kb2], a);
        S[mtd] = a; }
    { const bool odd = lane & 1; bf16_t* ob = op - (odd ? 1 : 0) + (size_t)(odd ? 2 : 0) * ostride;
#pragma unroll
      for (int mt = 0; mt < 4; ++mt) {
          const float s0 = odd ? o[mt][0] : o[mt][2], s1 = odd ? o[mt][1] : o[mt][3], m0 = odd ? o[mt][2] : o[mt][0], m1 = odd ? o[mt][3] : o[mt][1];
          const float r0 = __builtin_bit_cast(float, __builtin_amdgcn_update_dpp(0, __builtin_bit_cast(int, s0), 0xB1, 0xf, 0xf, true));
          const float r1 = __builtin_bit_cast(float, __builtin_amdgcn_update_dpp(0, __builtin_bit_cast(int, s1), 0xB1, 0xf, 0xf, true));
          *(unsigned*)(ob + (size_t)(16 * mt) * ostride) = odd ? pk2(r0, m0) : pk2(m0, r0);
          *(unsigned*)(ob + (size_t)(16 * mt + 1) * ostride) = odd ? pk2(r1, m1) : pk2(m1, r1); } }
#undef SC_SB
}
#define SC_BAR() do { asm volatile("s_waitcnt lgkmcnt(0)" ::: "memory"); __builtin_amdgcn_s_barrier(); asm volatile("" ::: "memory"); } while (0)
DI void phase_scan(const Params& p, int layer, unsigned char* smem) {
    if (blockIdx.x >= 128) return;
    const int tid = opaque_tid(p), lane = tid & 63, wid = __builtin_amdgcn_readfirstlane(tid >> 6), q4 = lane >> 4, l16 = lane & 15;
    const int bx = blockIdx.x & 7, by = blockIdx.x >> 3, nt = by & 7, g = bx + 8 * (by >> 3), b = g >> 3, h = g & 7;
    constexpr int BUFB = 59904;
#define SC_CB(c) (((c) == 0) ? 256 + b : 128 * b + (c) - 1)
    if (wid != 0) {
        const int r = wid - 1, rr = r >> 1, slot = 3 * (rr == 0) + 4 * (rr == 2) + 5 * (rr == 3), isq = (rr == 3);
        const unsigned char* sb = p.ws + WS_QB + (size_t)slot * SZ_ACT + (size_t)(r & 1) * 8192 + lane * 16;
        const unsigned char* ub = p.ws + WS_VB + nt * 2048 + lane * 32; const float* GT = (const float*)(p.ws + WS_GT);
        const size_t istride = (size_t)16384 >> isq;
        unsigned char* d0 = smem + r * 8192 + lane * 16; unsigned char* d1 = d0 + BUFB;
        unsigned char* e0 = smem + 57344 + lane * 32; unsigned char* e1 = e0 + BUFB;
        u32x4 ra[8], rb[8], rc[8], rd[8]; u32x4 xa[2], xb[2], xc[2], xd[2]; float ga = 0.f, gb = 0.f, gc = 0.f, gd = 0.f;
#define SC_LOAD(dst, xd_, gd_, c) do { const int cc_ = (c) < 129 ? (c) : 128; const int it_ = SC_CB(cc_) * 8 + h; const unsigned char* s_ = sb + (size_t)it_ * istride; \
        _Pragma("unroll") for (int i_ = 0; i_ < 8; ++i_) dst[i_] = *(const u32x4*)(s_ + i_ * 1024); \
        if (r == 6) { const unsigned char* us_ = ub + (size_t)it_ * 16384; xd_[0] = *(const u32x4*)us_; xd_[1] = *(const u32x4*)(us_ + 16); gd_ = GT[(size_t)it_ * 32]; } } while (0)
#define SC_WRITE(dptr, eptr, src, xs_, gs_) do { _Pragma("unroll") for (int i_ = 0; i_ < 8; ++i_) *(u32x4*)((dptr) + i_ * 1024) = src[i_]; \
        if (r == 6) { *(u32x4*)(eptr) = xs_[0]; *(u32x4*)((eptr) + 16) = xs_[1]; if (lane == 0) *(float*)((eptr) + 2048) = gs_; } } while (0)
        SC_LOAD(ra, xa, ga, 0); SC_WRITE(d0, e0, ra, xa, ga); SC_LOAD(ra, xa, ga, 1); SC_LOAD(rb, xb, gb, 2); SC_LOAD(rc, xc, gc, 3); SC_LOAD(rd, xd, gd, 4);
        SC_BAR();
        for (int c = 0; c < 128; c += 4) {
            SC_WRITE(d1, e1, ra, xa, ga); SC_LOAD(ra, xa, ga, c + 5); SC_BAR();
            SC_WRITE(d0, e0, rb, xb, gb); SC_LOAD(rb, xb, gb, c + 6); SC_BAR();
            SC_WRITE(d1, e1, rc, xc, gc); SC_LOAD(rc, xc, gc, c + 7); SC_BAR();
            SC_WRITE(d0, e0, rd, xd, gd); SC_LOAD(rd, xd, gd, c + 8); SC_BAR();
        }
        SC_BAR();
    } else {
        __builtin_amdgcn_s_setprio(3);
        bf16_t* OB = (bf16_t*)(p.ws + WS_KTB) + (size_t)(4 * q4) * 128 + 16 * nt + l16;
        f32x4 S[8];
#pragma unroll
        for (int i = 0; i < 8; ++i) S[i] = (f32x4){0.f, 0.f, 0.f, 0.f};
        SC_BAR();
        for (int c = 0; c < 128; c += 2) {
            scan_step<false>(smem, smem + 57344, *(const float*)(smem + 57344 + 2048), S, OB + (size_t)(SC_CB(c) * 8 + h) * 8192, 128, lane); SC_BAR();
            scan_step<false>(smem + BUFB, smem + BUFB + 57344, *(const float*)(smem + BUFB + 57344 + 2048), S, OB + (size_t)(SC_CB(c + 1) * 8 + h) * 8192, 128, lane); SC_BAR();
        }
        scan_step<false>(smem, smem + 57344, *(const float*)(smem + 57344 + 2048), S, OB + (size_t)(SC_CB(128) * 8 + h) * 8192, 128, lane);
        SC_BAR();
        __builtin_amdgcn_s_setprio(0);
    }
#undef SC_LOAD
#undef SC_WRITE
#undef SC_CB
}

DI void phase_scan2(const Params& p, int layer, unsigned char* smem) {
    const int tid = opaque_tid(p), lane = tid & 63, wid = __builtin_amdgcn_readfirstlane(tid >> 6), q4 = lane >> 4, l16 = lane & 15;
    const int sb = blockIdx.x, g = (sb & 7) + 8 * (sb >> 4), half = (sb >> 3) & 1, b = g >> 3, h = g & 7, nt = 4 * half + (wid & 3);
    PG8_LAS unsigned char* lds = (PG8_LAS unsigned char*)smem;
    unsigned* flags = (unsigned*)(p.ws + WS_FLAG) + layer * 2080; const float* GT = (const float*)(p.ws + WS_GT);
    float* gtl = (float*)(smem + 131072 + 16);
#define S2_ITEM(c) ((((c) == 0) ? 256 + b : 128 * b + (c) - 1) * 8 + h)
#define S2_POLL(c) do { const unsigned* f_ = flags + S2_ITEM(c); while (__builtin_amdgcn_readfirstlane(__hip_atomic_load(f_, __ATOMIC_RELAXED, __HIP_MEMORY_SCOPE_AGENT)) == 0u) __builtin_amdgcn_s_sleep(2); } while (0)
#define S2_ISSUE(c, bi) do { const int it_ = S2_ITEM(c), k_ = wid - 4; \
        _Pragma("unroll") for (int i_ = 0; i_ < 14; ++i_) { const int pc_ = k_ * 14 + i_, r_ = pc_ >> 4, slot_ = 3 * (r_ == 0) + 4 * (r_ == 2) + 5 * (r_ == 3); \
            const unsigned char* s_ = p.ws + WS_QB + (size_t)slot_ * SZ_ACT + (size_t)it_ * ((size_t)16384 >> (r_ == 3)) + (size_t)(pc_ & 15) * 1024 + lane * 16; \
            __builtin_amdgcn_global_load_lds((const unsigned*)s_, (PG8_LAS unsigned*)(lds + (bi) * 65536 + pc_ * 1024), 16, 0, 0); } \
        _Pragma("unroll") for (int i_ = 0; i_ < 2; ++i_) { const unsigned char* s_ = p.ws + WS_VB + (size_t)it_ * 16384 + (size_t)(4 * half + k_) * 2048 + i_ * 1024 + lane * 16; \
            __builtin_amdgcn_global_load_lds((const unsigned*)s_, (PG8_LAS unsigned*)(lds + (bi) * 65536 + 57344 + k_ * 2048 + i_ * 1024), 16, 0, 0); } } while (0)
    if (wid >= 4) {
        const int k = wid - 4;
#define S2_POLL8(base) do { if (k == 0) { const int ch_ = (base) + (lane & 7), chc_ = ch_ < 129 ? ch_ : 128; const unsigned* f_ = flags + S2_ITEM(chc_); \
        for (unsigned sp_ = 0; sp_ < (1u << 22); ++sp_) { const unsigned v_ = __hip_atomic_load(f_, __ATOMIC_RELAXED, __HIP_MEMORY_SCOPE_AGENT); if (__builtin_amdgcn_ballot_w64(v_ == 0u) == 0ull) break; __builtin_amdgcn_s_sleep(2); } \
        __builtin_amdgcn_fence(__ATOMIC_ACQUIRE, "agent"); } } while (0)
#define S2_PIECE(it_, pc_, bi) do { const int r_ = (pc_) >> 4, slot_ = 3 * (r_ == 0) + 4 * (r_ == 2) + 5 * (r_ == 3); \
        const unsigned char* s_ = p.ws + WS_QB + (size_t)slot_ * SZ_ACT + (size_t)(it_) * ((size_t)16384 >> (r_ == 3)) + (size_t)((pc_) & 15) * 1024 + lane * 16; \
        __builtin_amdgcn_global_load_lds((const unsigned*)s_, (PG8_LAS unsigned*)(lds + (bi) * 65536 + (pc_) * 1024), 16, 0, 0); } while (0)
#define S2_ISSUE_A(c, bi) do { const int it_ = S2_ITEM(c); _Pragma("unroll") for (int i_ = 0; i_ < 8; ++i_) S2_PIECE(it_, 8 * k + i_, bi); } while (0)
#define S2_ISSUE_B(c, bi) do { const int it_ = S2_ITEM(c); _Pragma("unroll") for (int i_ = 0; i_ < 6; ++i_) S2_PIECE(it_, 32 + 6 * k + i_, bi); \
        _Pragma("unroll") for (int i_ = 0; i_ < 2; ++i_) { const unsigned char* s_ = p.ws + WS_VB + (size_t)it_ * 16384 + (size_t)(4 * half + k) * 2048 + i_ * 1024 + lane * 16; \
            __builtin_amdgcn_global_load_lds((const unsigned*)s_, (PG8_LAS unsigned*)(lds + (bi) * 65536 + 57344 + k * 2048 + i_ * 1024), 16, 0, 0); } } while (0)
#define S2_RAWBAR() do { asm volatile("" ::: "memory"); __builtin_amdgcn_s_barrier(); asm volatile("" ::: "memory"); } while (0)
        S2_POLL8(0);
        asm volatile("s_waitcnt vmcnt(0)" ::: "memory");
        SC_BAR();
        S2_ISSUE_A(0, 0); S2_ISSUE_B(0, 0);
        if (k == 0) { const float g0 = GT[(size_t)S2_ITEM(0) * 32]; if (lane == 0) gtl[0] = g0; }
        asm volatile("s_waitcnt vmcnt(0)" ::: "memory");
        S2_ISSUE_A(1, 1);
        SC_BAR();
        for (int c = 0; c < 129; ++c) {
            float gn = 0.f;
            if (c + 1 < 129) { if (k == 0) gn = GT[(size_t)S2_ITEM(c + 1) * 32]; S2_ISSUE_B(c + 1, (c + 1) & 1); }
            S2_RAWBAR();
            if ((c & 7) == 0) S2_POLL8(c + 3);
            if (c + 2 < 129) { S2_ISSUE_A(c + 2, c & 1); asm volatile("s_waitcnt vmcnt(8)" ::: "memory"); }
            else asm volatile("s_waitcnt vmcnt(0)" ::: "memory");
            if (k == 0 && lane == 0 && c + 1 < 129) gtl[(c + 1) & 1] = gn;
            SC_BAR();
        }
#undef S2_PIECE
#undef S2_ISSUE_A
#undef S2_ISSUE_B
#undef S2_RAWBAR
    } else {
        __builtin_amdgcn_s_setprio(3);
        bf16_t* OB = (bf16_t*)(p.ws + WS_KTB) + (size_t)(4 * q4) * 128 + 16 * nt + l16;
        f32x4 S[8];
#pragma unroll
        for (int i = 0; i < 8; ++i) S[i] = (f32x4){0.f, 0.f, 0.f, 0.f};
        SC_BAR();
        SC_BAR();
        for (int c = 0; c < 129; ++c) {
            const unsigned char* buf = smem + (c & 1) * 65536;
            scan_step<true>(buf, buf + 57344 + (wid & 3) * 2048, gtl[c & 1], S, OB + (size_t)(((((c) == 0) ? 256 + b : 128 * b + (c) - 1) * 8 + h)) * 8192, 128, lane);
            SC_BAR();
        }
        __builtin_amdgcn_s_setprio(0);
    }
#undef S2_ITEM
#undef S2_POLL
#undef S2_ISSUE
}

DI void phase_combine(const Params& p, int layer, unsigned char* smem) {
    const int tid0 = opaque_tid(p);
    bf16_t* pl = (bf16_t*)smem;
    float* rs = (float*)(smem + 66560);
    const bf16_t* OB = (const bf16_t*)(p.ws + WS_KTB); const bf16_t* ZB = (const bf16_t*)(p.ws + WS_QB);     const bf16_t* GA = (const bf16_t*)(p.ws + WS_VB); const bf16_t* GB = (const bf16_t*)(p.ws + WS_WB);
    const bf16_t* PB = (const bf16_t*)(p.ws + WS_QKB); bf16_t* YB = (bf16_t*)(p.ws + WS_KB); const bf16_t* WPT = (const bf16_t*)(p.ws + WS_WPT);
    const float* hn = p.head_norm + layer * 128; const float* psc = p.pool_scale + layer * 1024;
    for (int cb = blockIdx.x; cb < 260; cb += gridDim.x) {
        int tid = tid0; asm volatile("" : "+v"(tid));
        const int lane = tid & 63, wid = tid >> 6, q4 = lane >> 4, l16 = lane & 15;
        if (cb >= 258) { const u32x4 z = {0u, 0u, 0u, 0u};
            for (int e = tid; e < 64 * 128; e += 512) *(u32x4*)(YB + (size_t)cb * 65536 + e * 8) = z;
            continue; }
        const bool meta = cb >= 256; const int b = meta ? cb - 256 : (cb >> 7);
#pragma unroll
        for (int rr = 0; rr < 8; ++rr) { const int t = 8 * wid + rr; if (meta && t < 48) continue;     const bf16_t* op = OB + ((size_t)(cb * 8 + (lane >> 3)) * 64 + t) * 128 + (lane & 7) * 16;
            const u32x4 a = *(const u32x4*)op, c = *(const u32x4*)(op + 8);
            float ss = bflo(a.x) * bflo(a.x) + bfhi(a.x) * bfhi(a.x) + bflo(a.y) * bflo(a.y) + bfhi(a.y) * bfhi(a.y) + bflo(a.z) * bflo(a.z) + bfhi(a.z) * bfhi(a.z) + bflo(a.w) * bflo(a.w) + bfhi(a.w) * bfhi(a.w)
                     + bflo(c.x) * bflo(c.x) + bfhi(c.x) * bfhi(c.x) + bflo(c.y) * bflo(c.y) + bfhi(c.y) * bfhi(c.y) + bflo(c.z) * bflo(c.z) + bfhi(c.z) * bfhi(c.z) + bflo(c.w) * bflo(c.w) + bfhi(c.w) * bfhi(c.w);
            ss += shxl(ss, 1, lane); ss += shxl(ss, 2, lane); ss += shxl(ss, 4, lane);
            if ((lane & 7) == 0) rs[t * 8 + (lane >> 3)] = rsqrtf(ss * (1.0f / 128.0f) + 1e-6f); }
        { const int t = tid >> 3, row0 = cb * 64 + t, pt = t - 48;
#pragma unroll
          for (int it = 0; it < 8; ++it) { const int g = it & 3, c8 = (tid & 7) + 8 * (it >> 2), win = 2 << g;
            int row = row0; asm volatile("" : "+v"(row));
            const int im = row - 8192 * b;
            u32x4 v[16];
#pragma unroll
            for (int d = 0; d < 16; ++d) if (d < win) {
                const bool ok = meta ? (d <= pt) : true; int pr; if (meta || im - d >= 0) pr = row - d; else pr = MMAIN + 64 * b + 64 + (im - d);
                v[d] = ok ? *(const u32x4*)(PB + (size_t)pr * 512 + g * 128 + c8 * 8) : (u32x4){0u, 0u, 0u, 0u}; }
            float acc[8];
#pragma unroll
            for (int j = 0; j < 8; ++j) acc[j] = 0.f;
#pragma unroll
            for (int d = 0; d < 16; ++d) if (d < win) { acc[0] += bflo(v[d].x); acc[1] += bfhi(v[d].x); acc[2] += bflo(v[d].y); acc[3] += bfhi(v[d].y); acc[4] += bflo(v[d].z); acc[5] += bfhi(v[d].z); acc[6] += bflo(v[d].w); acc[7] += bfhi(v[d].w); }
            int cnt = win; if (meta) { cnt = pt + 1 < win ? pt + 1 : win; if (cnt < 1) cnt = 1; }
            const float inv = 1.0f / (float)cnt; u32x4 w;
            w.x = pk2(acc[0] * inv - bflo(v[0].x), acc[1] * inv - bfhi(v[0].x)); w.y = pk2(acc[2] * inv - bflo(v[0].y), acc[3] * inv - bfhi(v[0].y));
            w.z = pk2(acc[4] * inv - bflo(v[0].z), acc[5] * inv - bfhi(v[0].z)); w.w = pk2(acc[6] * inv - bflo(v[0].w), acc[7] * inv - bfhi(v[0].w));
            *(u32x4*)(pl + t * 520 + g * 128 + c8 * 8) = w; asm volatile("" ::: "memory"); } }
        __syncthreads();
        { const int g = wid >> 1, colbase = 128 * wid; const bf16_t* wp = WPT + (size_t)g * 256 * 128 + (size_t)(colbase & 255) * 128;
#pragma unroll 1
          for (int j = 0; j < 4; ++j) { bf16x8 a0[4], a1[4];
              const int ca = 32 * j + 8 * (l16 >> 2) + (l16 & 3);
#pragma unroll
              for (int kb = 0; kb < 4; ++kb) { a0[kb] = *(const bf16x8*)(wp + ca * 128 + 32 * kb + 8 * q4); a1[kb] = *(const bf16x8*)(wp + (ca + 4) * 128 + 32 * kb + 8 * q4); }
              const int c0 = colbase + 32 * j + 8 * q4;
              const f32x4 hn0 = *(const f32x4*)(hn + (c0 & 127)), hn1 = *(const f32x4*)(hn + (c0 & 127) + 4), ps0 = *(const f32x4*)(psc + c0), ps1 = *(const f32x4*)(psc + c0 + 4);
              u32x4 o4[4], z4[4], a4[4], b4[4];
#pragma unroll
              for (int ntt = 0; ntt < 4; ++ntt) { if (meta && ntt < 3) continue; const int t = 16 * ntt + l16; const size_t off = (size_t)(cb * 64 + t) * 1024 + c0;
                  if (!(meta && t < 48)) { o4[ntt] = *(const u32x4*)(OB + ((size_t)(cb * 8 + wid) * 64 + t) * 128 + (c0 & 127)); z4[ntt] = *(const u32x4*)(ZB + off); a4[ntt] = *(const u32x4*)(GA + off); b4[ntt] = *(const u32x4*)(GB + off); }
                  else { o4[ntt] = (u32x4){0u, 0u, 0u, 0u}; z4[ntt] = o4[ntt]; a4[ntt] = o4[ntt]; b4[ntt] = o4[ntt]; } }
#pragma unroll
              for (int ntt = 0; ntt < 4; ++ntt) { if (meta && ntt < 3) continue;     f32x4 d0 = {0.f, 0.f, 0.f, 0.f}, d1 = {0.f, 0.f, 0.f, 0.f};
#pragma unroll
                  for (int kb = 0; kb < 4; ++kb) { const bf16x8 bb = *(const bf16x8*)(pl + (16 * ntt + l16) * 520 + g * 128 + 32 * kb + 8 * q4); d0 = mfma16(a0[kb], bb, d0); d1 = mfma16(a1[kb], bb, d1); }
                  const int t = 16 * ntt + l16; const size_t off = (size_t)(cb * 64 + t) * 1024 + c0; u32x4 yo = {0u, 0u, 0u, 0u};
                  if (!(meta && t < 48)) {
                      const float rq = rs[t * 8 + wid];
                      const unsigned ow[4] = {o4[ntt].x, o4[ntt].y, o4[ntt].z, o4[ntt].w}, zw[4] = {z4[ntt].x, z4[ntt].y, z4[ntt].z, z4[ntt].w};
                      const unsigned aw[4] = {a4[ntt].x, a4[ntt].y, a4[ntt].z, a4[ntt].w}, bw[4] = {b4[ntt].x, b4[ntt].y, b4[ntt].z, b4[ntt].w};
                      float y[8];
#pragma unroll
                      for (int e = 0; e < 8; ++e) { const float ov = (e & 1) ? bfhi(ow[e >> 1]) : bflo(ow[e >> 1]), zv = (e & 1) ? bfhi(zw[e >> 1]) : bflo(zw[e >> 1]);
                          const float av = (e & 1) ? bfhi(aw[e >> 1]) : bflo(aw[e >> 1]), bv = (e & 1) ? bfhi(bw[e >> 1]) : bflo(bw[e >> 1]);
                          const float hv = e < 4 ? hn0[e & 3] : hn1[e & 3], pv = e < 4 ? ps0[e & 3] : ps1[e & 3], dv = e < 4 ? d0[e & 3] : d1[e & 3];
                          y[e] = sigm(av) * (ov * rq * hv * silu(zv)) + sigm(bv) * (dv * pv); }
                      yo.x = pk2(y[0], y[1]); yo.y = pk2(y[2], y[3]); yo.z = pk2(y[4], y[5]); yo.w = pk2(y[6], y[7]); }
                  *(u32x4*)(YB + off) = yo; } } }
        __syncthreads();
    }
}

DI void phase_convact(const Params& p, int layer) {
    const int tid = opaque_tid(p);
    bf16_t* HID = (bf16_t*)(p.ws + WS_QB); const bf16_t* HALO = (const bf16_t*)(p.ws + WS_HALO);
    const float* cw = p.conv_ffn + (size_t)layer * 3 * FF2;
    if (tid >= 352) return;
    const int j0 = tid * 8;
    float wg[3][8], wv[3][8];
#pragma unroll
    for (int j = 0; j < 3; ++j)
#pragma unroll
        for (int e = 0; e < 8; ++e) { wg[j][e] = cw[j * FF2 + j0 + e]; wv[j][e] = cw[j * FF2 + DFF + j0 + e]; }
    for (int cb = blockIdx.x; cb < 258; cb += gridDim.x) {
        const bool meta = cb >= 256; const int prev = meta ? -1 : ((cb & 127) == 0 ? 256 + (cb >> 7) : cb - 1);
        float g1[8], g2[8], v1[8], v2[8];
        if (prev >= 0) { const bf16_t* hp = HALO + (size_t)prev * 2 * FF2;
            const u32x4 a = *(const u32x4*)(hp + j0), c = *(const u32x4*)(hp + DFF + j0), a1 = *(const u32x4*)(hp + FF2 + j0), c1 = *(const u32x4*)(hp + FF2 + DFF + j0);
            g2[0] = bflo(a.x); g2[1] = bfhi(a.x); g2[2] = bflo(a.y); g2[3] = bfhi(a.y); g2[4] = bflo(a.z); g2[5] = bfhi(a.z); g2[6] = bflo(a.w); g2[7] = bfhi(a.w);
            v2[0] = bflo(c.x); v2[1] = bfhi(c.x); v2[2] = bflo(c.y); v2[3] = bfhi(c.y); v2[4] = bflo(c.z); v2[5] = bfhi(c.z); v2[6] = bflo(c.w); v2[7] = bfhi(c.w);
            g1[0] = bflo(a1.x); g1[1] = bfhi(a1.x); g1[2] = bflo(a1.y); g1[3] = bfhi(a1.y); g1[4] = bflo(a1.z); g1[5] = bfhi(a1.z); g1[6] = bflo(a1.w); g1[7] = bfhi(a1.w);
            v1[0] = bflo(c1.x); v1[1] = bfhi(c1.x); v1[2] = bflo(c1.y); v1[3] = bfhi(c1.y); v1[4] = bflo(c1.z); v1[5] = bfhi(c1.z); v1[6] = bflo(c1.w); v1[7] = bfhi(c1.w);
        } else {
#pragma unroll
            for (int e = 0; e < 8; ++e) { g1[e] = 0.f; g2[e] = 0.f; v1[e] = 0.f; v2[e] = 0.f; } }
        for (int tb = meta ? 48 : 0; tb < 64; tb += 8) {
            u32x4 rg[8], rv[8];
#pragma unroll
            for (int i = 0; i < 8; ++i) { const bf16_t* hp = HID + (size_t)(cb * 64 + tb + i) * FF2 + j0; rg[i] = *(const u32x4*)hp; rv[i] = *(const u32x4*)(hp + DFF); }
#pragma unroll
            for (int i = 0; i < 8; ++i) {
                const float g0[8] = {bflo(rg[i].x), bfhi(rg[i].x), bflo(rg[i].y), bfhi(rg[i].y), bflo(rg[i].z), bfhi(rg[i].z), bflo(rg[i].w), bfhi(rg[i].w)};
                const float v0[8] = {bflo(rv[i].x), bfhi(rv[i].x), bflo(rv[i].y), bfhi(rv[i].y), bflo(rv[i].z), bfhi(rv[i].z), bflo(rv[i].w), bfhi(rv[i].w)};
                float a[8];
#pragma unroll
                for (int e = 0; e < 8; ++e) { const float cg = wg[0][e] * g2[e] + wg[1][e] * g1[e] + wg[2][e] * g0[e], cv = wv[0][e] * v2[e] + wv[1][e] * v1[e] + wv[2][e] * v0[e];
                    a[e] = silu(cg) * cv; g2[e] = g1[e]; g1[e] = g0[e]; v2[e] = v1[e]; v1[e] = v0[e]; }
                u32x4 w; w.x = pk2(a[0], a[1]); w.y = pk2(a[2], a[3]); w.z = pk2(a[4], a[5]); w.w = pk2(a[6], a[7]);
                *(u32x4*)(HID + (size_t)(cb * 64 + tb + i) * FF2 + j0) = w;
            }
        }
    }
}

__global__ void __launch_bounds__(512, 2) mega_fwd(Params p0) {
    extern __shared__ __attribute__((aligned(16))) unsigned char smem[];
    cg::grid_group grid = cg::this_grid();
    PG8_LAS unsigned char* lds = (PG8_LAS unsigned char*)smem;
    const int G = (int)gridDim.x, c = (int)blockIdx.x;
    Params p = p0; p.wid0 = __builtin_amdgcn_readfirstlane((int)threadIdx.x >> 6);
    const bool t0 = (threadIdx.x == 0);
    volatile LAS unsigned* xst = (volatile LAS unsigned*)(lds + 131072);
    if (threadIdx.x < 4) xst[threadIdx.x] = 0u;
    __syncthreads();
    const XcdBarrier xbar = xcd_barrier_post((unsigned*)(p0.ws + WS_BAR), xst, t0);
    if (blockIdx.x < 32 && threadIdx.x == 0) ((unsigned*)(p0.ws + WS_XT))[blockIdx.x] = xb_xcc_id();
    grid.sync();
#if TSA || TSB
    int tsk = 0;
#define TSTAMP() do { if (blockIdx.x == 0 && p.wid0 == 0 && lane_id_fresh() == 0) ((unsigned long long*)(p0.ws + WS_TS))[tsk] = __builtin_amdgcn_s_memrealtime(); ++tsk; } while (0)
#else
#define TSTAMP() do { } while (0)
#endif
    TSTAMP();
#define GSYNC() do { xcd_barrier(xbar, (p.wid0 == 0) && (lane_id_fresh() == 0)); TSTAMP(); } while (0)
#define FRESH() do { size_t z_ = 0; asm volatile("" : "+s"(z_)); p.ws = p0.ws + z_; p.out = p0.out + z_; } while (0)
#define WSP(off) ((bf16_t*)(p.ws + (off)))
#define GEMM_PLAIN 1 << 20, 256, 0
#pragma unroll 1
    for (int layer = 0; layer < 2; ++layer) {
        FRESH(); phase_norm(p, layer, 0, smem); GSYNC();
        FRESH();
        { pg8::Gemm g{WSP(WS_U), WSP(WS_WIN), MMAIN, 3072, 1024, 1024, 1024, GEMM_PLAIN}; pg8::StaticOrder S; S.init(MMAIN, 3072, G, c); EpiQKV E{WSP(WS_QB), WSP(WS_HALO)}; pg8::gemm_phase<EpiQKV, pg8::StaticOrder, true>(lds, g, S, E, opaque_tid(p));
          meta_gemm(smem, WSP(WS_U), 1024, WSP(WS_WIN), 1024, 1024, 192, MstQKV{WSP(WS_QB), WSP(WS_HALO)}, opaque_tid(p)); }
        GSYNC();
        FRESH();
#if DIAG_SPLIT
        if (blockIdx.x >= 32) { phase_p3(p, layer, smem, (int)blockIdx.x - 32, G - 32); convert_weights(p, layer, smem, opaque_tid(p), 1664, 4064, (int)blockIdx.x - 32, G - 32); }
        GSYNC();
        FRESH();
#if DIAG_SPLIT == 2
        phase_scan(p, layer, smem);
#else
        if (blockIdx.x < 32) phase_scan2(p, layer, smem);
#endif
        GSYNC();
#else
        if (blockIdx.x < 32) phase_scan2(p, layer, smem);
        else { const int pblk = (int)blockIdx.x - 32, npb = G - 32, nheavy = 129 * 16 - (129 * 16 / npb) * npb;
            phase_p3(p, layer, smem, pblk, npb);
            if (npb == 224) { if (pblk >= nheavy) convert_weights(p, layer, smem, opaque_tid(p), 1664, 1664 + 2112, pblk - nheavy, npb - nheavy);
                              else convert_weights(p, layer, smem, opaque_tid(p), 1664 + 2112, 4064, pblk, nheavy); }
            else convert_weights(p, layer, smem, opaque_tid(p), 1664, 4064, pblk, npb); }
        GSYNC();
#endif
        FRESH();
        { pg8::Gemm g{WSP(WS_U), WSP(WS_WIN) + (size_t)3072 * 1024, MMAIN, 3584, 1024, 1024, 1024, GEMM_PLAIN}; pg8::StaticOrder S; S.init(MMAIN, 3584, G, c); EpiZPG E{WSP(WS_QB)}; pg8::gemm_phase<EpiZPG, pg8::StaticOrder, true>(lds, g, S, E, opaque_tid(p));
          meta_gemm(smem, WSP(WS_U), 1024, WSP(WS_WIN) + (size_t)3072 * 1024, 1024, 1024, 224, MstZPG{WSP(WS_QB)}, opaque_tid(p)); }
        GSYNC();
        FRESH(); phase_combine(p, layer, smem); GSYNC();
        FRESH();
        { pg8::Gemm g{WSP(WS_KB), WSP(WS_WOUT), MMAIN, 1024, 1024, 1024, 1024, GEMM_PLAIN}; pg8::StaticOrder S; S.init(MMAIN, 1024, G, c); EpiRes E{p.out, (float*)(p.ws + WS_HM), 1.0f}; pg8::gemm_phase<EpiRes, pg8::StaticOrder>(lds, g, S, E, opaque_tid(p));
          meta_gemm(smem, WSP(WS_KB), 1024, WSP(WS_WOUT), 1024, 1024, 64, MstRes{(float*)(p.ws + WS_HM)}, opaque_tid(p)); }
        GSYNC();
        FRESH(); phase_norm(p, layer, 1, smem); GSYNC();
        FRESH();
        { pg8::Gemm g{WSP(WS_U), WSP(WS_WUP), 66 * 256, FF2, 1024, 1024, 1024, 33, 254, USEQ}; pg8::StaticOrder S; S.init(66 * 256, FF2, G, c);
          EpiAct E{WSP(WS_QB), p.conv_ffn + (size_t)layer * 3 * FF2, (PG8_LAS float*)(lds + 131072 + 16)}; pg8::gemm_phase<EpiAct, pg8::StaticOrder, true>(lds, g, S, E, opaque_tid(p)); }
        GSYNC();
        FRESH();
        { pg8::Gemm g{WSP(WS_QB), WSP(WS_WDN), MMAIN, 1024, DFF, DFF, DFF, GEMM_PLAIN}; pg8::StaticOrder S; S.init(MMAIN, 1024, G, c); EpiRes E{p.out, (float*)(p.ws + WS_HM), 1.0f}; pg8::gemm_phase<EpiRes, pg8::StaticOrder>(lds, g, S, E, opaque_tid(p));
          meta_gemm(smem, WSP(WS_QB), DFF, WSP(WS_WDN), DFF, DFF, 64, MstRes{(float*)(p.ws + WS_HM)}, opaque_tid(p)); }
        GSYNC();
    }
    FRESH(); phase_final(p);
#undef GEMM_PLAIN
#undef FRESH
#undef WSP
#undef GSYNC
}

extern "C" void kernel_launch(void* const* d_in, const int* in_sizes, int n_in, void* d_out, int out_size, void* d_ws, size_t ws_size, hipStream_t stream) {
    static int grid_blocks = 0;
    if (!grid_blocks) {
        int dev = 0, cus = 0, per_cu = 0;
        hipGetDevice(&dev);
        hipDeviceGetAttribute(&cus, hipDeviceAttributeMultiprocessorCount, dev);
        if (hipFuncSetAttribute((const void*)mega_fwd, hipFuncAttributeMaxDynamicSharedMemorySize, LDS_BYTES) != hipSuccess) fprintf(stderr, "hipFuncSetAttribute failed\n");
        hipOccupancyMaxActiveBlocksPerMultiprocessor(&per_cu, (const void*)mega_fwd, 512, LDS_BYTES);
        if (per_cu < 1) { fprintf(stderr, "occupancy query reports %d blocks/CU\n", per_cu); per_cu = 1; }
        if (per_cu > 1) per_cu = 1;
        grid_blocks = cus * per_cu;
        if (ws_size < WS_END) fprintf(stderr, "workspace too small: %zu < %zu\n", ws_size, (size_t)WS_END);
    }
    Params p{};
    p.x = (const float*)d_in[0]; p.meta = (const float*)d_in[1]; p.norm_mix = (const float*)d_in[2]; p.w_in = (const float*)d_in[3]; p.conv_qkv = (const float*)d_in[4];
    p.a_log = (const float*)d_in[5]; p.dt_bias = (const float*)d_in[6]; p.head_norm = (const float*)d_in[7]; p.w_pool = (const float*)d_in[8]; p.pool_scale = (const float*)d_in[9];
    p.w_out = (const float*)d_in[10]; p.norm_ffn = (const float*)d_in[11]; p.w_up = (const float*)d_in[12]; p.conv_ffn = (const float*)d_in[13]; p.w_down = (const float*)d_in[14]; p.norm_final = (const float*)d_in[15];
    p.out = (float*)d_out; p.ws = (unsigned char*)d_ws;
    (void)hipMemsetAsync((unsigned char*)d_ws + WS_BAR, 0, (size_t)(WS_END - WS_BAR), stream);
    void* args[] = {&p};
    hipError_t e = hipLaunchCooperativeKernel((const void*)mega_fwd, dim3(grid_blocks), dim3(512), args, LDS_BYTES, stream);
    if (e != hipSuccess) fprintf(stderr, "cooperative launch failed: %s (grid %d)\n", hipGetErrorString(e), grid_blocks);
}
```

```cpp
#include <hip/hip_runtime.h>
#include <hip/hip_cooperative_groups.h>
#include <cstdio>
namespace cg = cooperative_groups;
#ifndef PROBE
#define PROBE 0
#endif
#ifndef TSA
#define TSA 0
#define TSB 0
#endif
#ifndef DIAG_SPLIT
#define DIAG_SPLIT 0
#endif
#include <hip/hip_runtime.h>
namespace pg8 {
#define PG8_LAS __attribute__((address_space(3)))
typedef unsigned short bf16_t;
typedef short bf16x8 __attribute__((ext_vector_type(8)));
typedef float f32x4 __attribute__((ext_vector_type(4)));
typedef unsigned u32x4 __attribute__((ext_vector_type(4)));
constexpr int BM = 256, BK = 64, HALF = 128, HTB = HALF * BK * 2  , STAGE_BYTES = 8 * HTB, NXCD = 8, WGM = 8;

__host__ __device__ __forceinline__ int lds_byte(int r, int c) { const int st = (r >> 4) * 2 + (c >> 5), rr = r & 15, cc = c & 31, ob = rr * 64 + cc * 2; return st * 1024 + (ob ^ (((ob >> 9) & 1) << 5)); }
__host__ __device__ __forceinline__ void stage_rc(int b, int& R, int& C) { const int st = b / 1024, sb = b % 1024, swz = sb ^ (((sb >> 9) & 1) << 5); R = (st >> 1) * 16 + swz / 64; C = (st & 1) * 32 + (swz % 64) / 2; }
__host__ __device__ __forceinline__ int perm32(int rho) { const int n = rho >> 4, i = rho & 15; return 8 * (i >> 2) + 4 * n + (i & 3); }

struct Unit { int pm, pn; };
struct Gemm { const bf16_t* A; const bf16_t* Bt; int M, N, K, lda, ldb, mdiv, mlo, mhi; };

struct StaticOrder {
    int nM, nN, nwg, G, c;
    __host__ __device__ void init(int M, int N, int G_, int c_) { nM = M / BM; nN = N / BM; nwg = nM * nN; G = G_; c = c_; }
    __host__ __device__ bool next(int i, Unit& u) const {
        const long L = (long)i * G + c; if (L >= nwg) return false;
        int wgid = (int)L; { const int q = nwg / NXCD, r = nwg % NXCD, xcd = wgid % NXCD, off = wgid / NXCD; wgid = (xcd < r ? xcd * (q + 1) : r * (q + 1) + (xcd - r) * q) + off; }
        const int nig = WGM * nN, gid = wgid / nig, fm = gid * WGM, gsz = (nM - fm) < WGM ? (nM - fm) : WGM;
        u.pm = fm + ((wgid % nig) % gsz); u.pn = (wgid % nig) / gsz; return true;
    }
    __device__ __forceinline__ void a_ready(const Unit&) const {}
    __device__ __forceinline__ void done(const Unit&) const {}
};

template <class Epi, class Sched, bool ALIGN_EPI = false, bool SP2 = true>
__device__ __forceinline__ void gemm_phase(PG8_LAS unsigned char* lds, const Gemm g, const Sched& S, const Epi& E, int tid_in) {
    int tid = tid_in; asm volatile("" : "+v"(tid)); const int wid = __builtin_amdgcn_readfirstlane(tid >> 6), lane = tid & 63, wr = wid >> 2, wc = wid & 3, fr = lane & 15, fq = lane >> 4;
    const int K = g.K, nt = K / BK;
    unsigned voffA[2], voffB[2];
#pragma unroll
    for (int i = 0; i < 2; ++i) { int R, C; stage_rc(tid * 16 + i * 8192, R, C); const int Rb = Epi::PERM ? ((R & ~31) + perm32(R & 31)) : R;
        voffA[i] = (unsigned)(R * g.lda + C) * 2u; voffB[i] = (unsigned)(Rb * g.ldb + C) * 2u; }
    const size_t kstep = (size_t)(BK * 2);
    const size_t hstepA = (size_t)HALF * g.lda * 2, hstepB = (size_t)HALF * g.ldb * 2;
    const size_t tstepB = 2 * hstepB;
    const unsigned ldsw = (unsigned)wid * 1024u;
    const int aoff = lds_byte(wr * 64 + fr, fq * 8), boff = lds_byte(wc * 32 + fr, fq * 8);
#define PG8_SA(b, h) (((b) * 2 + (h)) * HTB)
#define PG8_SB(b, h) ((4 + (b) * 2 + (h)) * HTB)
#define PG8_STAGE(bufoff, gbase, voff) do { _Pragma("unroll") for (int _i = 0; _i < 2; ++_i) \
        __builtin_amdgcn_global_load_lds((const unsigned*)((const char*)(gbase) + (voff)[_i]), (PG8_LAS unsigned*)(lds + (bufoff) + ldsw + _i * 8192), 16, 0, 0); } while (0)
#define PG8_LDA(dst, b, h) do { _Pragma("unroll") for (int m = 0; m < 4; ++m) _Pragma("unroll") for (int k = 0; k < 2; ++k) dst[m][k] = *(const PG8_LAS bf16x8*)(lds + PG8_SA(b, h) + aoff + m * 2048 + k * 1024); } while (0)
#define PG8_LDB(dst, b, h) do { _Pragma("unroll") for (int n = 0; n < 2; ++n) _Pragma("unroll") for (int k = 0; k < 2; ++k) dst[n][k] = *(const PG8_LAS bf16x8*)(lds + PG8_SB(b, h) + boff + n * 2048 + k * 1024); } while (0)
#define PG8_MMA(ai, bj, At, Bt) do { __builtin_amdgcn_s_setprio(1); _Pragma("unroll") for (int m = 0; m < 4; ++m) _Pragma("unroll") for (int n = 0; n < 2; ++n) _Pragma("unroll") for (int k = 0; k < 2; ++k) \
        acc[ai][bj][m][n] = __builtin_amdgcn_mfma_f32_16x16x32_bf16(Bt[n][k], At[m][k], acc[ai][bj][m][n], 0, 0, 0); __builtin_amdgcn_s_setprio(0); } while (0)
#define PG8_WAIT_V(n) asm volatile("s_waitcnt vmcnt(" #n ")" ::: "memory")
#define PG8_WAIT_L(n) asm volatile("s_waitcnt lgkmcnt(" #n ")" ::: "memory")
#define PG8_BAR __builtin_amdgcn_s_barrier()
#define PG8_SCHED __builtin_amdgcn_sched_barrier(0)
    Unit cur, nxt; int ui = 0;
    if (!S.next(0, cur)) return;
    f32x4 acc[2][2][4][2];
#pragma unroll
    for (int a = 0; a < 2; ++a)
#pragma unroll
        for (int b = 0; b < 2; ++b)
#pragma unroll
            for (int m = 0; m < 4; ++m)
#pragma unroll
                for (int n = 0; n < 2; ++n) acc[a][b][m][n] = (f32x4){0.f, 0.f, 0.f, 0.f};
    bf16x8 At[4][2], B0[2][2], B1[2][2];
    const char* cA = (const char*)g.A + (size_t)((cur.pm / g.mdiv) * g.mhi + (cur.pm % g.mdiv) * g.mlo) * (size_t)g.lda * 2; const char* cB = (const char*)g.Bt + (size_t)cur.pn * tstepB;
    S.a_ready(cur);
    if constexpr (SP2) {
        PG8_STAGE(PG8_SB(0, 0), cB, voffB); PG8_STAGE(PG8_SB(0, 1), cB + hstepB, voffB); PG8_STAGE(PG8_SA(0, 0), cA, voffA); PG8_STAGE(PG8_SA(0, 1), cA + hstepA, voffA);
        if (wr == 1) PG8_BAR;
        PG8_WAIT_V(2); PG8_BAR;
        PG8_STAGE(PG8_SB(1, 0), cB + kstep, voffB); PG8_STAGE(PG8_SA(1, 0), cA + kstep, voffA); PG8_STAGE(PG8_SB(1, 1), cB + hstepB + kstep, voffB);
        PG8_WAIT_V(6); PG8_BAR;
    } else {
        PG8_STAGE(PG8_SB(0, 0), cB, voffB); PG8_STAGE(PG8_SA(0, 0), cA, voffA); PG8_STAGE(PG8_SB(0, 1), cB + hstepB, voffB); PG8_STAGE(PG8_SA(0, 1), cA + hstepA, voffA);
        if (wr == 1) PG8_BAR;
        PG8_WAIT_V(4); PG8_BAR;
        PG8_STAGE(PG8_SB(1, 0), cB + kstep, voffB); PG8_STAGE(PG8_SA(1, 0), cA + kstep, voffA); PG8_STAGE(PG8_SB(1, 1), cB + hstepB + kstep, voffB);
        PG8_WAIT_V(6); PG8_BAR;
    }
    for (;;) {
        const bool has_next = S.next(ui + 1, nxt);
        const char* nA = has_next ? (const char*)g.A + (size_t)((nxt.pm / g.mdiv) * g.mhi + (nxt.pm % g.mdiv) * g.mlo) * (size_t)g.lda * 2 : cA; const char* nB = has_next ? (const char*)g.Bt + (size_t)nxt.pn * tstepB : cB;
        for (int t = 0; t < nt; t += 2) {
            const bool last = (t == nt - 2);
            const char* a1 = cA + (size_t)(t + 1) * kstep;
            const char* a2 = last ? nA : cA + (size_t)(t + 2) * kstep; const char* b2 = last ? nB : cB + (size_t)(t + 2) * kstep;
            const char* a3 = a2 + kstep; const char* b3 = b2 + kstep;
            if (last && has_next) S.a_ready(nxt);
            if constexpr (SP2) {
            PG8_LDB(B0, 0, 0); PG8_LDB(B1, 0, 1); PG8_SCHED; PG8_LDA(At, 0, 0); PG8_STAGE(PG8_SA(1, 1), a1 + hstepA, voffA);
            PG8_WAIT_V(8); PG8_WAIT_L(0); PG8_BAR; PG8_MMA(0, 0, At, B0); PG8_MMA(0, 1, At, B1); PG8_BAR; PG8_SCHED;
            PG8_LDA(At, 0, 1); PG8_STAGE(PG8_SB(0, 0), b2, voffB); PG8_STAGE(PG8_SB(0, 1), b2 + hstepB, voffB); PG8_STAGE(PG8_SA(0, 0), a2, voffA);
            PG8_WAIT_V(8); PG8_WAIT_L(0); PG8_BAR; PG8_MMA(1, 0, At, B0); PG8_MMA(1, 1, At, B1); PG8_BAR; PG8_SCHED;
            PG8_LDB(B0, 1, 0); PG8_LDB(B1, 1, 1); PG8_SCHED; PG8_LDA(At, 1, 0); PG8_STAGE(PG8_SA(0, 1), a2 + hstepA, voffA);
            PG8_WAIT_V(8); PG8_WAIT_L(0); PG8_BAR; PG8_MMA(0, 0, At, B0); PG8_MMA(0, 1, At, B1); PG8_BAR; PG8_SCHED;
            PG8_LDA(At, 1, 1); PG8_STAGE(PG8_SB(1, 0), b3, voffB); PG8_STAGE(PG8_SB(1, 1), b3 + hstepB, voffB); PG8_STAGE(PG8_SA(1, 0), a3, voffA);
            PG8_WAIT_V(8); PG8_WAIT_L(0); PG8_BAR; PG8_MMA(1, 0, At, B0); PG8_MMA(1, 1, At, B1); PG8_BAR; PG8_SCHED;
            } else {
            PG8_LDB(B0, 0, 0); PG8_SCHED; PG8_LDA(At, 0, 0); PG8_STAGE(PG8_SA(1, 1), a1 + hstepA, voffA);
            PG8_WAIT_L(8); PG8_BAR; PG8_WAIT_L(0); PG8_MMA(0, 0, At, B0); PG8_BAR; PG8_SCHED;
            PG8_LDB(B1, 0, 1); PG8_STAGE(PG8_SB(0, 0), b2, voffB);
            PG8_BAR; PG8_WAIT_L(0); PG8_MMA(0, 1, At, B1); PG8_BAR;
            PG8_LDA(At, 0, 1); PG8_STAGE(PG8_SA(0, 0), a2, voffA);
            PG8_BAR; PG8_WAIT_L(0); PG8_MMA(1, 0, At, B0); PG8_BAR; PG8_SCHED;
            PG8_STAGE(PG8_SB(0, 1), b2 + hstepB, voffB);
            PG8_WAIT_V(6); PG8_BAR; PG8_MMA(1, 1, At, B1); PG8_BAR;
            PG8_LDB(B0, 1, 0); PG8_SCHED; PG8_LDA(At, 1, 0); PG8_STAGE(PG8_SA(0, 1), a2 + hstepA, voffA);
            PG8_WAIT_L(8); PG8_BAR; PG8_WAIT_L(0); PG8_MMA(0, 0, At, B0); PG8_BAR; PG8_SCHED;
            PG8_LDB(B1, 1, 1); PG8_STAGE(PG8_SB(1, 0), b3, voffB);
            PG8_BAR; PG8_WAIT_L(0); PG8_MMA(0, 1, At, B1); PG8_BAR;
            PG8_LDA(At, 1, 1); PG8_STAGE(PG8_SA(1, 0), a3, voffA);
            PG8_BAR; PG8_WAIT_L(0); PG8_MMA(1, 0, At, B0); PG8_BAR; PG8_SCHED;
            PG8_STAGE(PG8_SB(1, 1), b3 + hstepB, voffB);
            PG8_WAIT_V(6); PG8_BAR; PG8_MMA(1, 1, At, B1); PG8_BAR;
            }
        }
        if constexpr (ALIGN_EPI) { if (wr == 0) PG8_BAR; }
        if constexpr (!Epi::AFTER_DRAIN) { E(acc, cur, wr, wc, fr, fq); S.done(cur); }
        if (!has_next) break;
#pragma unroll
        for (int a = 0; a < 2; ++a)
#pragma unroll
            for (int b = 0; b < 2; ++b)
#pragma unroll
                for (int m = 0; m < 4; ++m)
#pragma unroll
                    for (int n = 0; n < 2; ++n) acc[a][b][m][n] = (f32x4){0.f, 0.f, 0.f, 0.f};
        cur = nxt; cA = nA; cB = nB; ++ui;
        if constexpr (ALIGN_EPI) { if (wr == 1) PG8_BAR; }
    }
    PG8_WAIT_V(0);
    if constexpr (!ALIGN_EPI) { if (wr == 0) PG8_BAR; }
    PG8_BAR;
    if constexpr (Epi::AFTER_DRAIN) { E.fused(acc, cur, wr, wc, fr, fq, lds, wid, lane); S.done(cur); }
#undef PG8_SA
#undef PG8_SB
#undef PG8_STAGE
#undef PG8_LDA
#undef PG8_LDB
#undef PG8_MMA
#undef PG8_WAIT_V
#undef PG8_WAIT_L
#undef PG8_BAR
#undef PG8_SCHED
}
}


#define XB_TMO      128
#define XB_XCNT(j)  (256  + 64 * (j))
#define XB_XSUB(j)  (1280 + 64 * (j))
#define XB_XGEN(j)  (2304 + 64 * (j))
#define XB_TOP      3328
#define XB_TOPGEN   3392
#define XCD_BAR_WORDS 3456
#define XB_SPIN_CAP (1u << 18)
#define LAS __attribute__((address_space(3)))

__device__ __forceinline__ unsigned xb_ld(unsigned* p)              { return __hip_atomic_load(p, __ATOMIC_RELAXED, __HIP_MEMORY_SCOPE_AGENT); }
__device__ __forceinline__ unsigned xb_add(unsigned* p, unsigned v) { return __hip_atomic_fetch_add(p, v, __ATOMIC_RELAXED, __HIP_MEMORY_SCOPE_AGENT); }
__device__ __forceinline__ unsigned xb_xcc_id() { return (unsigned)__builtin_amdgcn_s_getreg((3 << 11) | 20) & 0xFu; }
#define XB_SPIN(cond, bar) do { unsigned _sp = 0; while (cond) { __builtin_amdgcn_s_sleep(1); \
    if ((++_sp & 255u) == 0u) { if (xb_ld(&(bar)[XB_TMO])) break; if (_sp > XB_SPIN_CAP) { atomicAdd(&(bar)[XB_TMO], 1u); break; } } } } while (0)

struct XcdBarrier { unsigned* bar; unsigned x; volatile LAS unsigned* st; };
__device__ __forceinline__ XcdBarrier xcd_barrier_post(unsigned* bar, volatile LAS unsigned* st, bool t0) {
    XcdBarrier b; b.bar = bar; b.x = xb_xcc_id(); b.st = st;
    if (t0) (void)xb_add(&bar[XB_XCNT(b.x)], 1u);
    return b;
}
__device__ __forceinline__ void xcd_barrier_complete(unsigned* bar, unsigned x, unsigned& nloc, unsigned& nx) {
    const unsigned G = gridDim.x * gridDim.y * gridDim.z;
    unsigned sum, cnt, mine, sp = 0u;
    for (;;) {
        sum = 0u; cnt = 0u; mine = 0u;
#pragma unroll
        for (unsigned j = 0; j < 16; ++j) { const unsigned c = xb_ld(&bar[XB_XCNT(j)]); sum += c; cnt += (c > 0u) ? 1u : 0u; mine = (j == x) ? c : mine; }
        if (sum == G) break;
        __builtin_amdgcn_s_sleep(1);
        if ((++sp & 255u) == 0u) { if (xb_ld(&bar[XB_TMO])) break; if (sp > XB_SPIN_CAP) { atomicAdd(&bar[XB_TMO], 1u); break; } }
    }
    nloc = mine > 0u ? mine : 1u; nx = cnt > 0u ? cnt : 1u;
}
__device__ __forceinline__ void xcd_barrier(const XcdBarrier& b, bool t0) {
    asm volatile("s_waitcnt vmcnt(0)" ::: "memory");
    __syncthreads();
    if (t0) {
        unsigned* bar = b.bar;
        __builtin_amdgcn_s_waitcnt(0);
        unsigned nloc = b.st[0], nx = b.st[1];
        if (nloc == 0u) { xcd_barrier_complete(bar, b.x, nloc, nx); b.st[0] = nloc; b.st[1] = nx; }
        const unsigned old = xb_add(&bar[XB_XSUB(b.x)], 1u);
        const unsigned gen = old / nloc;
        if (old + 1u == (gen + 1u) * nloc) {
            __builtin_amdgcn_fence(__ATOMIC_RELEASE, "agent");
            asm volatile("s_waitcnt vmcnt(0)" ::: "memory");
            const unsigned og = xb_add(&bar[XB_TOP], 1u);
            const unsigned tg = og / nx;
            if (og + 1u == (tg + 1u) * nx) xb_add(&bar[XB_TOPGEN], 1u);
            else XB_SPIN(xb_ld(&bar[XB_TOPGEN]) == tg, bar);
            __builtin_amdgcn_fence(__ATOMIC_ACQUIRE, "agent");
            xb_add(&bar[XB_XGEN(b.x)], 1u);
            asm volatile("s_waitcnt vmcnt(0)" ::: "memory");
        } else {
            XB_SPIN(xb_ld(&bar[XB_XGEN(b.x)]) == gen, bar);
            __builtin_amdgcn_fence(__ATOMIC_ACQUIRE, "agent");
            asm volatile("s_waitcnt vmcnt(0)" ::: "memory");
        }
    }
    __syncthreads();
}

using pg8::bf16_t; using pg8::bf16x8; using pg8::f32x4; using pg8::u32x4;
typedef unsigned u32x2 __attribute__((ext_vector_type(2)));
typedef __bf16 bf16x2_t __attribute__((ext_vector_type(2)));
typedef float f32x2 __attribute__((ext_vector_type(2)));
#define DI __device__ __forceinline__

constexpr int MMAIN = 16384, MPAD = 16640, IN_DIM = 6672, DFF = 2816, FF2 = 5632;
constexpr size_t SZ_ACT = (size_t)MPAD * 1024 * 2;
constexpr size_t WS_WIN = 0;
constexpr size_t WS_WOUT = WS_WIN + (size_t)6656 * 1024 * 2;
constexpr size_t WS_WUP = WS_WOUT + (size_t)1024 * 1024 * 2;
constexpr size_t WS_WDN = WS_WUP + (size_t)5632 * 1024 * 2;
constexpr size_t WS_WPT = WS_WDN + (size_t)1024 * 2816 * 2;
constexpr size_t WS_U = WS_WPT + (size_t)4 * 256 * 128 * 2;
constexpr int USEQ = 8448;
constexpr size_t SZ_U = (size_t)2 * USEQ * 1024 * 2;
static_assert(SZ_U >= SZ_ACT, "U region");
constexpr size_t WS_QB = WS_U + SZ_U;
constexpr size_t WS_KB = WS_QB + SZ_ACT;
constexpr size_t WS_VB = WS_KB + SZ_ACT;
constexpr size_t WS_WB = WS_VB + SZ_ACT;
constexpr size_t WS_KTB = WS_WB + SZ_ACT;
constexpr size_t WS_QKB = WS_KTB + SZ_ACT;
constexpr size_t WS_HALO = WS_QKB + (size_t)260 * 8 * 4096 * 2;
constexpr size_t WS_BA = WS_HALO + (size_t)260 * 2 * 5632 * 2;
constexpr size_t WS_HM = WS_BA + (size_t)MPAD * 16 * 4;
constexpr size_t WS_GT = WS_HM + (size_t)256 * 1024 * 4;
constexpr size_t WS_BAR = WS_GT + (size_t)2080 * 128;
constexpr size_t WS_TS = WS_BAR + (size_t)XCD_BAR_WORDS * 4;
constexpr size_t WS_FLAG = WS_TS + 1024;
constexpr size_t WS_XT = WS_FLAG + (size_t)2 * 2080 * 4;
constexpr size_t WS_END = WS_XT + 256;
static_assert(WS_QKB + (size_t)260 * 8 * 4096 * 2 - WS_QB == (size_t)MPAD * FF2 * 2, "hid overlay");
static_assert(WS_END <= 268435456ull, "workspace");
constexpr int LDS_BYTES = 131072 + 16 + 8192 + 3072;

struct Params {
    const float *x, *meta, *norm_mix, *w_in, *conv_qkv, *a_log, *dt_bias, *head_norm, *w_pool, *pool_scale, *w_out, *norm_ffn, *w_up, *conv_ffn, *w_down, *norm_final;
    float* out; unsigned char* ws; int wid0, pad0;
};

DI int lane_id_fresh() { int l; asm volatile("v_mbcnt_lo_u32_b32 %0, -1, 0\n\tv_mbcnt_hi_u32_b32 %0, -1, %0" : "=&v"(l)); return l; }
DI int opaque_tid(const Params& p) { return (p.wid0 << 6) | lane_id_fresh(); }
DI unsigned pk2(float a, float b) { f32x2 v = {a, b}; bf16x2_t r = __builtin_convertvector(v, bf16x2_t); return __builtin_bit_cast(unsigned, r); }
DI bf16_t f2bf(float a) { return (bf16_t)(pk2(a, 0.f) & 0xffffu); }
DI float bflo(unsigned w) { return __uint_as_float(w << 16); }
DI float bfhi(unsigned w) { return __uint_as_float(w & 0xffff0000u); }
DI float bf2f(bf16_t b) { return __uint_as_float(((unsigned)b) << 16); }
DI bf16x8 pack8(f32x4 a, f32x4 b) { u32x4 w; w.x = pk2(a[0], a[1]); w.y = pk2(a[2], a[3]); w.z = pk2(b[0], b[1]); w.w = pk2(b[2], b[3]); return __builtin_bit_cast(bf16x8, w); }
DI f32x4 mfma16(bf16x8 a, bf16x8 b, f32x4 c) { return __builtin_amdgcn_mfma_f32_16x16x32_bf16(a, b, c, 0, 0, 0); }
DI float sigm(float x) { return __builtin_amdgcn_rcpf(1.0f + __expf(-x)); }
DI float silu(float x) { return x * __builtin_amdgcn_rcpf(1.0f + __expf(-x)); }
DI float shxl(float v, int off, int lane) { return __builtin_bit_cast(float, __builtin_amdgcn_ds_bpermute((lane ^ off) << 2, __builtin_bit_cast(int, v))); }
DI float wsum(float v, int lane) { v += shxl(v, 32, lane); v += shxl(v, 16, lane); v += shxl(v, 8, lane); v += shxl(v, 4, lane); v += shxl(v, 2, lane); v += shxl(v, 1, lane); return v; }
DI void st_wt16(void* ptr, u32x4 v) {
    unsigned long long* q = (unsigned long long*)ptr;
    __hip_atomic_store(q, ((unsigned long long)v.y << 32) | v.x, __ATOMIC_RELAXED, __HIP_MEMORY_SCOPE_AGENT);
    __hip_atomic_store(q + 1, ((unsigned long long)v.w << 32) | v.z, __ATOMIC_RELAXED, __HIP_MEMORY_SCOPE_AGENT); }
DI void st_wt4(float* ptr, float v) { __hip_atomic_store(ptr, v, __ATOMIC_RELAXED, __HIP_MEMORY_SCOPE_AGENT); }
DI float* hrow(const Params& p, int r) { return r < MMAIN ? p.out + (size_t)r * 1024 : (float*)(p.ws + WS_HM) + (size_t)(r - MMAIN) * 1024; }

struct EpiQKV {
    static constexpr bool PERM = true, AFTER_DRAIN = false;
    bf16_t *Q, *halo;
    DI void operator()(const f32x4 (&acc)[2][2][4][2], const pg8::Unit& u, int wr, int wc, int fr, int fq) const {
        const int which = u.pn >> 2; bf16_t* base = Q + (size_t)which * (SZ_ACT / 2);
#pragma unroll
        for (int ai = 0; ai < 2; ++ai)
#pragma unroll
            for (int m = 0; m < 4; ++m) {
                const int cb = u.pm * 4 + ai * 2 + wr, rr = m * 16 + fr;
#pragma unroll
                for (int bj = 0; bj < 2; ++bj) {
                    const int head = (u.pn & 3) * 2 + bj, cc = wc * 32 + 8 * fq;
                    const f32x4 v0 = acc[ai][bj][m][0], v1 = acc[ai][bj][m][1];
                    u32x4 w; w.x = pk2(v0[0], v0[1]); w.y = pk2(v0[2], v0[3]); w.z = pk2(v1[0], v1[1]); w.w = pk2(v1[2], v1[3]);
                    *(u32x4*)(base + ((size_t)(cb * 8 + head) * 64 + rr) * 128 + cc) = w;
                    if (m == 3 && fr >= 13) *(u32x4*)(halo + ((size_t)cb * 3 + (rr - 61)) * 3072 + u.pn * 256 + bj * 128 + cc) = w;
                }
            }
    }
};
struct EpiZPG {
    static constexpr bool PERM = true, AFTER_DRAIN = false;
    bf16_t *QB0;
    DI void operator()(const f32x4 (&acc)[2][2][4][2], const pg8::Unit& u, int wr, int wc, int fr, int fq) const {
        const int ge4 = u.pn >= 4, ge6 = u.pn >= 6, ge10 = u.pn >= 10, idx = ge4 + ge6 + ge10, is1 = (idx == 1);
        const int slot = idx + 4 * is1, ld = 1024 >> is1, c0 = (u.pn - (4 * ge4 + 2 * ge6 + 4 * ge10)) * 256;
        bf16_t* base = QB0 + (size_t)slot * (SZ_ACT / 2);
#pragma unroll
        for (int ai = 0; ai < 2; ++ai)
#pragma unroll
            for (int m = 0; m < 4; ++m) {
                const int row = u.pm * 256 + ai * 128 + wr * 64 + m * 16 + fr;
#pragma unroll
                for (int bj = 0; bj < 2; ++bj) {
                    const f32x4 v0 = acc[ai][bj][m][0], v1 = acc[ai][bj][m][1];
                    u32x4 w; w.x = pk2(v0[0], v0[1]); w.y = pk2(v0[2], v0[3]); w.z = pk2(v1[0], v1[1]); w.w = pk2(v1[2], v1[3]);
                    *(u32x4*)(base + (size_t)row * ld + c0 + bj * 128 + wc * 32 + 8 * fq) = w;
                }
            }
    }
};
DI float dpp_shr1(float old, float src) { return __builtin_bit_cast(float, __builtin_amdgcn_update_dpp(__builtin_bit_cast(int, old), __builtin_bit_cast(int, src), 0x111, 0xf, 0xf, false)); }
DI float dpp_shr2(float old, float src) { return __builtin_bit_cast(float, __builtin_amdgcn_update_dpp(__builtin_bit_cast(int, old), __builtin_bit_cast(int, src), 0x112, 0xf, 0xf, false)); }
DI float dpp_ror1(float src) { return __builtin_bit_cast(float, __builtin_amdgcn_update_dpp(0, __builtin_bit_cast(int, src), 0x121, 0xf, 0xf, false)); }
DI float dpp_ror2(float src) { return __builtin_bit_cast(float, __builtin_amdgcn_update_dpp(0, __builtin_bit_cast(int, src), 0x122, 0xf, 0xf, false)); }
struct EpiAct {
    static constexpr bool PERM = true, AFTER_DRAIN = false;
    bf16_t* ACT; const float* cw; PG8_LAS float* X;
    DI void operator()(const f32x4 (&acc)[2][2][4][2], const pg8::Unit& u, int wr, int wc, int fr, int fq) const {
        int fqz = fq; asm volatile("" : "+v"(fqz));
        const int xcol = wc * 32 + 8 * fqz, f0 = u.pn * 128 + xcol;
        PG8_LAS float* CW = X + 2048;
        if (fr == 0 && wr == 0) {
#pragma unroll
            for (int j = 0; j < 3; ++j)
#pragma unroll
                for (int bj = 0; bj < 2; ++bj)
#pragma unroll
                    for (int n = 0; n < 2; ++n) *(PG8_LAS f32x4*)(CW + (j * 2 + bj) * 128 + xcol + 4 * n) = *(const f32x4*)(cw + j * FF2 + bj * DFF + f0 + 4 * n);
        }
        if (fr >= 14) {
#pragma unroll
            for (int ai = 0; ai < 2; ++ai)
#pragma unroll
                for (int bj = 0; bj < 2; ++bj)
#pragma unroll
                    for (int n = 0; n < 2; ++n) *(PG8_LAS f32x4*)(X + (((2 * ai + wr) * 2 + (fr - 14)) * 256 + bj * 128 + xcol + 4 * n)) = acc[ai][bj][3][n];
        }
        asm volatile("s_waitcnt lgkmcnt(0)" ::: "memory"); __builtin_amdgcn_s_barrier(); asm volatile("" ::: "memory"); __builtin_amdgcn_s_barrier(); asm volatile("" ::: "memory");
        const int batch = u.pm / 33, jt = u.pm % 33;
#pragma unroll
        for (int ai = 0; ai < 2; ++ai)
#pragma unroll
            for (int m = 0; m < 4; ++m) {
                const int r = 128 * ai + 64 * wr + 16 * m + fr, pos = 254 * jt - 2 + r, blk = 2 * ai + wr;
                float gv[2][8];
#pragma unroll
                for (int bj = 0; bj < 2; ++bj)
#pragma unroll
                    for (int n = 0; n < 2; ++n) {
                        const f32x4 cur = acc[ai][bj][m][n]; f32x4 q1, q2;
                        if (m > 0) { const f32x4 pv = acc[ai][bj][m - 1][n];
#pragma unroll
                            for (int e = 0; e < 4; ++e) { q1[e] = dpp_ror1(pv[e]); q2[e] = dpp_ror2(pv[e]); } }
                        else if (blk > 0) { q1 = *(const PG8_LAS f32x4*)(X + (((blk - 1) * 2 + 1) * 256 + bj * 128 + xcol + 4 * n)); q2 = *(const PG8_LAS f32x4*)(X + (((blk - 1) * 2 + (fr & 1)) * 256 + bj * 128 + xcol + 4 * n)); }
                        else { q1 = (f32x4){0.f, 0.f, 0.f, 0.f}; q2 = q1; }
                        const f32x4 w0 = *(const PG8_LAS f32x4*)(CW + (0 * 2 + bj) * 128 + xcol + 4 * n), w1 = *(const PG8_LAS f32x4*)(CW + (1 * 2 + bj) * 128 + xcol + 4 * n), w2 = *(const PG8_LAS f32x4*)(CW + (2 * 2 + bj) * 128 + xcol + 4 * n);
#pragma unroll
                        for (int e = 0; e < 4; ++e) { const float p1 = dpp_shr1(q1[e], cur[e]), p2 = dpp_shr2(q2[e], cur[e]); gv[bj][4 * n + e] = w0[e] * p2 + w1[e] * p1 + w2[e] * cur[e]; }
                    }
                u32x4 w; float a[8];
#pragma unroll
                for (int e = 0; e < 8; ++e) a[e] = silu(gv[0][e]) * gv[1][e];
                w.x = pk2(a[0], a[1]); w.y = pk2(a[2], a[3]); w.z = pk2(a[4], a[5]); w.w = pk2(a[6], a[7]);
                if (r >= 2 && pos <= 8207) { const size_t orow = pos >= 16 ? (size_t)batch * 8192 + (pos - 16) : (size_t)MMAIN + 64 * batch + 48 + pos;
                    *(u32x4*)(ACT + orow * DFF + f0) = w; }
            }
    }
};
struct EpiRes {
    static constexpr bool PERM = true, AFTER_DRAIN = false;
    float *hmain, *hmeta; float scale;
    DI void operator()(const f32x4 (&acc)[2][2][4][2], const pg8::Unit& u, int wr, int wc, int fr, int fq) const {
        const int col0 = u.pn * 256 + wc * 32 + 8 * fq;
#pragma unroll
        for (int ai = 0; ai < 2; ++ai) {
            f32x4 t[4][2][2];
#pragma unroll
            for (int m = 0; m < 4; ++m) { const int row = u.pm * 256 + ai * 128 + wr * 64 + m * 16 + fr;
                const float* rp = (row < MMAIN ? hmain + (size_t)row * 1024 : hmeta + (size_t)(row - MMAIN) * 1024) + col0;
#pragma unroll
                for (int bj = 0; bj < 2; ++bj)
#pragma unroll
                    for (int n = 0; n < 2; ++n) t[m][bj][n] = *(const f32x4*)(rp + bj * 128 + n * 4); }
#pragma unroll
            for (int m = 0; m < 4; ++m) { const int row = u.pm * 256 + ai * 128 + wr * 64 + m * 16 + fr;
                float* rp = (row < MMAIN ? hmain + (size_t)row * 1024 : hmeta + (size_t)(row - MMAIN) * 1024) + col0;
#pragma unroll
                for (int bj = 0; bj < 2; ++bj)
#pragma unroll
                    for (int n = 0; n < 2; ++n) *(f32x4*)(rp + bj * 128 + n * 4) = t[m][bj][n] + acc[ai][bj][m][n] * scale; }
        }
    }
};

struct MstQKV { bf16_t *Q, *halo; DI void operator()(int b, int i, int col, float v) const {
    const int which = col >> 10, head = (col >> 7) & 7, cc = col & 127, cb = 256 + b, rr = 48 + i; const bf16_t w = f2bf(v);
    Q[(size_t)which * (SZ_ACT / 2) + ((size_t)(cb * 8 + head) * 64 + rr) * 128 + cc] = w;
    if (rr >= 61) halo[((size_t)cb * 3 + rr - 61) * 3072 + col] = w; } };
struct MstZPG { bf16_t* QB0; DI void operator()(int b, int i, int col, float v) const {
    const int ge1 = col >= 1024, ge2 = col >= 1536, ge3 = col >= 2560, idx = ge1 + ge2 + ge3, is1 = (idx == 1);
    const int slot = idx + 4 * is1, ld = 1024 >> is1, c = col - (1024 * ge1 + 512 * ge2 + 1024 * ge3); const size_t row = MMAIN + 64 * b + 48 + i;
    QB0[(size_t)slot * (SZ_ACT / 2) + row * ld + c] = f2bf(v); } };
struct MstRes { float* hm; DI void operator()(int b, int i, int col, float v) const { (void)__hip_atomic_fetch_add(hm + (size_t)(64 * b + 48 + i) * 1024 + col, v, __ATOMIC_RELAXED, __HIP_MEMORY_SCOPE_AGENT); } };
struct MstHid { bf16_t *H, *halo; DI void operator()(int b, int i, int col, float v) const {
    const size_t row = MMAIN + 64 * b + 48 + i; const int rr = 48 + i; const bf16_t w = f2bf(v);
    H[row * FF2 + col] = w; if (rr >= 62) halo[((size_t)(256 + b) * 2 + rr - 62) * FF2 + col] = w; } };
template <class St> DI void meta_gemm(unsigned char* smem, const bf16_t* A, int lda, const bf16_t* Bt, int ldb, int K, int nitems, const St& st, int tid, int span) {
    const int lane = tid & 63, wid = tid >> 6, q4 = lane >> 4, l16 = lane & 15;
    float* red = (float*)smem;
    const int first = (int)gridDim.x - 1 - (int)blockIdx.x; if (first >= span) return;
    for (int it = first; it < nitems; it += span) {
        const int n0 = it * 16;
        const bf16_t* a0 = A + (size_t)(MMAIN + 48 + l16) * lda + 8 * q4; const bf16_t* a1 = a0 + (size_t)64 * lda;
        const bf16_t* bp = Bt + (size_t)(n0 + l16) * ldb + 8 * q4;
        const int ks = K >> 3, kbeg = wid * ks, kend = kbeg + ks;
        f32x4 d0 = {0.f, 0.f, 0.f, 0.f}, d1 = {0.f, 0.f, 0.f, 0.f};
        for (int k = kbeg; k < kend; k += 128) { bf16x8 fa0[4], fa1[4], fb[4]; const int nst = (kend - k) >> 5;
#pragma unroll
            for (int s = 0; s < 4; ++s) if (s < nst) { fa0[s] = *(const bf16x8*)(a0 + k + 32 * s); fa1[s] = *(const bf16x8*)(a1 + k + 32 * s); fb[s] = *(const bf16x8*)(bp + k + 32 * s); }
#pragma unroll
            for (int s = 0; s < 4; ++s) if (s < nst) { d0 = mfma16(fa0[s], fb[s], d0); d1 = mfma16(fa1[s], fb[s], d1); } }
        *(f32x4*)(red + (wid * 64 + lane) * 8) = d0; *(f32x4*)(red + (wid * 64 + lane) * 8 + 4) = d1;
        __syncthreads();
        if (wid == 0) {
#pragma unroll
            for (int w = 1; w < 8; ++w) { d0 += *(const f32x4*)(red + (w * 64 + lane) * 8); d1 += *(const f32x4*)(red + (w * 64 + lane) * 8 + 4); }
#pragma unroll
            for (int e = 0; e < 4; ++e) { st(0, 4 * q4 + e, n0 + l16, d0[e]); st(1, 4 * q4 + e, n0 + l16, d1[e]); } }
        __syncthreads();
    }
}

struct CvtTile { const float* src; bf16_t* dst; int ldw, ldb; };
DI CvtTile cvt_decode(const Params& p, int layer, int t) {
    const float* win = p.w_in + (size_t)layer * 1024 * IN_DIM; const float* wout = p.w_out + (size_t)layer * 1024 * 1024;
    const float* wup = p.w_up + (size_t)layer * 1024 * FF2; const float* wdn = p.w_down + (size_t)layer * DFF * 1024; const float* wpl = p.w_pool + (size_t)layer * 4 * 128 * 256;
    bf16_t* Win = (bf16_t*)(p.ws + WS_WIN); bf16_t* Wout = (bf16_t*)(p.ws + WS_WOUT); bf16_t* Wup = (bf16_t*)(p.ws + WS_WUP); bf16_t* Wdn = (bf16_t*)(p.ws + WS_WDN); bf16_t* Wpt = (bf16_t*)(p.ws + WS_WPT);
    CvtTile c;
    if (t < 1664) { const int kt = t / 104, nt = t % 104, n0 = nt * 64; c.src = win + (size_t)(kt * 64) * IN_DIM + n0 + (n0 >= 4096 ? 16 : 0); c.ldw = IN_DIM; c.dst = Win + (size_t)n0 * 1024 + kt * 64; c.ldb = 1024; }
    else if (t < 1920) { const int q = t - 1664, kt = q >> 4, nt = q & 15; c.src = wout + (size_t)(kt * 64) * 1024 + nt * 64; c.ldw = 1024; c.dst = Wout + (size_t)(nt * 64) * 1024 + kt * 64; c.ldb = 1024; }
    else if (t < 3328) { const int q = t - 1920, kt = q / 88, nt = q % 88; const int n0 = nt * 64; c.src = wup + (size_t)(kt * 64) * FF2 + ((n0 >> 7) & 1) * DFF + (n0 >> 8) * 128 + (n0 & 127); c.ldw = FF2; c.dst = Wup + (size_t)(nt * 64) * 1024 + kt * 64; c.ldb = 1024; }
    else if (t < 4032) { const int q = t - 3328, kt = q >> 4, nt = q & 15; c.src = wdn + (size_t)(kt * 64) * 1024 + nt * 64; c.ldw = 1024; c.dst = Wdn + (size_t)(nt * 64) * DFF + kt * 64; c.ldb = DFF; }
    else { const int q = t - 4032, g = q >> 3, kt = (q >> 2) & 1, nt = q & 3; c.src = wpl + (size_t)g * 128 * 256 + (size_t)(kt * 64) * 256 + nt * 64; c.ldw = 256; c.dst = Wpt + (size_t)g * 256 * 128 + (size_t)(nt * 64) * 128 + kt * 64; c.ldb = 128; }
    return c;
}
DI void convert_weights(const Params& p, int layer, unsigned char* smem, int tid, int t_begin, int t_end, int blk, int nblk) {
    float* tl0 = (float*)smem; float* tl1 = tl0 + 64 * 65;
    const int kk = tid >> 4, c4 = (tid & 15) * 4, nn = tid >> 3, k8 = (tid & 7) * 8;
    int t = t_begin + blk; if (t >= t_end) return;
    CvtTile a = cvt_decode(p, layer, t); bool hb = (t + nblk < t_end); CvtTile b = hb ? cvt_decode(p, layer, t + nblk) : a;
    float4 a0 = *(const float4*)(a.src + (size_t)kk * a.ldw + c4), a1 = *(const float4*)(a.src + (size_t)(kk + 32) * a.ldw + c4);
    float4 b0 = *(const float4*)(b.src + (size_t)kk * b.ldw + c4), b1 = *(const float4*)(b.src + (size_t)(kk + 32) * b.ldw + c4);
    for (;;) {
        const int tn = t + 2 * nblk; const bool more = tn < t_end;
        CvtTile na = a, nb = b; bool nhb = false; float4 na0 = a0, na1 = a1, nb0 = b0, nb1 = b1;
        if (more) { na = cvt_decode(p, layer, tn); nhb = (tn + nblk < t_end); nb = nhb ? cvt_decode(p, layer, tn + nblk) : na;
            na0 = *(const float4*)(na.src + (size_t)kk * na.ldw + c4); na1 = *(const float4*)(na.src + (size_t)(kk + 32) * na.ldw + c4);
            nb0 = *(const float4*)(nb.src + (size_t)kk * nb.ldw + c4); nb1 = *(const float4*)(nb.src + (size_t)(kk + 32) * nb.ldw + c4); }
        tl0[kk * 65 + c4 + 0] = a0.x; tl0[kk * 65 + c4 + 1] = a0.y; tl0[kk * 65 + c4 + 2] = a0.z; tl0[kk * 65 + c4 + 3] = a0.w;
        tl0[(kk + 32) * 65 + c4 + 0] = a1.x; tl0[(kk + 32) * 65 + c4 + 1] = a1.y; tl0[(kk + 32) * 65 + c4 + 2] = a1.z; tl0[(kk + 32) * 65 + c4 + 3] = a1.w;
        if (hb) { tl1[kk * 65 + c4 + 0] = b0.x; tl1[kk * 65 + c4 + 1] = b0.y; tl1[kk * 65 + c4 + 2] = b0.z; tl1[kk * 65 + c4 + 3] = b0.w;
            tl1[(kk + 32) * 65 + c4 + 0] = b1.x; tl1[(kk + 32) * 65 + c4 + 1] = b1.y; tl1[(kk + 32) * 65 + c4 + 2] = b1.z; tl1[(kk + 32) * 65 + c4 + 3] = b1.w; }
        __syncthreads();
        { float f[8];
#pragma unroll
          for (int j = 0; j < 8; ++j) f[j] = tl0[(k8 + j) * 65 + nn];
          u32x4 w; w.x = pk2(f[0], f[1]); w.y = pk2(f[2], f[3]); w.z = pk2(f[4], f[5]); w.w = pk2(f[6], f[7]);
          *(u32x4*)(a.dst + (size_t)nn * a.ldb + k8) = w; }
        if (hb) { float f[8];
#pragma unroll
          for (int j = 0; j < 8; ++j) f[j] = tl1[(k8 + j) * 65 + nn];
          u32x4 w; w.x = pk2(f[0], f[1]); w.y = pk2(f[2], f[3]); w.z = pk2(f[4], f[5]); w.w = pk2(f[6], f[7]);
          *(u32x4*)(b.dst + (size_t)nn * b.ldb + k8) = w; }
        __syncthreads();
        if (!more) break;
        t = tn; a = na; b = nb; hb = nhb; a0 = na0; a1 = na1; b0 = nb0; b1 = nb1;
    }
}

DI const float* norm_src(const Params& p, bool init, int r) {
    if (!init) return hrow(p, r);
    if (r < MMAIN) return p.x + (size_t)r * 1024;
    const int rm = r - MMAIN, s = rm & 63; return (rm < 128 && s >= 48) ? p.meta + (size_t)(s - 48) * 1024 : nullptr;
}
DI void phase_norm(const Params& p, int layer, int which, unsigned char* smem) {
    const int tid = opaque_tid(p), lane = tid & 63, wid = tid >> 6;
    float* wba = (float*)smem;
    float* BA = (float*)(p.ws + WS_BA); bf16_t* U = (bf16_t*)(p.ws + WS_U);
    if (which == 0) {
        convert_weights(p, layer, smem, tid, 0, 1664, (int)blockIdx.x, (int)gridDim.x);
        __syncthreads();
        const float* win = p.w_in + (size_t)layer * 1024 * IN_DIM;
        for (int e = tid; e < 4096; e += 512) { const int k = e >> 2, j4 = (e & 3) * 4; const float4 w = *(const float4*)(win + (size_t)k * IN_DIM + 4096 + j4);
            wba[(j4 + 0) * 1024 + k] = w.x; wba[(j4 + 1) * 1024 + k] = w.y; wba[(j4 + 2) * 1024 + k] = w.z; wba[(j4 + 3) * 1024 + k] = w.w; }
        __syncthreads();
    }
    if (which == 1 && blockIdx.x == 0) { for (int e = tid; e < 4 * 128; e += 512) { const int rr = e >> 7, c8 = (e & 127) * 8; *(u32x4*)(U + ((size_t)(rr >> 1) * USEQ + (rr & 1)) * 1024 + c8) = (u32x4){0u, 0u, 0u, 0u}; } }
    const float* gain = (which == 0 ? p.norm_mix : p.norm_ffn) + layer * 1024;
    const bool init = (layer == 0 && which == 0);
    int r = blockIdx.x * 8 + wid; const int rstep = gridDim.x * 8;
    f32x4 nv[4];
    { const float* s0 = r < MPAD ? norm_src(p, init, r) : nullptr;
#pragma unroll
      for (int i = 0; i < 4; ++i) nv[i] = s0 ? *(const f32x4*)(s0 + 256 * i + 4 * lane) : (f32x4){0.f, 0.f, 0.f, 0.f}; }
    for (; r < MPAD; r += rstep) {
        f32x4 v[4]; float ss = 0.f;
#pragma unroll
        for (int i = 0; i < 4; ++i) { v[i] = nv[i]; ss += (v[i][0] * v[i][0] + v[i][1] * v[i][1]) + (v[i][2] * v[i][2] + v[i][3] * v[i][3]); }
        { const int rn = r + rstep; const float* s1 = rn < MPAD ? norm_src(p, init, rn) : nullptr;
#pragma unroll
          for (int i = 0; i < 4; ++i) nv[i] = s1 ? *(const f32x4*)(s1 + 256 * i + 4 * lane) : (f32x4){0.f, 0.f, 0.f, 0.f}; }
        if (r >= MMAIN) { const int rm_ = r - MMAIN; if (!(rm_ < 128 && (rm_ & 63) >= 48)) continue; }
        if (init) { float* hr = hrow(p, r);
#pragma unroll
            for (int i = 0; i < 4; ++i) *(f32x4*)(hr + 256 * i + 4 * lane) = v[i]; }
        ss = wsum(ss, lane);
        const float rstd = rsqrtf(ss * (1.0f / 1024.0f) + 1e-6f);
        long urow = r;
        if (which == 1) { if (r < MMAIN) urow = (long)(r >> 13) * USEQ + 18 + (r & 8191); else { const int rm = r - MMAIN, s = rm & 63; urow = (rm < 128 && s >= 48) ? (long)(rm >> 6) * USEQ + 2 + (s - 48) : -1; } }
#pragma unroll
        for (int i = 0; i < 4; ++i) { const f32x4 g4 = *(const f32x4*)(gain + 256 * i + 4 * lane); v[i] = v[i] * rstd * g4;
            if (urow >= 0) { u32x2 w; w.x = pk2(v[i][0], v[i][1]); w.y = pk2(v[i][2], v[i][3]); *(u32x2*)(U + (size_t)urow * 1024 + 256 * i + 4 * lane) = w; } }
        if (which == 0) {
            float acc[16]; int vz = 0; asm volatile("" : "+v"(vz)); const float* wbz = wba + vz + 4 * lane;
#pragma unroll
            for (int j = 0; j < 16; ++j) { float a = 0.f;
#pragma unroll
                for (int i = 0; i < 4; ++i) { const f32x4 w = *(const f32x4*)(wbz + j * 1024 + 256 * i); a += (v[i][0] * w[0] + v[i][1] * w[1]) + (v[i][2] * w[2] + v[i][3] * w[3]); }
                acc[j] = a; }
#pragma unroll
            for (int off = 32; off >= 1; off >>= 1) { float t[16];
#pragma unroll
                for (int j = 0; j < 16; ++j) t[j] = shxl(acc[j], off, lane);
#pragma unroll
                for (int j = 0; j < 16; ++j) acc[j] += t[j]; }
            float o = 0.f;
#pragma unroll
            for (int j = 0; j < 16; ++j) o = (lane == j) ? acc[j] : o;
            if (lane < 16) BA[(size_t)r * 16 + lane] = o;
        }
    }
}
DI void phase_final(const Params& p) {
    const int tid = opaque_tid(p), lane = tid & 63, wid = tid >> 6;
    for (int r = blockIdx.x * 8 + wid; r < MMAIN; r += gridDim.x * 8) {
        float* hr = p.out + (size_t)r * 1024; f32x4 v[4]; float ss = 0.f;
#pragma unroll
        for (int i = 0; i < 4; ++i) { v[i] = *(const f32x4*)(hr + 256 * i + 4 * lane); ss += (v[i][0] * v[i][0] + v[i][1] * v[i][1]) + (v[i][2] * v[i][2] + v[i][3] * v[i][3]); }
        ss = wsum(ss, lane); const float rstd = rsqrtf(ss * (1.0f / 1024.0f) + 1e-6f);
#pragma unroll
        for (int i = 0; i < 4; ++i) *(f32x4*)(hr + 256 * i + 4 * lane) = v[i] * rstd * *(const f32x4*)(p.norm_final + 256 * i + 4 * lane);
    }
}

DI void phase_p3(const Params& p, int layer, unsigned char* smem, int pblk, int npblk) {
    const int tid = opaque_tid(p), lane = tid & 63, wid = tid >> 6; int q4 = lane >> 4, l16 = lane & 15;
    bf16_t* qs = (bf16_t*)(smem); bf16_t* ks = (bf16_t*)(smem + 17408); bf16_t* vbT = (bf16_t*)(smem + 34816); bf16_t* kgT = (bf16_t*)(smem + 53248);
    float* Lm = (float*)(smem + 71680); bf16_t* Tb = (bf16_t*)(smem + 89088); float* sc = (float*)(smem + 98304);
    bf16_t* QB = (bf16_t*)(p.ws + WS_QB); bf16_t* KB = (bf16_t*)(p.ws + WS_KB); bf16_t* VB = (bf16_t*)(p.ws + WS_VB); bf16_t* WB = (bf16_t*)(p.ws + WS_WB);
    bf16_t* KTB = (bf16_t*)(p.ws + WS_KTB); bf16_t* QKB = (bf16_t*)(p.ws + WS_QKB); const bf16_t* HALO = (const bf16_t*)(p.ws + WS_HALO);
    const float* BA = (const float*)(p.ws + WS_BA); float* GT = (float*)(p.ws + WS_GT);
    const float* cw = p.conv_qkv + (size_t)layer * 4 * 3072;
    const float SCALE = 0.08838834764831845f;
    unsigned* flags = (unsigned*)(p.ws + WS_FLAG) + layer * 2080;
    const unsigned* XT = (const unsigned*)(p.ws + WS_XT); const unsigned myx = xb_xcc_id();
    for (int o = pblk; o < 129 * 16; o += npblk) {
        const int c = o >> 4, b = (o >> 3) & 1, h = o & 7, cb = (c == 0) ? 256 + b : 128 * b + c - 1, item = cb * 8 + h;
        const int prev_cb = (c == 0) ? -1 : (c == 1 ? 256 + b : cb - 1);
        const size_t blk = (size_t)item * 8192;
            const int c0 = 2 * lane, r0 = 8 * wid;
            float wq[4][2], wk[4][2], wv[4][2];
#pragma unroll
            for (int j = 0; j < 4; ++j)
#pragma unroll
                for (int e = 0; e < 2; ++e) { wq[j][e] = cw[j * 3072 + h * 128 + c0 + e]; wk[j][e] = cw[j * 3072 + 1024 + h * 128 + c0 + e]; wv[j][e] = cw[j * 3072 + 2048 + h * 128 + c0 + e]; }
            unsigned xq[11], xk[11], xv[11];
#pragma unroll
            for (int i = 0; i < 11; ++i) { const int rr = r0 - 3 + i;
                if (c == 0 && rr < 48) { xq[i] = 0u; xk[i] = 0u; xv[i] = 0u; }
                else if (rr >= 0) { xq[i] = *(const unsigned*)(QB + blk + rr * 128 + c0); xk[i] = *(const unsigned*)(KB + blk + rr * 128 + c0); xv[i] = *(const unsigned*)(VB + blk + rr * 128 + c0); }
                else if (prev_cb >= 0) { const bf16_t* hp = HALO + ((size_t)prev_cb * 3 + (rr + 3)) * 3072 + h * 128 + c0; xq[i] = *(const unsigned*)hp; xk[i] = *(const unsigned*)(hp + 1024); xv[i] = *(const unsigned*)(hp + 2048); }
                else { xq[i] = 0u; xk[i] = 0u; xv[i] = 0u; } }
        if (wid == 0) {
            const int row = cb * 64 + lane;
            const float braw = BA[(size_t)row * 16 + h], araw = BA[(size_t)row * 16 + 8 + h];
            float beta = 1.0f / (1.0f + expf(-braw));
            const float xx = araw + p.dt_bias[layer * 8 + h]; const float sp = fmaxf(xx, 0.f) + __logf(1.0f + __expf(-fabsf(xx)));
            float g = -expf(p.a_log[layer * 8 + h]) * sp;
            if (c == 0 && lane < 48) { g = 0.f; beta = 0.f; }
            float G = g;
#pragma unroll
            for (int off = 1; off < 64; off <<= 1) { const float t = __builtin_bit_cast(float, __builtin_amdgcn_ds_bpermute(((lane - off) & 63) << 2, __builtin_bit_cast(int, G))); if (lane >= off) G += t; }
            const float Gl = __builtin_bit_cast(float, __builtin_amdgcn_readlane(__builtin_bit_cast(int, G), 63));
            sc[lane] = beta; sc[64 + lane] = G; sc[128 + lane] = expf(G); sc[192 + lane] = expf(Gl - G);
            if (lane == 63) st_wt4(GT + (size_t)item * 32, expf(G));
        }
        __syncthreads();
        {
            float cq[8][2], ck[8][2], cv[8][2], sq[8], sk[8];
#pragma unroll
            for (int i = 0; i < 8; ++i) {
                float cq0 = 0.f, cq1 = 0.f, ck0 = 0.f, ck1 = 0.f, cv0 = 0.f, cv1 = 0.f;
#pragma unroll
                for (int j = 0; j < 4; ++j) { cq0 += wq[j][0] * bflo(xq[i + j]); cq1 += wq[j][1] * bfhi(xq[i + j]); ck0 += wk[j][0] * bflo(xk[i + j]); ck1 += wk[j][1] * bfhi(xk[i + j]);
                    cv0 += wv[j][0] * bflo(xv[i + j]); cv1 += wv[j][1] * bfhi(xv[i + j]); }
                cq[i][0] = silu(cq0); cq[i][1] = silu(cq1); ck[i][0] = silu(ck0); ck[i][1] = silu(ck1); cv[i][0] = silu(cv0); cv[i][1] = silu(cv1);
                sq[i] = cq[i][0] * cq[i][0] + cq[i][1] * cq[i][1]; sk[i] = ck[i][0] * ck[i][0] + ck[i][1] * ck[i][1];
            }
#pragma unroll
            for (int off = 32; off >= 1; off >>= 1) { float tq[8], tk[8];
#pragma unroll
                for (int i = 0; i < 8; ++i) { tq[i] = shxl(sq[i], off, lane); tk[i] = shxl(sk[i], off, lane); }
#pragma unroll
                for (int i = 0; i < 8; ++i) { sq[i] += tq[i]; sk[i] += tk[i]; } }
#pragma unroll
            for (int i = 0; i < 8; ++i) {
                const int r = r0 + i;
                const float rq = rsqrtf(sq[i] + 1e-6f), rk = rsqrtf(sk[i] + 1e-6f);
                const float cq0 = cq[i][0] * rq, cq1 = cq[i][1] * rq, ck0 = ck[i][0] * rk, ck1 = ck[i][1] * rk, cv0 = cv[i][0], cv1 = cv[i][1];
                const float beta = sc[r], eg = sc[128 + r];
                *(unsigned*)(qs + r * 136 + c0) = pk2(cq0, cq1); *(unsigned*)(ks + r * 136 + c0) = pk2(ck0, ck1);
                vbT[(c0 + 0) * 72 + r] = f2bf(cv0 * beta); vbT[(c0 + 1) * 72 + r] = f2bf(cv1 * beta);
                kgT[(c0 + 0) * 72 + r] = f2bf(ck0 * beta * eg); kgT[(c0 + 1) * 72 + r] = f2bf(ck1 * beta * eg);
            }
        }
        __syncthreads();
        { int lz = lane; asm volatile("" : "+v"(lz)); q4 = lz >> 4; l16 = lz & 15; }
        if (wid < 4) {
            const int mt = wid; bf16x8 a[4];
#pragma unroll
            for (int kb = 0; kb < 4; ++kb) a[kb] = *(const bf16x8*)(ks + (16 * mt + l16) * 136 + 32 * kb + 8 * q4);
            for (int nt = 0; nt <= mt; ++nt) {
                f32x4 d = {0.f, 0.f, 0.f, 0.f};
#pragma unroll
                for (int kb = 0; kb < 4; ++kb) d = mfma16(a[kb], *(const bf16x8*)(ks + (16 * nt + l16) * 136 + 32 * kb + 8 * q4), d);
                const int j_ = 16 * nt + l16; const float Gj = sc[64 + j_];
#pragma unroll
                for (int i = 0; i < 4; ++i) { const int i_ = 16 * mt + 4 * q4 + i; Lm[i_ * 68 + j_] = (i_ > j_) ? sc[i_] * d[i] * expf(sc[64 + i_] - Gj) : 0.f; }
            }
            for (int nt = mt + 1; nt < 4; ++nt) {
#pragma unroll
                for (int i = 0; i < 4; ++i) Lm[(16 * mt + 4 * q4 + i) * 68 + 16 * nt + l16] = 0.f; }
        } else {
            const int nti = wid - 4; bf16x8 bq[4]; f32x4 d[4];
#pragma unroll
            for (int kb = 0; kb < 4; ++kb) bq[kb] = *(const bf16x8*)(qs + (16 * nti + l16) * 136 + 32 * kb + 8 * q4);
            const int i_ = 16 * nti + l16; const float Gi = sc[64 + i_];
#pragma unroll
            for (int mtj = 0; mtj < 4; ++mtj) {
                f32x4 t = {0.f, 0.f, 0.f, 0.f};
                if (mtj <= nti) {
#pragma unroll
                    for (int kb = 0; kb < 4; ++kb) t = mfma16(*(const bf16x8*)(ks + (16 * mtj + l16) * 136 + 32 * kb + 8 * q4), bq[kb], t);
#pragma unroll
                    for (int i = 0; i < 4; ++i) { const int j_ = 16 * mtj + 4 * q4 + i; t[i] = (i_ >= j_) ? t[i] * SCALE * expf(Gi - sc[64 + j_]) : 0.f; }
                }
                d[mtj] = t;
            }
            st_wt16(QKB + (size_t)item * 4096 + ((nti * 2 + 0) * 64 + lane) * 8, __builtin_bit_cast(u32x4, pack8(d[0], d[1])));
            st_wt16(QKB + (size_t)item * 4096 + ((nti * 2 + 1) * 64 + lane) * 8, __builtin_bit_cast(u32x4, pack8(d[2], d[3])));
        }
        __syncthreads();
        if (wid < 4) {
            int vz; asm volatile("v_mov_b32 %0, 0" : "=v"(vz));
            const int lz = lane + vz, jcol = 16 * wid + (lz >> 2), part = lz & 3;
            const float* Lv = Lm + vz + 4 * part;
            float tq[4][4];
#pragma unroll
            for (int a = 0; a < 4; ++a)
#pragma unroll
                for (int e = 0; e < 4; ++e) tq[a][e] = 0.f;
#pragma unroll
            for (int i = 0; i < 64; ++i) {
                float a = 0.f;
#pragma unroll
                for (int kq = 0; kq * 16 < i; ++kq) { const float4 l = *(const float4*)(Lv + i * 68 + 16 * kq); a += (l.x * tq[kq][0] + l.y * tq[kq][1]) + (l.z * tq[kq][2] + l.w * tq[kq][3]); }
                a += __builtin_bit_cast(float, __builtin_amdgcn_update_dpp(0, __builtin_bit_cast(int, a), 0xB1, 0xf, 0xf, true));
                a += __builtin_bit_cast(float, __builtin_amdgcn_update_dpp(0, __builtin_bit_cast(int, a), 0x4E, 0xf, 0xf, true));
                const float ti = ((i == jcol) ? 1.f : 0.f) - a;
                tq[i >> 4][i & 3] = (part == ((i >> 2) & 3)) ? ti : tq[i >> 4][i & 3];
            }
#pragma unroll
            for (int kq = 0; kq < 4; ++kq)
#pragma unroll
                for (int e = 0; e < 4; ++e) Tb[(16 * kq + 4 * part + e) * 72 + jcol] = f2bf(tq[kq][e]);
        } else {
            { int lz = lane; asm volatile("" : "+v"(lz)); q4 = lz >> 4; l16 = lz & 15; }
            for (int f = wid - 4; f < 32; f += 4) {
                if (f < 16) {
                    const int mt = f >> 2, kb = f & 3, row = 16 * mt + l16; const float s = SCALE * sc[128 + row];
                    const u32x2 lo = *(const u32x2*)(qs + row * 136 + 32 * kb + 4 * q4), hi = *(const u32x2*)(qs + row * 136 + 32 * kb + 16 + 4 * q4);
                    u32x4 w; w.x = pk2(bflo(lo.x) * s, bfhi(lo.x) * s); w.y = pk2(bflo(lo.y) * s, bfhi(lo.y) * s); w.z = pk2(bflo(hi.x) * s, bfhi(hi.x) * s); w.w = pk2(bflo(hi.y) * s, bfhi(hi.y) * s);
                    st_wt16(QB + blk + (f * 64 + lane) * 8, w);
                } else {
                    const int ff = f - 16, mtd = ff >> 1, kb2 = ff & 1, dk = 16 * mtd + l16; float v[8];
#pragma unroll
                    for (int j = 0; j < 8; ++j) { const int tok = 32 * kb2 + 16 * (j >> 2) + 4 * q4 + (j & 3); v[j] = bf2f(ks[tok * 136 + dk]) * sc[192 + tok]; }
                    u32x4 w; w.x = pk2(v[0], v[1]); w.y = pk2(v[2], v[3]); w.z = pk2(v[4], v[5]); w.w = pk2(v[6], v[7]);
                    st_wt16(KTB + blk + (ff * 64 + lane) * 8, w);
                }
            }
        }
        __syncthreads();
        { int lz = lane; asm volatile("" : "+v"(lz)); q4 = lz >> 4; l16 = lz & 15; }
        {
            const int nt = wid; bf16x8 bv[2]; f32x4 d[4];
#pragma unroll
            for (int kb2 = 0; kb2 < 2; ++kb2) bv[kb2] = *(const bf16x8*)(vbT + (16 * nt + l16) * 72 + 32 * kb2 + 8 * q4);
#pragma unroll
            for (int mt = 0; mt < 4; ++mt) { f32x4 t = {0.f, 0.f, 0.f, 0.f};
#pragma unroll
                for (int kb2 = 0; kb2 < 2; ++kb2) t = mfma16(*(const bf16x8*)(Tb + (16 * mt + l16) * 72 + 32 * kb2 + 8 * q4), bv[kb2], t);
                d[mt] = t; }
            st_wt16(VB + blk + nt * 1024 + lane * 16, __builtin_bit_cast(u32x4, pack8(d[0], d[1])));
            st_wt16(VB + blk + nt * 1024 + lane * 16 + 8, __builtin_bit_cast(u32x4, pack8(d[2], d[3])));
        }
        {
            const int mtt = wid & 3, half = wid >> 2; bf16x8 bt[2]; f32x4 d[4];
#pragma unroll
            for (int kb2 = 0; kb2 < 2; ++kb2) bt[kb2] = *(const bf16x8*)(Tb + (16 * mtt + l16) * 72 + 32 * kb2 + 8 * q4);
#pragma unroll
            for (int m4 = 0; m4 < 4; ++m4) { const int mtd = 4 * half + m4; f32x4 t = {0.f, 0.f, 0.f, 0.f};
#pragma unroll
                for (int kb2 = 0; kb2 < 2; ++kb2) t = mfma16(*(const bf16x8*)(kgT + (16 * mtd + l16) * 72 + 32 * kb2 + 8 * q4), bt[kb2], t);
                d[m4] = t; }
            st_wt16(WB + blk + ((mtt * 4 + 2 * half + 0) * 64 + lane) * 8, __builtin_bit_cast(u32x4, pack8(d[0], d[1])));
            st_wt16(WB + blk + ((mtt * 4 + 2 * half + 1) * 64 + lane) * 8, __builtin_bit_cast(u32x4, pack8(d[2], d[3])));
        }
        asm volatile("s_waitcnt vmcnt(0)" ::: "memory");
        __syncthreads();
        if (tid == 0) { const int g_ = b * 8 + h, sb0_ = (g_ & 7) + 16 * (g_ >> 3);
            if (XT[sb0_] != myx || XT[sb0_ + 8] != myx) { __builtin_amdgcn_fence(__ATOMIC_RELEASE, "agent"); asm volatile("s_waitcnt vmcnt(0)" ::: "memory"); }
            __hip_atomic_store(flags + item, 1u, __ATOMIC_RELAXED, __HIP_MEMORY_SCOPE_AGENT); }
    }
}

template <bool MIDBAR> DI void scan_step(const unsigned char* buf, const unsigned char* ubuf, const float gt, f32x4 (&S)[8], bf16_t* op, int ostride, int lane) {
    const bf16x8* Wf = (const bf16x8*)(buf) + lane; const bf16x8* Qf = (const bf16x8*)(buf + 16384) + lane;
    const bf16x8* Kf = (const bf16x8*)(buf + 32768) + lane; const bf16x8* Pf = (const bf16x8*)(buf + 49152) + lane;
#define SC_SB() __builtin_amdgcn_sched_barrier(0)
    bf16x8 fa[16], fb[16], Sb[4], Vb[2]; f32x4 vn[4], o[4];
#pragma unroll
    for (int f = 0; f < 16; ++f) fa[f] = Wf[f * 64];
#pragma unroll
    for (int kb = 0; kb < 4; ++kb) Sb[kb] = pack8(S[2 * kb], S[2 * kb + 1]);
    SC_SB();
#pragma unroll
    for (int f = 0; f < 16; ++f) fb[f] = Qf[f * 64];
    SC_SB();
    if (MIDBAR) { asm volatile("s_waitcnt lgkmcnt(0)" ::: "memory"); __builtin_amdgcn_s_barrier(); asm volatile("" ::: "memory"); SC_SB(); }
    const u32x4 u0 = *(const u32x4*)(ubuf + lane * 32), u1 = *(const u32x4*)(ubuf + lane * 32 + 16);
    const unsigned uw[8] = {u0.x, u0.y, u0.z, u0.w, u1.x, u1.y, u1.z, u1.w};
#pragma unroll
    for (int mt = 0; mt < 4; ++mt) { f32x4 a = {0.f, 0.f, 0.f, 0.f};
#pragma unroll
        for (int kb = 0; kb < 4; ++kb) a = mfma16(fa[mt * 4 + kb], Sb[kb], a);
        vn[mt][0] = bflo(uw[2 * mt]) - a[0]; vn[mt][1] = bfhi(uw[2 * mt]) - a[1]; vn[mt][2] = bflo(uw[2 * mt + 1]) - a[2]; vn[mt][3] = bfhi(uw[2 * mt + 1]) - a[3]; }
    SC_SB();
#pragma unroll
    for (int f = 0; f < 8; ++f) fa[f] = Pf[f * 64];
#pragma unroll
    for (int f = 0; f < 8; ++f) fa[8 + f] = Kf[f * 64];
    Vb[0] = pack8(vn[0], vn[1]); Vb[1] = pack8(vn[2], vn[3]);
    SC_SB();
#pragma unroll
    for (int mt = 0; mt < 4; ++mt) { f32x4 a = {0.f, 0.f, 0.f, 0.f};
#pragma unroll
        for (int kb = 0; kb < 4; ++kb) a = mfma16(fb[mt * 4 + kb], Sb[kb], a);
        o[mt] = a; }
    SC_SB();
#pragma unroll
    for (int f = 0; f < 8; ++f) fb[f] = Kf[(8 + f) * 64];
    SC_SB();
#pragma unroll
    for (int mt = 0; mt < 4; ++mt) { f32x4 a = o[mt];
#pragma unroll
        for (int kb2 = 0; kb2 < 2; ++kb2) a = mfma16(fa[mt * 2 + kb2], Vb[kb2], a);
        o[mt] = a; }
#pragma unroll
    for (int mtd = 0; mtd < 4; ++mtd) { f32x4 a = S[mtd] * gt;
#pragma unroll
        for (int kb2 = 0; kb2 < 2; ++kb2) a = mfma16(fa[8 + mtd * 2 + kb2], Vb[kb2], a);
        S[mtd] = a; }
    SC_SB();
#pragma unroll
    for (int mtd = 4; mtd < 8; ++mtd) { f32x4 a = S[mtd] * gt;
#pragma unroll
        for (int kb2 = 0; kb2 < 2; ++kb2) a = mfma16(fb[(mtd - 4) * 2 + kb2], Vb[kb2], a);
        S[mtd] = a; }
    { const bool odd = lane & 1; bf16_t* ob = op - (odd ? 1 : 0) + (size_t)(odd ? 2 : 0) * ostride;
#pragma unroll
      for (int mt = 0; mt < 4; ++mt) {
          const float s0 = odd ? o[mt][0] : o[mt][2], s1 = odd ? o[mt][1] : o[mt][3], m0 = odd ? o[mt][2] : o[mt][0], m1 = odd ? o[mt][3] : o[mt][1];
          const float r0 = __builtin_bit_cast(float, __builtin_amdgcn_update_dpp(0, __builtin_bit_cast(int, s0), 0xB1, 0xf, 0xf, true));
          const float r1 = __builtin_bit_cast(float, __builtin_amdgcn_update_dpp(0, __builtin_bit_cast(int, s1), 0xB1, 0xf, 0xf, true));
          *(unsigned*)(ob + (size_t)(16 * mt) * ostride) = odd ? pk2(r0, m0) : pk2(m0, r0);
          *(unsigned*)(ob + (size_t)(16 * mt + 1) * ostride) = odd ? pk2(r1, m1) : pk2(m1, r1); } }
#undef SC_SB
}
#define SC_BAR() do { asm volatile("s_waitcnt lgkmcnt(0)" ::: "memory"); __builtin_amdgcn_s_barrier(); asm volatile("" ::: "memory"); } while (0)
DI void phase_scan(const Params& p, int layer, unsigned char* smem) {
    if (blockIdx.x >= 128) return;
    const int tid = opaque_tid(p), lane = tid & 63, wid = __builtin_amdgcn_readfirstlane(tid >> 6), q4 = lane >> 4, l16 = lane & 15;
    const int bx = blockIdx.x & 7, by = blockIdx.x >> 3, nt = by & 7, g = bx + 8 * (by >> 3), b = g >> 3, h = g & 7;
    constexpr int BUFB = 59904;
#define SC_CB(c) (((c) == 0) ? 256 + b : 128 * b + (c) - 1)
    if (wid != 0) {
        const int r = wid - 1, rr = r >> 1, slot = 3 * (rr == 0) + 4 * (rr == 2) + 5 * (rr == 3), isq = (rr == 3);
        const unsigned char* sb = p.ws + WS_QB + (size_t)slot * SZ_ACT + (size_t)(r & 1) * 8192 + lane * 16;
        const unsigned char* ub = p.ws + WS_VB + nt * 2048 + lane * 32; const float* GT = (const float*)(p.ws + WS_GT);
        const size_t istride = (size_t)16384 >> isq;
        unsigned char* d0 = smem + r * 8192 + lane * 16; unsigned char* d1 = d0 + BUFB;
        unsigned char* e0 = smem + 57344 + lane * 32; unsigned char* e1 = e0 + BUFB;
        u32x4 ra[8], rb[8], rc[8], rd[8]; u32x4 xa[2], xb[2], xc[2], xd[2]; float ga = 0.f, gb = 0.f, gc = 0.f, gd = 0.f;
#define SC_LOAD(dst, xd_, gd_, c) do { const int cc_ = (c) < 129 ? (c) : 128; const int it_ = SC_CB(cc_) * 8 + h; const unsigned char* s_ = sb + (size_t)it_ * istride; \
        _Pragma("unroll") for (int i_ = 0; i_ < 8; ++i_) dst[i_] = *(const u32x4*)(s_ + i_ * 1024); \
        if (r == 6) { const unsigned char* us_ = ub + (size_t)it_ * 16384; xd_[0] = *(const u32x4*)us_; xd_[1] = *(const u32x4*)(us_ + 16); gd_ = GT[(size_t)it_ * 32]; } } while (0)
#define SC_WRITE(dptr, eptr, src, xs_, gs_) do { _Pragma("unroll") for (int i_ = 0; i_ < 8; ++i_) *(u32x4*)((dptr) + i_ * 1024) = src[i_]; \
        if (r == 6) { *(u32x4*)(eptr) = xs_[0]; *(u32x4*)((eptr) + 16) = xs_[1]; if (lane == 0) *(float*)((eptr) + 2048) = gs_; } } while (0)
        SC_LOAD(ra, xa, ga, 0); SC_WRITE(d0, e0, ra, xa, ga); SC_LOAD(ra, xa, ga, 1); SC_LOAD(rb, xb, gb, 2); SC_LOAD(rc, xc, gc, 3); SC_LOAD(rd, xd, gd, 4);
        SC_BAR();
        for (int c = 0; c < 128; c += 4) {
            SC_WRITE(d1, e1, ra, xa, ga); SC_LOAD(ra, xa, ga, c + 5); SC_BAR();
            SC_WRITE(d0, e0, rb, xb, gb); SC_LOAD(rb, xb, gb, c + 6); SC_BAR();
            SC_WRITE(d1, e1, rc, xc, gc); SC_LOAD(rc, xc, gc, c + 7); SC_BAR();
            SC_WRITE(d0, e0, rd, xd, gd); SC_LOAD(rd, xd, gd, c + 8); SC_BAR();
        }
        SC_BAR();
    } else {
        __builtin_amdgcn_s_setprio(3);
        bf16_t* OB = (bf16_t*)(p.ws + WS_KTB) + (size_t)(4 * q4) * 128 + 16 * nt + l16;
        f32x4 S[8];
#pragma unroll
        for (int i = 0; i < 8; ++i) S[i] = (f32x4){0.f, 0.f, 0.f, 0.f};
        SC_BAR();
        for (int c = 0; c < 128; c += 2) {
            scan_step<false>(smem, smem + 57344, *(const float*)(smem + 57344 + 2048), S, OB + (size_t)(SC_CB(c) * 8 + h) * 8192, 128, lane); SC_BAR();
            scan_step<false>(smem + BUFB, smem + BUFB + 57344, *(const float*)(smem + BUFB + 57344 + 2048), S, OB + (size_t)(SC_CB(c + 1) * 8 + h) * 8192, 128, lane); SC_BAR();
        }
        scan_step<false>(smem, smem + 57344, *(const float*)(smem + 57344 + 2048), S, OB + (size_t)(SC_CB(128) * 8 + h) * 8192, 128, lane);
        SC_BAR();
        __builtin_amdgcn_s_setprio(0);
    }
#undef SC_LOAD
#undef SC_WRITE
#undef SC_CB
}

DI void phase_scan2(const Params& p, int layer, unsigned char* smem) {
    const int tid = opaque_tid(p), lane = tid & 63, wid = __builtin_amdgcn_readfirstlane(tid >> 6), q4 = lane >> 4, l16 = lane & 15;
    const int sb = blockIdx.x, g = (sb & 7) + 8 * (sb >> 4), half = (sb >> 3) & 1, b = g >> 3, h = g & 7, nt = 4 * half + (wid & 3);
    PG8_LAS unsigned char* lds = (PG8_LAS unsigned char*)smem;
    unsigned* flags = (unsigned*)(p.ws + WS_FLAG) + layer * 2080; const float* GT = (const float*)(p.ws + WS_GT);
    float* gtl = (float*)(smem + 131072 + 16);
#define S2_ITEM(c) ((((c) == 0) ? 256 + b : 128 * b + (c) - 1) * 8 + h)
#define S2_POLL(c) do { const unsigned* f_ = flags + S2_ITEM(c); while (__builtin_amdgcn_readfirstlane(__hip_atomic_load(f_, __ATOMIC_RELAXED, __HIP_MEMORY_SCOPE_AGENT)) == 0u) __builtin_amdgcn_s_sleep(2); } while (0)
#define S2_ISSUE(c, bi) do { const int it_ = S2_ITEM(c), k_ = wid - 4; \
        _Pragma("unroll") for (int i_ = 0; i_ < 14; ++i_) { const int pc_ = k_ * 14 + i_, r_ = pc_ >> 4, slot_ = 3 * (r_ == 0) + 4 * (r_ == 2) + 5 * (r_ == 3); \
            const unsigned char* s_ = p.ws + WS_QB + (size_t)slot_ * SZ_ACT + (size_t)it_ * ((size_t)16384 >> (r_ == 3)) + (size_t)(pc_ & 15) * 1024 + lane * 16; \
            __builtin_amdgcn_global_load_lds((const unsigned*)s_, (PG8_LAS unsigned*)(lds + (bi) * 65536 + pc_ * 1024), 16, 0, 0); } \
        _Pragma("unroll") for (int i_ = 0; i_ < 2; ++i_) { const unsigned char* s_ = p.ws + WS_VB + (size_t)it_ * 16384 + (size_t)(4 * half + k_) * 2048 + i_ * 1024 + lane * 16; \
            __builtin_amdgcn_global_load_lds((const unsigned*)s_, (PG8_LAS unsigned*)(lds + (bi) * 65536 + 57344 + k_ * 2048 + i_ * 1024), 16, 0, 0); } } while (0)
    if (wid >= 4) {
        const int k = wid - 4;
#define S2_POLL8(base) do { if (k == 0) { const int ch_ = (base) + (lane & 7), chc_ = ch_ < 129 ? ch_ : 128; const unsigned* f_ = flags + S2_ITEM(chc_); \
        for (unsigned sp_ = 0; sp_ < (1u << 22); ++sp_) { const unsigned v_ = __hip_atomic_load(f_, __ATOMIC_RELAXED, __HIP_MEMORY_SCOPE_AGENT); if (__builtin_amdgcn_ballot_w64(v_ == 0u) == 0ull) break; __builtin_amdgcn_s_sleep(2); } \
        __builtin_amdgcn_fence(__ATOMIC_ACQUIRE, "agent"); } } while (0)
#define S2_PIECE(it_, pc_, bi) do { const int r_ = (pc_) >> 4, slot_ = 3 * (r_ == 0) + 4 * (r_ == 2) + 5 * (r_ == 3); \
        const unsigned char* s_ = p.ws + WS_QB + (size_t)slot_ * SZ_ACT + (size_t)(it_) * ((size_t)16384 >> (r_ == 3)) + (size_t)((pc_) & 15) * 1024 + lane * 16; \
        __builtin_amdgcn_global_load_lds((const unsigned*)s_, (PG8_LAS unsigned*)(lds + (bi) * 65536 + (pc_) * 1024), 16, 0, 0); } while (0)
#define S2_ISSUE_A(c, bi) do { const int it_ = S2_ITEM(c); _Pragma("unroll") for (int i_ = 0; i_ < 8; ++i_) S2_PIECE(it_, 8 * k + i_, bi); } while (0)
#define S2_ISSUE_B(c, bi) do { const int it_ = S2_ITEM(c); _Pragma("unroll") for (int i_ = 0; i_ < 6; ++i_) S2_PIECE(it_, 32 + 6 * k + i_, bi); \
        _Pragma("unroll") for (int i_ = 0; i_ < 2; ++i_) { const unsigned char* s_ = p.ws + WS_VB + (size_t)it_ * 16384 + (size_t)(4 * half + k) * 2048 + i_ * 1024 + lane * 16; \
            __builtin_amdgcn_global_load_lds((const unsigned*)s_, (PG8_LAS unsigned*)(lds + (bi) * 65536 + 57344 + k * 2048 + i_ * 1024), 16, 0, 0); } } while (0)
#define S2_RAWBAR() do { asm volatile("" ::: "memory"); __builtin_amdgcn_s_barrier(); asm volatile("" ::: "memory"); } while (0)
        S2_POLL8(0);
        asm volatile("s_waitcnt vmcnt(0)" ::: "memory");
        SC_BAR();
        S2_ISSUE_A(0, 0); S2_ISSUE_B(0, 0);
        if (k == 0) { const float g0 = GT[(size_t)S2_ITEM(0) * 32]; if (lane == 0) gtl[0] = g0; }
        asm volatile("s_waitcnt vmcnt(0)" ::: "memory");
        S2_ISSUE_A(1, 1);
        SC_BAR();
        for (int c = 0; c < 129; ++c) {
            float gn = 0.f;
            if (c + 1 < 129) { if (k == 0) gn = GT[(size_t)S2_ITEM(c + 1) * 32]; S2_ISSUE_B(c + 1, (c + 1) & 1); }
            S2_RAWBAR();
            if ((c & 7) == 0) S2_POLL8(c + 3);
            if (c + 2 < 129) { S2_ISSUE_A(c + 2, c & 1); asm volatile("s_waitcnt vmcnt(8)" ::: "memory"); }
            else asm volatile("s_waitcnt vmcnt(0)" ::: "memory");
            if (k == 0 && lane == 0 && c + 1 < 129) gtl[(c + 1) & 1] = gn;
            SC_BAR();
        }
#undef S2_PIECE
#undef S2_ISSUE_A
#undef S2_ISSUE_B
#undef S2_RAWBAR
    } else {
        __builtin_amdgcn_s_setprio(3);
        bf16_t* OB = (bf16_t*)(p.ws + WS_KTB) + (size_t)(4 * q4) * 128 + 16 * nt + l16;
        f32x4 S[8];
#pragma unroll
        for (int i = 0; i < 8; ++i) S[i] = (f32x4){0.f, 0.f, 0.f, 0.f};
        SC_BAR();
        SC_BAR();
        for (int c = 0; c < 129; ++c) {
            const unsigned char* buf = smem + (c & 1) * 65536;
            scan_step<true>(buf, buf + 57344 + (wid & 3) * 2048, gtl[c & 1], S, OB + (size_t)(((((c) == 0) ? 256 + b : 128 * b + (c) - 1) * 8 + h)) * 8192, 128, lane);
            SC_BAR();
        }
        __builtin_amdgcn_s_setprio(0);
    }
#undef S2_ITEM
#undef S2_POLL
#undef S2_ISSUE
}

DI void phase_combine(const Params& p, int layer, unsigned char* smem) {
    const int tid0 = opaque_tid(p);
    bf16_t* pl = (bf16_t*)smem;
    float* rs = (float*)(smem + 66560);
    const bf16_t* OB = (const bf16_t*)(p.ws + WS_KTB); const bf16_t* ZB = (const bf16_t*)(p.ws + WS_QB);     const bf16_t* GA = (const bf16_t*)(p.ws + WS_VB); const bf16_t* GB = (const bf16_t*)(p.ws + WS_WB);
    const bf16_t* PB = (const bf16_t*)(p.ws + WS_QKB); bf16_t* YB = (bf16_t*)(p.ws + WS_KB); const bf16_t* WPT = (const bf16_t*)(p.ws + WS_WPT);
    const float* hn = p.head_norm + layer * 128; const float* psc = p.pool_scale + layer * 1024;
    for (int cb = blockIdx.x; cb < 260; cb += gridDim.x) {
        int tid = tid0; asm volatile("" : "+v"(tid));
        const int lane = tid & 63, wid = tid >> 6, q4 = lane >> 4, l16 = lane & 15;
        if (cb >= 258) { const u32x4 z = {0u, 0u, 0u, 0u};
            for (int e = tid; e < 64 * 128; e += 512) *(u32x4*)(YB + (size_t)cb * 65536 + e * 8) = z;
            continue; }
        const bool meta = cb >= 256; const int b = meta ? cb - 256 : (cb >> 7);
#pragma unroll
        for (int rr = 0; rr < 8; ++rr) { const int t = 8 * wid + rr; if (meta && t < 48) continue;     const bf16_t* op = OB + ((size_t)(cb * 8 + (lane >> 3)) * 64 + t) * 128 + (lane & 7) * 16;
            const u32x4 a = *(const u32x4*)op, c = *(const u32x4*)(op + 8);
            float ss = bflo(a.x) * bflo(a.x) + bfhi(a.x) * bfhi(a.x) + bflo(a.y) * bflo(a.y) + bfhi(a.y) * bfhi(a.y) + bflo(a.z) * bflo(a.z) + bfhi(a.z) * bfhi(a.z) + bflo(a.w) * bflo(a.w) + bfhi(a.w) * bfhi(a.w)
                     + bflo(c.x) * bflo(c.x) + bfhi(c.x) * bfhi(c.x) + bflo(c.y) * bflo(c.y) + bfhi(c.y) * bfhi(c.y) + bflo(c.z) * bflo(c.z) + bfhi(c.z) * bfhi(c.z) + bflo(c.w) * bflo(c.w) + bfhi(c.w) * bfhi(c.w);
            ss += shxl(ss, 1, lane); ss += shxl(ss, 2, lane); ss += shxl(ss, 4, lane);
            if ((lane & 7) == 0) rs[t * 8 + (lane >> 3)] = rsqrtf(ss * (1.0f / 128.0f) + 1e-6f); }
        { const int t = tid >> 3, row0 = cb * 64 + t, pt = t - 48;
#pragma unroll
          for (int it = 0; it < 8; ++it) { const int g = it & 3, c8 = (tid & 7) + 8 * (it >> 2), win = 2 << g;
            int row = row0; asm volatile("" : "+v"(row));
            const int im = row - 8192 * b;
            u32x4 v[16];
#pragma unroll
            for (int d = 0; d < 16; ++d) if (d < win) {
                const bool ok = meta ? (d <= pt) : true; int pr; if (meta || im - d >= 0) pr = row - d; else pr = MMAIN + 64 * b + 64 + (im - d);
                v[d] = ok ? *(const u32x4*)(PB + (size_t)pr * 512 + g * 128 + c8 * 8) : (u32x4){0u, 0u, 0u, 0u}; }
            float acc[8];
#pragma unroll
            for (int j = 0; j < 8; ++j) acc[j] = 0.f;
#pragma unroll
            for (int d = 0; d < 16; ++d) if (d < win) { acc[0] += bflo(v[d].x); acc[1] += bfhi(v[d].x); acc[2] += bflo(v[d].y); acc[3] += bfhi(v[d].y); acc[4] += bflo(v[d].z); acc[5] += bfhi(v[d].z); acc[6] += bflo(v[d].w); acc[7] += bfhi(v[d].w); }
            int cnt = win; if (meta) { cnt = pt + 1 < win ? pt + 1 : win; if (cnt < 1) cnt = 1; }
            const float inv = 1.0f / (float)cnt; u32x4 w;
            w.x = pk2(acc[0] * inv - bflo(v[0].x), acc[1] * inv - bfhi(v[0].x)); w.y = pk2(acc[2] * inv - bflo(v[0].y), acc[3] * inv - bfhi(v[0].y));
            w.z = pk2(acc[4] * inv - bflo(v[0].z), acc[5] * inv - bfhi(v[0].z)); w.w = pk2(acc[6] * inv - bflo(v[0].w), acc[7] * inv - bfhi(v[0].w));
            *(u32x4*)(pl + t * 520 + g * 128 + c8 * 8) = w; asm volatile("" ::: "memory"); } }
        __syncthreads();
        { const int g = wid >> 1, colbase = 128 * wid; const bf16_t* wp = WPT + (size_t)g * 256 * 128 + (size_t)(colbase & 255) * 128;
#pragma unroll 1
          for (int j = 0; j < 4; ++j) { bf16x8 a0[4], a1[4];
              const int ca = 32 * j + 8 * (l16 >> 2) + (l16 & 3);
#pragma unroll
              for (int kb = 0; kb < 4; ++kb) { a0[kb] = *(const bf16x8*)(wp + ca * 128 + 32 * kb + 8 * q4); a1[kb] = *(const bf16x8*)(wp + (ca + 4) * 128 + 32 * kb + 8 * q4); }
              const int c0 = colbase + 32 * j + 8 * q4;
              const f32x4 hn0 = *(const f32x4*)(hn + (c0 & 127)), hn1 = *(const f32x4*)(hn + (c0 & 127) + 4), ps0 = *(const f32x4*)(psc + c0), ps1 = *(const f32x4*)(psc + c0 + 4);
              u32x4 o4[4], z4[4], a4[4], b4[4];
#pragma unroll
              for (int ntt = 0; ntt < 4; ++ntt) { if (meta && ntt < 3) continue; const int t = 16 * ntt + l16; const size_t off = (size_t)(cb * 64 + t) * 1024 + c0;
                  if (!(meta && t < 48)) { o4[ntt] = *(const u32x4*)(OB + ((size_t)(cb * 8 + wid) * 64 + t) * 128 + (c0 & 127)); z4[ntt] = *(const u32x4*)(ZB + off); a4[ntt] = *(const u32x4*)(GA + off); b4[ntt] = *(const u32x4*)(GB + off); }
                  else { o4[ntt] = (u32x4){0u, 0u, 0u, 0u}; z4[ntt] = o4[ntt]; a4[ntt] = o4[ntt]; b4[ntt] = o4[ntt]; } }
#pragma unroll
              for (int ntt = 0; ntt < 4; ++ntt) { if (meta && ntt < 3) continue;     f32x4 d0 = {0.f, 0.f, 0.f, 0.f}, d1 = {0.f, 0.f, 0.f, 0.f};
#pragma unroll
                  for (int kb = 0; kb < 4; ++kb) { const bf16x8 bb = *(const bf16x8*)(pl + (16 * ntt + l16) * 520 + g * 128 + 32 * kb + 8 * q4); d0 = mfma16(a0[kb], bb, d0); d1 = mfma16(a1[kb], bb, d1); }
                  const int t = 16 * ntt + l16; const size_t off = (size_t)(cb * 64 + t) * 1024 + c0; u32x4 yo = {0u, 0u, 0u, 0u};
                  if (!(meta && t < 48)) {
                      const float rq = rs[t * 8 + wid];
                      const unsigned ow[4] = {o4[ntt].x, o4[ntt].y, o4[ntt].z, o4[ntt].w}, zw[4] = {z4[ntt].x, z4[ntt].y, z4[ntt].z, z4[ntt].w};
                      const unsigned aw[4] = {a4[ntt].x, a4[ntt].y, a4[ntt].z, a4[ntt].w}, bw[4] = {b4[ntt].x, b4[ntt].y, b4[ntt].z, b4[ntt].w};
                      float y[8];
#pragma unroll
                      for (int e = 0; e < 8; ++e) { const float ov = (e & 1) ? bfhi(ow[e >> 1]) : bflo(ow[e >> 1]), zv = (e & 1) ? bfhi(zw[e >> 1]) : bflo(zw[e >> 1]);
                          const float av = (e & 1) ? bfhi(aw[e >> 1]) : bflo(aw[e >> 1]), bv = (e & 1) ? bfhi(bw[e >> 1]) : bflo(bw[e >> 1]);
                          const float hv = e < 4 ? hn0[e & 3] : hn1[e & 3], pv = e < 4 ? ps0[e & 3] : ps1[e & 3], dv = e < 4 ? d0[e & 3] : d1[e & 3];
                          y[e] = sigm(av) * (ov * rq * hv * silu(zv)) + sigm(bv) * (dv * pv); }
                      yo.x = pk2(y[0], y[1]); yo.y = pk2(y[2], y[3]); yo.z = pk2(y[4], y[5]); yo.w = pk2(y[6], y[7]); }
                  *(u32x4*)(YB + off) = yo; } } }
        __syncthreads();
    }
}

DI void phase_convact(const Params& p, int layer) {
    const int tid = opaque_tid(p);
    bf16_t* HID = (bf16_t*)(p.ws + WS_QB); const bf16_t* HALO = (const bf16_t*)(p.ws + WS_HALO);
    const float* cw = p.conv_ffn + (size_t)layer * 3 * FF2;
    if (tid >= 352) return;
    const int j0 = tid * 8;
    float wg[3][8], wv[3][8];
#pragma unroll
    for (int j = 0; j < 3; ++j)
#pragma unroll
        for (int e = 0; e < 8; ++e) { wg[j][e] = cw[j * FF2 + j0 + e]; wv[j][e] = cw[j * FF2 + DFF + j0 + e]; }
    for (int cb = blockIdx.x; cb < 258; cb += gridDim.x) {
        const bool meta = cb >= 256; const int prev = meta ? -1 : ((cb & 127) == 0 ? 256 + (cb >> 7) : cb - 1);
        float g1[8], g2[8], v1[8], v2[8];
        if (prev >= 0) { const bf16_t* hp = HALO + (size_t)prev * 2 * FF2;
            const u32x4 a = *(const u32x4*)(hp + j0), c = *(const u32x4*)(hp + DFF + j0), a1 = *(const u32x4*)(hp + FF2 + j0), c1 = *(const u32x4*)(hp + FF2 + DFF + j0);
            g2[0] = bflo(a.x); g2[1] = bfhi(a.x); g2[2] = bflo(a.y); g2[3] = bfhi(a.y); g2[4] = bflo(a.z); g2[5] = bfhi(a.z); g2[6] = bflo(a.w); g2[7] = bfhi(a.w);
            v2[0] = bflo(c.x); v2[1] = bfhi(c.x); v2[2] = bflo(c.y); v2[3] = bfhi(c.y); v2[4] = bflo(c.z); v2[5] = bfhi(c.z); v2[6] = bflo(c.w); v2[7] = bfhi(c.w);
            g1[0] = bflo(a1.x); g1[1] = bfhi(a1.x); g1[2] = bflo(a1.y); g1[3] = bfhi(a1.y); g1[4] = bflo(a1.z); g1[5] = bfhi(a1.z); g1[6] = bflo(a1.w); g1[7] = bfhi(a1.w);
            v1[0] = bflo(c1.x); v1[1] = bfhi(c1.x); v1[2] = bflo(c1.y); v1[3] = bfhi(c1.y); v1[4] = bflo(c1.z); v1[5] = bfhi(c1.z); v1[6] = bflo(c1.w); v1[7] = bfhi(c1.w);
        } else {
#pragma unroll
            for (int e = 0; e < 8; ++e) { g1[e] = 0.f; g2[e] = 0.f; v1[e] = 0.f; v2[e] = 0.f; } }
        for (int tb = meta ? 48 : 0; tb < 64; tb += 8) {
            u32x4 rg[8], rv[8];
#pragma unroll
            for (int i = 0; i < 8; ++i) { const bf16_t* hp = HID + (size_t)(cb * 64 + tb + i) * FF2 + j0; rg[i] = *(const u32x4*)hp; rv[i] = *(const u32x4*)(hp + DFF); }
#pragma unroll
            for (int i = 0; i < 8; ++i) {
                const float g0[8] = {bflo(rg[i].x), bfhi(rg[i].x), bflo(rg[i].y), bfhi(rg[i].y), bflo(rg[i].z), bfhi(rg[i].z), bflo(rg[i].w), bfhi(rg[i].w)};
                const float v0[8] = {bflo(rv[i].x), bfhi(rv[i].x), bflo(rv[i].y), bfhi(rv[i].y), bflo(rv[i].z), bfhi(rv[i].z), bflo(rv[i].w), bfhi(rv[i].w)};
                float a[8];
#pragma unroll
                for (int e = 0; e < 8; ++e) { const float cg = wg[0][e] * g2[e] + wg[1][e] * g1[e] + wg[2][e] * g0[e], cv = wv[0][e] * v2[e] + wv[1][e] * v1[e] + wv[2][e] * v0[e];
                    a[e] = silu(cg) * cv; g2[e] = g1[e]; g1[e] = g0[e]; v2[e] = v1[e]; v1[e] = v0[e]; }
                u32x4 w; w.x = pk2(a[0], a[1]); w.y = pk2(a[2], a[3]); w.z = pk2(a[4], a[5]); w.w = pk2(a[6], a[7]);
                *(u32x4*)(HID + (size_t)(cb * 64 + tb + i) * FF2 + j0) = w;
            }
        }
    }
}

__global__ void __launch_bounds__(512, 2) mega_fwd(Params p0) {
    extern __shared__ __attribute__((aligned(16))) unsigned char smem[];
    cg::grid_group grid = cg::this_grid();
    PG8_LAS unsigned char* lds = (PG8_LAS unsigned char*)smem;
    const int G = (int)gridDim.x, c = (int)blockIdx.x;
    Params p = p0; p.wid0 = __builtin_amdgcn_readfirstlane((int)threadIdx.x >> 6);
    const bool t0 = (threadIdx.x == 0);
    volatile LAS unsigned* xst = (volatile LAS unsigned*)(lds + 131072);
    if (threadIdx.x < 4) xst[threadIdx.x] = 0u;
    __syncthreads();
    const XcdBarrier xbar = xcd_barrier_post((unsigned*)(p0.ws + WS_BAR), xst, t0);
    if (blockIdx.x < 32 && threadIdx.x == 0) ((unsigned*)(p0.ws + WS_XT))[blockIdx.x] = xb_xcc_id();
    grid.sync();
#if TSA || TSB
    int tsk = 0;
#define TSTAMP() do { if (blockIdx.x == 0 && p.wid0 == 0 && lane_id_fresh() == 0) ((unsigned long long*)(p0.ws + WS_TS))[tsk] = __builtin_amdgcn_s_memrealtime(); ++tsk; } while (0)
#else
#define TSTAMP() do { } while (0)
#endif
    TSTAMP();
#define GSYNC() do { xcd_barrier(xbar, (p.wid0 == 0) && (lane_id_fresh() == 0)); TSTAMP(); } while (0)
#define FRESH() do { size_t z_ = 0; asm volatile("" : "+s"(z_)); p.ws = p0.ws + z_; p.out = p0.out + z_; } while (0)
#define WSP(off) ((bf16_t*)(p.ws + (off)))
#define GEMM_PLAIN 1 << 20, 256, 0
#pragma unroll 1
    for (int layer = 0; layer < 2; ++layer) {
        FRESH(); phase_norm(p, layer, 0, smem); GSYNC();
        FRESH();
        { pg8::Gemm g{WSP(WS_U), WSP(WS_WIN), MMAIN, 3072, 1024, 1024, 1024, GEMM_PLAIN}; pg8::StaticOrder S; S.init(MMAIN, 3072, G, c); EpiQKV E{WSP(WS_QB), WSP(WS_HALO)}; pg8::gemm_phase<EpiQKV, pg8::StaticOrder, true>(lds, g, S, E, opaque_tid(p));
          meta_gemm(smem, WSP(WS_U), 1024, WSP(WS_WIN), 1024, 1024, 192, MstQKV{WSP(WS_QB), WSP(WS_HALO)}, opaque_tid(p), G); }
        GSYNC();
        FRESH();
#if DIAG_SPLIT
        if (blockIdx.x >= 32) { phase_p3(p, layer, smem, (int)blockIdx.x - 32, G - 32); convert_weights(p, layer, smem, opaque_tid(p), 1664, 4064, (int)blockIdx.x - 32, G - 32); }
        GSYNC();
        FRESH();
#if DIAG_SPLIT == 2
        phase_scan(p, layer, smem);
#else
        if (blockIdx.x < 32) phase_scan2(p, layer, smem);
#endif
        GSYNC();
#else
        if (blockIdx.x < 32) phase_scan2(p, layer, smem);
        else { const int pblk = (int)blockIdx.x - 32, npb = G - 32, nheavy = 129 * 16 - (129 * 16 / npb) * npb;
            phase_p3(p, layer, smem, pblk, npb);
            if (npb == 224) { if (pblk >= nheavy) convert_weights(p, layer, smem, opaque_tid(p), 1664, 1664 + 2112, pblk - nheavy, npb - nheavy);
                              else convert_weights(p, layer, smem, opaque_tid(p), 1664 + 2112, 4064, pblk, nheavy); }
            else convert_weights(p, layer, smem, opaque_tid(p), 1664, 4064, pblk, npb); }
        GSYNC();
#endif
        FRESH();
        { pg8::Gemm g{WSP(WS_U), WSP(WS_WIN) + (size_t)3072 * 1024, MMAIN, 3584, 1024, 1024, 1024, GEMM_PLAIN}; pg8::StaticOrder S; S.init(MMAIN, 3584, G, c); EpiZPG E{WSP(WS_QB)}; pg8::gemm_phase<EpiZPG, pg8::StaticOrder, true>(lds, g, S, E, opaque_tid(p));
          meta_gemm(smem, WSP(WS_U), 1024, WSP(WS_WIN) + (size_t)3072 * 1024, 1024, 1024, 224, MstZPG{WSP(WS_QB)}, opaque_tid(p), G / 2); }
        GSYNC();
        FRESH(); phase_combine(p, layer, smem); GSYNC();
        FRESH();
        { pg8::Gemm g{WSP(WS_KB), WSP(WS_WOUT), MMAIN, 1024, 1024, 1024, 1024, GEMM_PLAIN}; pg8::StaticOrder S; S.init(MMAIN, 1024, G, c); EpiRes E{p.out, (float*)(p.ws + WS_HM), 1.0f}; pg8::gemm_phase<EpiRes, pg8::StaticOrder>(lds, g, S, E, opaque_tid(p));
          meta_gemm(smem, WSP(WS_KB), 1024, WSP(WS_WOUT), 1024, 1024, 64, MstRes{(float*)(p.ws + WS_HM)}, opaque_tid(p), G); }
        GSYNC();
        FRESH(); phase_norm(p, layer, 1, smem); GSYNC();
        FRESH();
        { pg8::Gemm g{WSP(WS_U), WSP(WS_WUP), 66 * 256, FF2, 1024, 1024, 1024, 33, 254, USEQ}; pg8::StaticOrder S; S.init(66 * 256, FF2, G, c);
          EpiAct E{WSP(WS_QB), p.conv_ffn + (size_t)layer * 3 * FF2, (PG8_LAS float*)(lds + 131072 + 16)}; pg8::gemm_phase<EpiAct, pg8::StaticOrder, true>(lds, g, S, E, opaque_tid(p)); }
        GSYNC();
        FRESH();
        { pg8::Gemm g{WSP(WS_QB), WSP(WS_WDN), MMAIN, 1024, DFF, DFF, DFF, GEMM_PLAIN}; pg8::StaticOrder S; S.init(MMAIN, 1024, G, c); EpiRes E{p.out, (float*)(p.ws + WS_HM), 1.0f}; pg8::gemm_phase<EpiRes, pg8::StaticOrder>(lds, g, S, E, opaque_tid(p));
          meta_gemm(smem, WSP(WS_QB), DFF, WSP(WS_WDN), DFF, DFF, 64, MstRes{(float*)(p.ws + WS_HM)}, opaque_tid(p), G); }
        GSYNC();
    }
    FRESH(); phase_final(p);
#undef GEMM_PLAIN
#undef FRESH
#undef WSP
#undef GSYNC
}

extern "C" void kernel_launch(void* const* d_in, const int* in_sizes, int n_in, void* d_out, int out_size, void* d_ws, size_t ws_size, hipStream_t stream) {
    static int grid_blocks = 0;
    if (!grid_blocks) {
        int dev = 0, cus = 0, per_cu = 0;
        hipGetDevice(&dev);
        hipDeviceGetAttribute(&cus, hipDeviceAttributeMultiprocessorCount, dev);
        if (hipFuncSetAttribute((const void*)mega_fwd, hipFuncAttributeMaxDynamicSharedMemorySize, LDS_BYTES) != hipSuccess) fprintf(stderr, "hipFuncSetAttribute failed\n");
        hipOccupancyMaxActiveBlocksPerMultiprocessor(&per_cu, (const void*)mega_fwd, 512, LDS_BYTES);
        if (per_cu < 1) { fprintf(stderr, "occupancy query reports %d blocks/CU\n", per_cu); per_cu = 1; }
        if (per_cu > 1) per_cu = 1;
        grid_blocks = cus * per_cu;
        if (ws_size < WS_END) fprintf(stderr, "workspace too small: %zu < %zu\n", ws_size, (size_t)WS_END);
    }
    Params p{};
    p.x = (const float*)d_in[0]; p.meta = (const float*)d_in[1]; p.norm_mix = (const float*)d_in[2]; p.w_in = (const float*)d_in[3]; p.conv_qkv = (const float*)d_in[4];
    p.a_log = (const float*)d_in[5]; p.dt_bias = (const float*)d_in[6]; p.head_norm = (const float*)d_in[7]; p.w_pool = (const float*)d_in[8]; p.pool_scale = (const float*)d_in[9];
    p.w_out = (const float*)d_in[10]; p.norm_ffn = (const float*)d_in[11]; p.w_up = (const float*)d_in[12]; p.conv_ffn = (const float*)d_in[13]; p.w_down = (const float*)d_in[14]; p.norm_final = (const float*)d_in[15];
    p.out = (float*)d_out; p.ws = (unsigned char*)d_ws;
    (void)hipMemsetAsync((unsigned char*)d_ws + WS_BAR, 0, (size_t)(WS_END - WS_BAR), stream);
    void* args[] = {&p};
    hipError_t e = hipLaunchCooperativeKernel((const void*)mega_fwd, dim3(grid_blocks), dim3(512), args, LDS_BYTES, stream);
    if (e != hipSuccess) fprintf(stderr, "cooperative launch failed: %s (grid %d)\n", hipGetErrorString(e), grid_blocks);
}
```
